# Optimizing an MI355X kernel written in HIP

```python
import math
import jax
import jax.numpy as jnp
from jax import lax
import numpy as np

D_MODEL = 1024
BATCH = 4
SEQ = 8192
DEPTH = 4

GRID_W = 64
CTX_LEN = 256
MIX_WIDTH = 2 * D_MODEL
S5_WIDTH = MIX_WIDTH // 2
RG_WIDTH = MIX_WIDTH - S5_WIDTH
IN_WIDTH_EVEN = 2 * S5_WIDTH + 2 * RG_WIDTH
S5_GROUP = 16
S5_GROUPS = S5_WIDTH // S5_GROUP
S5_STATE = 64
S5_CHUNK = 128
RG_HEADS = 4
RG_HEAD_DIM = RG_WIDTH // RG_HEADS
RG_C = 8.0
CONV_W = 4
ML_WIDTH = MIX_WIDTH
IN_WIDTH_ODD = 2 * ML_WIDTH
ML_HEADS = 4
ML_HEAD_DIM = ML_WIDTH // ML_HEADS
ML_QKV_BLOCK = 4
ML_CHUNK = 64
EPS = 1e-6

kernel_name = 'hybrid_s5_rglru_mlstm_prefix_dit'


def rms_norm(x, g):
    xf = x.astype(jnp.float32)
    y = xf * lax.rsqrt(jnp.mean(xf * xf, axis=-1, keepdims=True) + EPS)
    return (y * g.astype(jnp.float32)).astype(x.dtype)


def centred_dwconv(x, w, b):
    L = x.shape[1]
    left = (CONV_W - 1) // 2
    xp = jnp.pad(x, ((0, 0), (left, CONV_W - 1 - left), (0, 0)))
    y = b + xp[:, 0:L] * w[0]
    for j in range(1, CONV_W):
        y = y + xp[:, j:j + L] * w[j]
    return y


def headwise(x, w):
    nb, bi, bo = w.shape
    y = jnp.einsum('blgi,gio->blgo', x.reshape(x.shape[0], x.shape[1], nb, bi), w)
    return y.reshape(x.shape[0], x.shape[1], nb * bo)


def to_col_major(h, rows):
    bt, L, dm = h.shape
    return h.reshape(bt, rows, GRID_W, dm).transpose(0, 2, 1, 3).reshape(bt, L, dm)


def from_col_major(h, rows):
    bt, L, dm = h.shape
    return h.reshape(bt, GRID_W, rows, dm).transpose(0, 2, 1, 3).reshape(bt, L, dm)


def cmul(ar, ai, br, bi):
    return ar * br - ai * bi, ar * bi + ai * br


def prefix_bidir(scan_fn, ctx_seqs, lat_seqs, p_fwd, p_bwd):
    n_ctx = ctx_seqs[0].shape[1]
    fwd = scan_fn(*[jnp.concatenate([cs, ls], axis=1) for cs, ls in zip(ctx_seqs, lat_seqs)], *p_fwd)
    bwd = scan_fn(*[jnp.concatenate([jnp.flip(cs, 1), jnp.flip(ls, 1)], axis=1) for cs, ls in zip(ctx_seqs, lat_seqs)], *p_bwd)
    y_ctx = fwd[:, :n_ctx] + jnp.flip(bwd[:, :n_ctx], 1)
    y_lat = fwd[:, n_ctx:] + jnp.flip(bwd[:, n_ctx:], 1)
    return y_ctx, y_lat


def s5_scan(u, a_re, a_im, log_dt, b_re, b_im, c_re, c_im):
    f32 = jnp.float32
    bt, L, G, H = u.shape
    a_re, a_im = a_re.astype(f32), a_im.astype(f32)
    b_re, b_im = b_re.astype(f32), b_im.astype(f32)
    c_re, c_im = c_re.astype(f32), c_im.astype(f32)
    P = a_re.shape[-1]
    dt = jnp.exp(log_dt.astype(f32))[:, None]
    dar, dai = dt * a_re, dt * a_im
    mag = jnp.exp(dar)
    ab_re, ab_im = mag * jnp.cos(dai), mag * jnp.sin(dai)
    den = a_re * a_re + a_im * a_im
    nr, ni = ab_re - 1.0, ab_im
    co_re = (nr * a_re + ni * a_im) / den
    co_im = (ni * a_re - nr * a_im) / den
    bb_re = co_re[..., None] * b_re - co_im[..., None] * b_im
    bb_im = co_re[..., None] * b_im + co_im[..., None] * b_re
    k = jnp.arange(1, S5_CHUNK + 1, dtype=f32)[:, None, None]
    pmag = jnp.exp(k * dar)
    pw_re, pw_im = pmag * jnp.cos(k * dai), pmag * jnp.sin(k * dai)
    a_blk_re = jnp.broadcast_to(ab_re, (bt, S5_CHUNK, G, P))
    a_blk_im = jnp.broadcast_to(ab_im, (bt, S5_CHUNK, G, P))
    nc = L // S5_CHUNK
    uc = u.reshape(bt, nc, S5_CHUNK, G, H).transpose(1, 0, 2, 3, 4)

    def combine(e1, e2):
        a1r, a1i, b1r, b1i = e1
        a2r, a2i, b2r, b2i = e2
        ar, ai = cmul(a2r, a2i, a1r, a1i)
        br, bi = cmul(a2r, a2i, b1r, b1i)
        return ar, ai, br + b2r, bi + b2i

    def step(h, u_blk):
        hr, hi = h
        bur = jnp.einsum('btgh,gph->btgp', u_blk, bb_re)
        bui = jnp.einsum('btgh,gph->btgp', u_blk, bb_im)
        _, _, sr, si = lax.associative_scan(combine, (a_blk_re, a_blk_im, bur, bui), axis=1)
        cr, ci = cmul(pw_re, pw_im, hr[:, None], hi[:, None])
        sr, si = sr + cr, si + ci
        y = jnp.einsum('btgp,ghp->btgh', sr, c_re) - jnp.einsum('btgp,ghp->btgh', si, c_im)
        return (sr[:, -1], si[:, -1]), y

    h0 = jnp.zeros((bt, G, P), f32)
    _, y = lax.scan(step, (h0, h0), uc)
    return y.transpose(1, 0, 2, 3, 4).reshape(bt, L, G, H)


def rglru_scan(xc, wa, ba, wx, bx, lam):
    f32 = jnp.float32
    bt, L, W = xc.shape
    xf = xc.astype(f32)
    xh = xf.reshape(bt, L, RG_HEADS, RG_HEAD_DIM)
    r = jax.nn.sigmoid(jnp.einsum('blhi,hij->blhj', xh, wa.astype(f32)).reshape(bt, L, W) + ba.astype(f32))
    ig = jax.nn.sigmoid(jnp.einsum('blhi,hij->blhj', xh, wx.astype(f32)).reshape(bt, L, W) + bx.astype(f32))
    log_a = -RG_C * r * jax.nn.softplus(-lam.astype(f32))
    a = jnp.exp(log_a)
    bterm = jnp.sqrt(-jnp.expm1(2.0 * log_a)) * (ig * xf)

    def combine(e1, e2):
        return e1[0] * e2[0], e2[0] * e1[1] + e2[1]

    _, h = lax.associative_scan(combine, (a, bterm), axis=1)
    return h


def mlstm_scan(q, k, v, w_if, b_if):
    f32 = jnp.float32
    bt, L, nh, dh = q.shape
    e = nh * dh
    q, k, v = q.astype(f32), k.astype(f32), v.astype(f32)
    w_if = w_if.astype(f32)
    g = (q.reshape(bt, L, e) @ w_if[0] + k.reshape(bt, L, e) @ w_if[1]
         + v.reshape(bt, L, e) @ w_if[2] + b_if.astype(f32))
    log_i = g[..., :nh]
    log_f = jax.nn.log_sigmoid(g[..., nh:])
    k = k * (dh ** -0.5)
    nc = L // ML_CHUNK
    chunk = lambda t: t.reshape(bt, nc, ML_CHUNK, nh, dh).transpose(1, 0, 3, 2, 4)
    gchunk = lambda t: t.reshape(bt, nc, ML_CHUNK, nh).transpose(1, 0, 3, 2)
    mask = jnp.tril(jnp.ones((ML_CHUNK, ML_CHUNK), dtype=bool))

    def step(carry, xs):
        cmat, nvec, m = carry
        qc, kc, vc, li, lf = xs
        b = jnp.cumsum(lf, axis=-1)
        dmat = jnp.where(mask, b[..., :, None] - b[..., None, :] + li[..., None, :], -jnp.inf)
        inter = b + m[..., None]
        m_t = jnp.maximum(inter, jnp.max(dmat, axis=-1))
        s = jnp.einsum('bntd,bnsd->bnts', qc, kc) * jnp.exp(dmat - m_t[..., None])
        sc = jnp.exp(inter - m_t)
        num = jnp.einsum('bnts,bnse->bnte', s, vc) + sc[..., None] * jnp.einsum('bntd,bnde->bnte', qc, cmat)
        den = jnp.sum(s, axis=-1) + sc * jnp.einsum('bntd,bnd->bnt', qc, nvec)
        h = num / jnp.maximum(jnp.abs(den), jnp.exp(-m_t))[..., None]
        b_end = b[..., -1]
        g_s = b_end[..., None] - b + li
        m_new = jnp.maximum(b_end + m, jnp.max(g_s, axis=-1))
        decay = jnp.exp(b_end + m - m_new)
        kw = kc * jnp.exp(g_s - m_new[..., None])[..., None]
        c_new = decay[..., None, None] * cmat + jnp.einsum('bnsd,bnse->bnde', kw, vc)
        n_new = decay[..., None] * nvec + jnp.sum(kw, axis=2)
        return (c_new, n_new, m_new), h

    init = (jnp.zeros((bt, nh, dh, dh), f32), jnp.zeros((bt, nh, dh), f32), jnp.zeros((bt, nh), f32))
    _, h = lax.scan(step, init, (chunk(q), chunk(k), chunk(v), gchunk(log_i), gchunk(log_f)))
    return h.transpose(1, 0, 3, 2, 4).reshape(bt, L, nh, dh)


def head_norm(h, g):
    mu = jnp.mean(h, axis=-1, keepdims=True)
    var = jnp.mean(jnp.square(h - mu), axis=-1, keepdims=True)
    y = (h - mu) * lax.rsqrt(var + EPS)
    return y.reshape(h.shape[0], h.shape[1], -1) * g.astype(jnp.float32)


def even_mixer(h_ctx, h_lat, w_in, w_out, a_re, a_im, log_dt, b_re, b_im, c_re, c_im,
               s5_d, glu_w, glu_b, conv_w, conv_b, wa, ba, wx, bx, lam):
    def split_proj(h):
        return jnp.split(h @ w_in, [S5_WIDTH, 2 * S5_WIDTH, 2 * S5_WIDTH + RG_WIDTH], axis=-1)

    u_c, gs_c, xr_c, gr_c = split_proj(h_ctx)
    u_l, gs_l, xr_l, gr_l = split_proj(h_lat)
    grp = lambda u: u.astype(jnp.float32).reshape(u.shape[0], u.shape[1], S5_GROUPS, S5_GROUP)
    s5p = lambda d: (a_re[d], a_im[d], log_dt[d], b_re[d], b_im[d], c_re[d], c_im[d])
    ys_c, ys_l = prefix_bidir(s5_scan, (grp(u_c),), (grp(u_l),), s5p(0), s5p(1))
    rgp = lambda d: (wa[d], ba[d], wx[d], bx[d], lam[d])
    yr_c, yr_l = prefix_bidir(rglru_scan, (centred_dwconv(xr_c, conv_w, conv_b),),
                              (centred_dwconv(xr_l, conv_w, conv_b),), rgp(0), rgp(1))

    def post(ys, u, gs, yr, gr):
        y = ys.reshape(u.shape).astype(u.dtype) + s5_d * u
        y = jax.nn.gelu(y)
        y = y * jax.nn.sigmoid(y @ glu_w + glu_b)
        a_out = y * jax.nn.silu(gs)
        b_out = yr.astype(gr.dtype) * jax.nn.silu(gr)
        return jnp.concatenate([a_out, b_out], axis=-1) @ w_out

    return post(ys_c, u_c, gs_c, yr_c, gr_c), post(ys_l, u_l, gs_l, yr_l, gr_l)


def odd_mixer(h_ctx, h_lat, w_in, w_out, conv_w, conv_b, wq, wk, wv, w_if, b_if, norm_g, skip):
    def pre(h):
        xm, zg = jnp.split(h @ w_in, [ML_WIDTH], axis=-1)
        xcv = jax.nn.silu(centred_dwconv(xm, conv_w, conv_b))
        heads = lambda t: t.reshape(t.shape[0], t.shape[1], ML_HEADS, ML_HEAD_DIM)
        return xcv, zg, heads(headwise(xcv, wq)), heads(headwise(xcv, wk)), heads(headwise(xm, wv))

    xcv_c, z_c, q_c, k_c, v_c = pre(h_ctx)
    xcv_l, z_l, q_l, k_l, v_l = pre(h_lat)
    hm_c, hm_l = prefix_bidir(mlstm_scan, (q_c, k_c, v_c), (q_l, k_l, v_l),
                              (w_if[0], b_if[0]), (w_if[1], b_if[1]))

    def post(hm, xcv, zg):
        hn = head_norm(hm, norm_g).astype(xcv.dtype)
        return ((hn + skip * xcv) * jax.nn.silu(zg)) @ w_out

    return post(hm_c, xcv_c, z_c), post(hm_l, xcv_l, z_l)


def setup_inputs(seed: int = 0) -> dict:
    key = jax.random.key(seed)
    ks = iter(jax.random.split(key, 64))
    f32 = jnp.float32
    ne, no = (DEPTH + 1) // 2, DEPTH // 2
    dm = D_MODEL
    G, P, H = S5_GROUPS, S5_STATE, S5_GROUP

    def nrm(shape, scale):
        return scale * jax.random.normal(next(ks), shape, f32)

    lru_u = jax.random.uniform(next(ks), (ne, 2, RG_WIDTH), f32, 0.9, 0.999)
    lru_s = lru_u ** (1.0 / RG_C)
    f_bias = jnp.linspace(3.0, 6.0, ML_HEADS, dtype=f32)
    b_if = jnp.concatenate([nrm((no, 2, ML_HEADS), 0.1), f_bias + nrm((no, 2, ML_HEADS), 0.1)], axis=-1)
    return {
        'x': nrm((BATCH, SEQ, dm), 1.0),
        'c': nrm((BATCH, dm), 1.0),
        'ctx': nrm((BATCH, CTX_LEN, dm), 1.0),
        'c_ctx': nrm((dm,), 1.0),
        'norm_g': 1.0 + nrm((DEPTH, dm), 0.02),
        'mod_w': nrm((DEPTH, dm, 3 * dm), 0.5 * dm ** -0.5),
        'mod_b': nrm((DEPTH, 3 * dm), 0.02),
        'final_g': 1.0 + nrm((dm,), 0.02),
        'e_w_in': nrm((ne, dm, IN_WIDTH_EVEN), dm ** -0.5),
        'e_w_out': nrm((ne, MIX_WIDTH, dm), MIX_WIDTH ** -0.5),
        's5_a_re': -0.5 + nrm((ne, 2, G, P), 0.01),
        's5_a_im': math.pi * jnp.arange(P, dtype=f32) + nrm((ne, 2, G, P), 0.01),
        's5_log_dt': jax.random.uniform(next(ks), (ne, 2, G), f32, math.log(1e-3), math.log(1e-1)),
        's5_b_re': nrm((ne, 2, G, P, H), (2 * H) ** -0.5),
        's5_b_im': nrm((ne, 2, G, P, H), (2 * H) ** -0.5),
        's5_c_re': nrm((ne, 2, G, H, P), P ** -0.5),
        's5_c_im': nrm((ne, 2, G, H, P), P ** -0.5),
        's5_d': nrm((ne, S5_WIDTH), 1.0),
        's5_glu_w': nrm((ne, S5_WIDTH, S5_WIDTH), S5_WIDTH ** -0.5),
        's5_glu_b': nrm((ne, S5_WIDTH), 0.02),
        'rg_conv_w': nrm((ne, CONV_W, RG_WIDTH), CONV_W ** -0.5),
        'rg_conv_b': nrm((ne, RG_WIDTH), 0.02),
        'rg_wa': nrm((ne, 2, RG_HEADS, RG_HEAD_DIM, RG_HEAD_DIM), RG_HEAD_DIM ** -0.5),
        'rg_ba': nrm((ne, 2, RG_WIDTH), 0.02),
        'rg_wx': nrm((ne, 2, RG_HEADS, RG_HEAD_DIM, RG_HEAD_DIM), RG_HEAD_DIM ** -0.5),
        'rg_bx': nrm((ne, 2, RG_WIDTH), 0.02),
        'rg_lam': jnp.log(lru_s) - jnp.log1p(-lru_s),
        'o_w_in': nrm((no, dm, IN_WIDTH_ODD), dm ** -0.5),
        'o_w_out': nrm((no, ML_WIDTH, dm), ML_WIDTH ** -0.5),
        'ml_conv_w': nrm((no, CONV_W, ML_WIDTH), CONV_W ** -0.5),
        'ml_conv_b': nrm((no, ML_WIDTH), 0.02),
        'ml_wq': nrm((no, ML_WIDTH // ML_QKV_BLOCK, ML_QKV_BLOCK, ML_QKV_BLOCK), ML_QKV_BLOCK ** -0.5),
        'ml_wk': nrm((no, ML_WIDTH // ML_QKV_BLOCK, ML_QKV_BLOCK, ML_QKV_BLOCK), ML_QKV_BLOCK ** -0.5),
        'ml_wv': nrm((no, ML_WIDTH // ML_QKV_BLOCK, ML_QKV_BLOCK, ML_QKV_BLOCK), ML_QKV_BLOCK ** -0.5),
        'ml_w_if': nrm((no, 2, 3, ML_WIDTH, 2 * ML_HEADS), (3 * ML_WIDTH) ** -0.5),
        'ml_b_if': b_if,
        'ml_norm_g': 1.0 + nrm((no, ML_WIDTH), 0.02),
        'ml_skip': 1.0 + nrm((no, ML_WIDTH), 0.02),
    }


def reference(x, c, ctx, c_ctx, norm_g, mod_w, mod_b, final_g, e_w_in, e_w_out,
              s5_a_re, s5_a_im, s5_log_dt, s5_b_re, s5_b_im, s5_c_re, s5_c_im, s5_d, s5_glu_w, s5_glu_b,
              rg_conv_w, rg_conv_b, rg_wa, rg_ba, rg_wx, rg_bx, rg_lam,
              o_w_in, o_w_out, ml_conv_w, ml_conv_b, ml_wq, ml_wk, ml_wv, ml_w_if, ml_b_if,
              ml_norm_g, ml_skip):
    rows = x.shape[1] // GRID_W
    s_lat = jax.nn.silu(c)
    s_ctx = jax.nn.silu(c_ctx)
    for l in range(DEPTH):
        j = l // 2
        sh, sc, gt = jnp.split(s_lat @ mod_w[l] + mod_b[l], 3, axis=-1)
        shc, scc, gtc = jnp.split(s_ctx @ mod_w[l] + mod_b[l], 3, axis=-1)
        h_lat = rms_norm(x, norm_g[l]) * (1.0 + sc[:, None]) + sh[:, None]
        h_ctx = rms_norm(ctx, norm_g[l]) * (1.0 + scc) + shc
        if l % 2 == 0:
            o_ctx, o_lat = even_mixer(h_ctx, h_lat, e_w_in[j], e_w_out[j],
                                      s5_a_re[j], s5_a_im[j], s5_log_dt[j], s5_b_re[j], s5_b_im[j],
                                      s5_c_re[j], s5_c_im[j], s5_d[j], s5_glu_w[j], s5_glu_b[j],
                                      rg_conv_w[j], rg_conv_b[j], rg_wa[j], rg_ba[j], rg_wx[j],
                                      rg_bx[j], rg_lam[j])
        else:
            o_ctx, o_lat = odd_mixer(h_ctx, to_col_major(h_lat, rows), o_w_in[j], o_w_out[j],
                                     ml_conv_w[j], ml_conv_b[j], ml_wq[j], ml_wk[j], ml_wv[j],
                                     ml_w_if[j], ml_b_if[j], ml_norm_g[j], ml_skip[j])
            o_lat = from_col_major(o_lat, rows)
        x = x + gt[:, None] * o_lat
        if l < DEPTH - 1:
            ctx = ctx + gtc * o_ctx
    return rms_norm(x, final_g)
```

```cpp
#include <hip/hip_runtime.h>
#include <cstdio>
#include <cstdint>

#ifndef NAIVE_GEMM
#define NAIVE_GEMM 0
#endif
#if NAIVE_GEMM
#define GEMM_CALL(K_, la_, lb_, S_, E_) pg8::gemm_phase_naive(F.tid, K_, la_, lb_, S_, E_)
#else
#define GEMM_CALL(K_, la_, lb_, S_, E_) pg8::gemm_phase(F.lds, F.tid, K_, la_, lb_, S_, E_)
#endif
#ifndef ONE_LAUNCH
#define ONE_LAUNCH 1
#endif

#define LAS __attribute__((address_space(3)))
#define GAS __attribute__((address_space(1)))
typedef unsigned short bf16;
typedef short bf16x8 __attribute__((ext_vector_type(8)));
typedef float f32x4 __attribute__((ext_vector_type(4)));
typedef unsigned u32x4 __attribute__((ext_vector_type(4)));
typedef unsigned u32x2 __attribute__((ext_vector_type(2)));
typedef short s16x4 __attribute__((ext_vector_type(4)));

constexpr int NB = 4, LLAT = 8192, LCTX = 256, SEQL = LLAT + LCTX;
constexpr int M = NB * SEQL;
constexpr int D = 1024, DEPTH = 4;
constexpr int MH = M / 2;
constexpr int NTILE = M / 256, TPB = SEQL / 256;
constexpr float EPS = 1e-6f;
constexpr int NCH = SEQL / 64;

constexpr size_t MiB = 1u << 20;
constexpr size_t WS_CTL = 0, CTL_ZERO_BYTES = 64 * 1024;
constexpr size_t WS_MODV = 1 * MiB;
constexpr size_t WS_MG = WS_MODV + 256 * 1024;
constexpr size_t WS_WGT = WS_MG + 64 * 1024;
constexpr size_t WS_PC = WS_WGT + 128 * 1024;
constexpr size_t WS_SPT = WS_MODV + 512 * 1024;
constexpr size_t WS_DS = 2 * MiB;
constexpr size_t WS_PS = 3 * MiB;
constexpr size_t WS_GATE = 6 * MiB;
constexpr size_t WS_XCTX = 9 * MiB;
constexpr size_t WS_DN = 13 * MiB;
constexpr size_t WS_W = 16 * MiB;
constexpr size_t W_IN = 0, W_OUT = 8 * MiB, W_GLU = 12 * MiB, W_GATE = 14 * MiB;
constexpr size_t WS_ST = 32 * MiB;
constexpr size_t WS_SLAB = 50 * MiB;
constexpr size_t SLAB = (size_t)M * 1024 * 2;
static_assert(SLAB == 66 * MiB, "slab");
constexpr size_t WS_END = WS_SLAB + 7 * SLAB;
static_assert(WS_END == 512 * MiB, "ws map");

constexpr int LDS_BYTES = 163840;
constexpr int MISC_OFF = 163840 - 256;
constexpr int NWAVES = 8, NTHR = 512;

__device__ __forceinline__ float bf2f(unsigned b) { return __uint_as_float(b << 16); }
typedef __bf16 bf2v_t __attribute__((ext_vector_type(2)));
__device__ __forceinline__ unsigned f2bf(float f) { return (unsigned)__builtin_bit_cast(unsigned short, (__bf16)f); }
__device__ __forceinline__ unsigned pk2(float lo, float hi) { bf2v_t v; v.x = (__bf16)lo; v.y = (__bf16)hi; return __builtin_bit_cast(unsigned, v); }
__device__ __forceinline__ float sigm(float x) { return __builtin_amdgcn_rcpf(1.f + __expf(-x)); }
__device__ __forceinline__ float silu(float x) { return x * __builtin_amdgcn_rcpf(1.f + __expf(-x)); }
__device__ __forceinline__ float softplus(float x) { return x > 20.f ? x : __logf(1.f + __expf(x)); }
__device__ __forceinline__ float logsigmoid(float x) { return fminf(x, 0.f) - __logf(1.f + __expf(-fabsf(x))); }
__device__ __forceinline__ float gelu_tanh(float x) { return x * sigm(1.5957691216057308f * (x + 0.044715f * x * x * x)); }
__device__ __forceinline__ void unpack8(const u32x4 w, float (&v)[8]) {
    v[0] = bf2f(w.x & 0xffffu); v[1] = bf2f(w.x >> 16); v[2] = bf2f(w.y & 0xffffu); v[3] = bf2f(w.y >> 16);
    v[4] = bf2f(w.z & 0xffffu); v[5] = bf2f(w.z >> 16); v[6] = bf2f(w.w & 0xffffu); v[7] = bf2f(w.w >> 16);
}
__device__ __forceinline__ u32x4 pack8(const float (&v)[8]) { u32x4 w; w.x = pk2(v[0], v[1]); w.y = pk2(v[2], v[3]); w.z = pk2(v[4], v[5]); w.w = pk2(v[6], v[7]); return w; }
#define SWZX(v, m) __int_as_float(__builtin_amdgcn_ds_swizzle(__float_as_int(v), (((m) << 10) | 0x1f)))
__device__ __forceinline__ float wave_sum(float v) {
    v += SWZX(v, 1); v += SWZX(v, 2); v += SWZX(v, 4); v += SWZX(v, 8); v += SWZX(v, 16);
    return __int_as_float(__builtin_amdgcn_readlane(__float_as_int(v), 0)) + __int_as_float(__builtin_amdgcn_readlane(__float_as_int(v), 32));
}
__device__ __forceinline__ float sum8(float v) { v += SWZX(v, 1); v += SWZX(v, 2); v += SWZX(v, 4); return v; }
#define LDS_WAIT() asm volatile("s_waitcnt lgkmcnt(0)" ::: "memory")
#define VM_WAIT() asm volatile("s_waitcnt vmcnt(0)" ::: "memory")
#define WAVE_SYNC() do { asm volatile("s_waitcnt lgkmcnt(0)" ::: "memory"); __builtin_amdgcn_wave_barrier(); } while (0)

__device__ __forceinline__ int pos2s_even(int pos, int d) { return d == 0 ? pos : (pos < LCTX ? LCTX - 1 - pos : (SEQL + LCTX - 1) - pos); }
__device__ __forceinline__ int pos2s_odd(int pos, int d) {
    if (pos < LCTX) return d == 0 ? pos : LCTX - 1 - pos;
    const int p = d == 0 ? pos - LCTX : LLAT - 1 - (pos - LCTX);
    return LCTX + (p & 127) * 64 + (p >> 7);
}
__device__ __forceinline__ int nb_even(int s, int o) { const int t = s + o; return s < LCTX ? ((t >= 0 && t < LCTX) ? t : -1) : ((t >= LCTX && t < SEQL) ? t : -1); }
__device__ __forceinline__ int nb_odd(int s, int o) {
    if (s < LCTX) { const int t = s + o; return (t >= 0 && t < LCTX) ? t : -1; }
    const int i = s - LCTX, p = (i & 63) * 128 + (i >> 6) + o;
    if (p < 0 || p >= LLAT) return -1;
    return LCTX + (p & 127) * 64 + (p >> 7);
}

#define XB_TMO      128
#define XB_XCNT(j)  (256  + 64 * (j))
#define XB_XSUB(j)  (1280 + 64 * (j))
#define XB_XGEN(j)  (2304 + 64 * (j))
#define XB_TOP      3328
#define XB_TOPGEN   3392
#define XCD_BAR_WORDS 3456
#define XB_SPIN_CAP (1u << 22)
__device__ __forceinline__ unsigned xb_ld(unsigned* p)              { return __hip_atomic_load(p, __ATOMIC_RELAXED, __HIP_MEMORY_SCOPE_AGENT); }
__device__ __forceinline__ unsigned xb_add(unsigned* p, unsigned v) { return __hip_atomic_fetch_add(p, v, __ATOMIC_RELAXED, __HIP_MEMORY_SCOPE_AGENT); }
__device__ __forceinline__ unsigned xb_xcc_id() { return (unsigned)__builtin_amdgcn_s_getreg((3 << 11) | 20) & 0xFu; }
#define XB_SPIN(cond, bar) do { unsigned _sp = 0; while (cond) { __builtin_amdgcn_s_sleep(1); \
    if ((++_sp & 255u) == 0u) { if (xb_ld(&(bar)[XB_TMO])) break; if (_sp > XB_SPIN_CAP) { atomicAdd(&(bar)[XB_TMO], 1u); break; } } } } while (0)
struct XcdBarrier { unsigned* bar; unsigned x; volatile LAS unsigned* st; };
__device__ __forceinline__ XcdBarrier xcd_barrier_post(unsigned* bar, volatile LAS unsigned* st) {
    XcdBarrier b; b.bar = bar; b.x = xb_xcc_id(); b.st = st;
    if (threadIdx.x == 0) (void)xb_add(&bar[XB_XCNT(b.x)], 1u);
    return b;
}
__device__ __forceinline__ void xcd_barrier_complete(unsigned* bar, unsigned x, unsigned& nloc, unsigned& nx) {
    const unsigned G = gridDim.x * gridDim.y * gridDim.z;
    unsigned sum, cnt, mine, sp = 0u;
    for (;;) {
        sum = 0u; cnt = 0u; mine = 0u;
#pragma unroll
        for (unsigned j = 0; j < 16; ++j) { const unsigned c = xb_ld(&bar[XB_XCNT(j)]); sum += c; cnt += (c > 0u) ? 1u : 0u; mine = (j == x) ? c : mine; }
        if (sum == G) break;
        __builtin_amdgcn_s_sleep(1);
        if ((++sp & 255u) == 0u) { if (xb_ld(&bar[XB_TMO])) break; if (sp > XB_SPIN_CAP) { atomicAdd(&bar[XB_TMO], 1u); break; } }
    }
    nloc = mine > 0u ? mine : 1u; nx = cnt > 0u ? cnt : 1u;
}
__device__ __forceinline__ void xcd_barrier(const XcdBarrier& b, const bool leader) {
    asm volatile("s_waitcnt vmcnt(0)" ::: "memory");
    __syncthreads();
    if (leader) {
        unsigned* bar = b.bar;
        __builtin_amdgcn_s_waitcnt(0);
        unsigned nloc = b.st[0], nx = b.st[1];
        if (nloc == 0u) { xcd_barrier_complete(bar, b.x, nloc, nx); b.st[0] = nloc; b.st[1] = nx; }
        const unsigned old = xb_add(&bar[XB_XSUB(b.x)], 1u);
        const unsigned gen = old / nloc;
        if (old + 1u == (gen + 1u) * nloc) {
            __builtin_amdgcn_fence(__ATOMIC_RELEASE, "agent");
            asm volatile("s_waitcnt vmcnt(0)" ::: "memory");
            const unsigned og = xb_add(&bar[XB_TOP], 1u);
            const unsigned tg = og / nx;
            if (og + 1u == (tg + 1u) * nx) xb_add(&bar[XB_TOPGEN], 1u);
            else XB_SPIN(xb_ld(&bar[XB_TOPGEN]) == tg, bar);
            __builtin_amdgcn_fence(__ATOMIC_ACQUIRE, "agent");
            xb_add(&bar[XB_XGEN(b.x)], 1u);
            asm volatile("s_waitcnt vmcnt(0)" ::: "memory");
        } else {
            XB_SPIN(xb_ld(&bar[XB_XGEN(b.x)]) == gen, bar);
            __builtin_amdgcn_fence(__ATOMIC_ACQUIRE, "agent");
            asm volatile("s_waitcnt vmcnt(0)" ::: "memory");
        }
    }
    __syncthreads();
}

__device__ __forceinline__ void rg_coefs(const float la, float& om, float& mlt) {
    const float a = __expf(la);
    const float pom = -la * (1.f + la * (0.5f + la * (0.16666667f + la * 0.041666668f)));
    om = la > -0.125f ? pom : 1.f - a;
    mlt = __builtin_amdgcn_sqrtf(fmaxf(om * (2.f - om), 0.f));
}
namespace pg8 {
constexpr int BM = 256, BK = 64, HALF = 128, HTB = HALF * BK * 2, STAGE_BYTES = 8 * HTB, NXCD = 8, WGM = 8;
__host__ __device__ __forceinline__ int lds_byte(int r, int c) { const int st = (r >> 4) * 2 + (c >> 5), rr = r & 15, cc = c & 31, ob = rr * 64 + cc * 2; return st * 1024 + (ob ^ (((ob >> 9) & 1) << 5)); }
__host__ __device__ __forceinline__ void stage_rc(int b, int& R, int& C) { const int st = b / 1024, sb = b % 1024, swz = sb ^ (((sb >> 9) & 1) << 5); R = (st >> 1) * 16 + swz / 64; C = (st & 1) * 32 + (swz % 64) / 2; }
__host__ __device__ __forceinline__ int perm32(int rho) { const int n = rho >> 4, i = rho & 15; return 8 * (i >> 2) + 4 * n + (i & 3); }
struct Unit { int pm, pn; const char* a; const char* b; };
struct TileOrder {
    int nM, nN, nwg, G, c, skipctx;
    const char* A; size_t a_tile; int a_sh; size_t a_pn; const char* B; size_t b_tile;
    __device__ __forceinline__ void init(int nM_, int nN_, int G_, int c_, const void* A_, size_t a_tile_, const void* B_, size_t b_tile_, int a_sh_ = 0, size_t a_pn_ = 0) {
        nM = nM_; nN = nN_; nwg = nM * nN; G = G_; c = c_; skipctx = 0; A = (const char*)A_; a_tile = a_tile_; a_sh = a_sh_; a_pn = a_pn_; B = (const char*)B_; b_tile = b_tile_; }
    __device__ __forceinline__ bool next(int i, Unit& u) const {
        const long L = (long)i * G + c; if (L >= nwg) return false;
        int wgid = (int)L; { const int q = nwg / NXCD, r = nwg % NXCD, xcd = wgid % NXCD, off = wgid / NXCD; wgid = (xcd < r ? xcd * (q + 1) : r * (q + 1) + (xcd - r) * q) + off; }
        const int nig = WGM * nN, gid = wgid / nig, fm = gid * WGM, gsz = (nM - fm) < WGM ? (nM - fm) : WGM;
        u.pm = fm + ((wgid % nig) % gsz); u.pn = (wgid % nig) / gsz;
        if (skipctx) u.pm += u.pm / (TPB - 1) + 1;
        u.a = A + (size_t)u.pm * a_tile + (size_t)(u.pn >> a_sh) * a_pn; u.b = B + (size_t)u.pn * b_tile; return true;
    }
    __device__ __forceinline__ void a_ready(const Unit&) const {}
    __device__ __forceinline__ void done(const Unit&) const {}
};
__device__ __forceinline__ unsigned cvt_pk_bf16(float lo, float hi) { unsigned r; asm volatile("v_cvt_pk_bf16_f32 %0, %1, %2" : "=v"(r) : "v"(lo), "v"(hi)); return r; }

template <class Epi, class Sched>
__device__ __forceinline__ void gemm_phase(LAS unsigned char* lds, const int tid, const int K_, const int lda, const int ldb, const Sched& S, const Epi& E) {
    int K = K_; asm volatile("" : "+s"(K));
    const int wid = __builtin_amdgcn_readfirstlane(tid >> 6), lane = tid & 63, wr = wid >> 2, wc = wid & 3, fr = lane & 15, fq = lane >> 4;
    const int nt = K / BK;
    unsigned voffA[2], voffB[2];
#pragma unroll
    for (int i = 0; i < 2; ++i) { int R, C; stage_rc(tid * 16 + i * 8192, R, C); const int Rb = Epi::PERM ? ((R & ~31) + perm32(R & 31)) : R;
        voffA[i] = (unsigned)(R * lda + C) * 2u; voffB[i] = (unsigned)(Rb * ldb + C) * 2u; }
    const size_t kstep = (size_t)(BK * 2);
    const size_t hstepA = (size_t)HALF * lda * 2, hstepB = (size_t)HALF * ldb * 2;
    const unsigned ldsw = (unsigned)wid * 1024u;
    const int aoff = lds_byte(wr * 64 + fr, fq * 8), boff = lds_byte(wc * 32 + fr, fq * 8);
#define PG8_SA(b, h) (((b) * 2 + (h)) * HTB)
#define PG8_SB(b, h) ((4 + (b) * 2 + (h)) * HTB)
#define PG8_STAGE(bufoff, gbase, voff) do { _Pragma("unroll") for (int _i = 0; _i < 2; ++_i) \
        __builtin_amdgcn_global_load_lds((const unsigned*)((const char*)(gbase) + (voff)[_i]), (LAS unsigned*)(lds + (bufoff) + ldsw + _i * 8192), 16, 0, 0); } while (0)
#define PG8_LDA(dst, b, h) do { _Pragma("unroll") for (int m = 0; m < 4; ++m) _Pragma("unroll") for (int k = 0; k < 2; ++k) dst[m][k] = *(const LAS bf16x8*)(lds + PG8_SA(b, h) + aoff + m * 2048 + k * 1024); } while (0)
#define PG8_LDB(dst, b, h) do { _Pragma("unroll") for (int n = 0; n < 2; ++n) _Pragma("unroll") for (int k = 0; k < 2; ++k) dst[n][k] = *(const LAS bf16x8*)(lds + PG8_SB(b, h) + boff + n * 2048 + k * 1024); } while (0)
#define PG8_MMA(ai, bj, At, Bt) do { __builtin_amdgcn_s_setprio(1); _Pragma("unroll") for (int m = 0; m < 4; ++m) _Pragma("unroll") for (int n = 0; n < 2; ++n) _Pragma("unroll") for (int k = 0; k < 2; ++k) \
        acc[ai][bj][m][n] = __builtin_amdgcn_mfma_f32_16x16x32_bf16(Bt[n][k], At[m][k], acc[ai][bj][m][n], 0, 0, 0); __builtin_amdgcn_s_setprio(0); } while (0)
#define PG8_WAIT_V(n) asm volatile("s_waitcnt vmcnt(" #n ")" ::: "memory")
#define PG8_WAIT_L(n) asm volatile("s_waitcnt lgkmcnt(" #n ")" ::: "memory")
#define PG8_BAR __builtin_amdgcn_s_barrier()
#define PG8_SCHED __builtin_amdgcn_sched_barrier(0)
    Unit cur, nxt; int ui = 0;
    if (!S.next(0, cur)) return;
    f32x4 acc[2][2][4][2];
#pragma unroll
    for (int a = 0; a < 2; ++a)
#pragma unroll
        for (int b = 0; b < 2; ++b)
#pragma unroll
            for (int m = 0; m < 4; ++m)
#pragma unroll
                for (int n = 0; n < 2; ++n) acc[a][b][m][n] = (f32x4){0.f, 0.f, 0.f, 0.f};
    bf16x8 At[4][2], B0[2][2], B1[2][2];
    const char* cA = cur.a; const char* cB = cur.b;
    S.a_ready(cur);
    PG8_STAGE(PG8_SB(0, 0), cB, voffB); PG8_STAGE(PG8_SA(0, 0), cA, voffA); PG8_STAGE(PG8_SB(0, 1), cB + hstepB, voffB); PG8_STAGE(PG8_SA(0, 1), cA + hstepA, voffA);
    if (wr == 1) PG8_BAR;
    PG8_WAIT_V(4); PG8_BAR;
    PG8_STAGE(PG8_SB(1, 0), cB + kstep, voffB); PG8_STAGE(PG8_SA(1, 0), cA + kstep, voffA); PG8_STAGE(PG8_SB(1, 1), cB + hstepB + kstep, voffB);
    PG8_WAIT_V(6); PG8_BAR;
    for (;;) {
        const bool has_next = S.next(ui + 1, nxt);
        const char* nA = has_next ? nxt.a : cA; const char* nB = has_next ? nxt.b : cB;
        for (int t = 0; t < nt; t += 2) {
            const bool last = (t == nt - 2);
            const char* a1 = cA + (size_t)(t + 1) * kstep;
            const char* a2 = last ? nA : cA + (size_t)(t + 2) * kstep; const char* b2 = last ? nB : cB + (size_t)(t + 2) * kstep;
            const char* a3 = a2 + kstep; const char* b3 = b2 + kstep;
            if (last && has_next) S.a_ready(nxt);
            PG8_LDB(B0, 0, 0); PG8_SCHED; PG8_LDA(At, 0, 0); PG8_STAGE(PG8_SA(1, 1), a1 + hstepA, voffA);
            PG8_WAIT_L(8); PG8_BAR; PG8_WAIT_L(0); PG8_MMA(0, 0, At, B0); PG8_BAR; PG8_SCHED;
            PG8_LDB(B1, 0, 1); PG8_STAGE(PG8_SB(0, 0), b2, voffB);
            PG8_BAR; PG8_WAIT_L(0); PG8_MMA(0, 1, At, B1); PG8_BAR;
            PG8_LDA(At, 0, 1); PG8_STAGE(PG8_SA(0, 0), a2, voffA);
            PG8_BAR; PG8_WAIT_L(0); PG8_MMA(1, 0, At, B0); PG8_BAR; PG8_SCHED;
            PG8_STAGE(PG8_SB(0, 1), b2 + hstepB, voffB);
            PG8_WAIT_V(6); PG8_BAR; PG8_MMA(1, 1, At, B1); PG8_BAR;
            PG8_LDB(B0, 1, 0); PG8_SCHED; PG8_LDA(At, 1, 0); PG8_STAGE(PG8_SA(0, 1), a2 + hstepA, voffA);
            PG8_WAIT_L(8); PG8_BAR; PG8_WAIT_L(0); PG8_MMA(0, 0, At, B0); PG8_BAR; PG8_SCHED;
            PG8_LDB(B1, 1, 1); PG8_STAGE(PG8_SB(1, 0), b3, voffB);
            PG8_BAR; PG8_WAIT_L(0); PG8_MMA(0, 1, At, B1); PG8_BAR;
            PG8_LDA(At, 1, 1); PG8_STAGE(PG8_SA(1, 0), a3, voffA);
            PG8_BAR; PG8_WAIT_L(0); PG8_MMA(1, 0, At, B0); PG8_BAR; PG8_SCHED;
            PG8_STAGE(PG8_SB(1, 1), b3 + hstepB, voffB);
            PG8_WAIT_V(6); PG8_BAR; PG8_MMA(1, 1, At, B1); PG8_BAR;
        }
        E(acc, cur, wr, wc, fr, fq); S.done(cur);
        if (!has_next) break;
#pragma unroll
        for (int a = 0; a < 2; ++a)
#pragma unroll
            for (int b = 0; b < 2; ++b)
#pragma unroll
                for (int m = 0; m < 4; ++m)
#pragma unroll
                    for (int n = 0; n < 2; ++n) acc[a][b][m][n] = (f32x4){0.f, 0.f, 0.f, 0.f};
        cur = nxt; cA = nA; cB = nB; ++ui;
    }
    PG8_WAIT_V(0);
    if (wr == 0) PG8_BAR;
    PG8_BAR;
#undef PG8_SA
#undef PG8_SB
#undef PG8_STAGE
#undef PG8_LDA
#undef PG8_LDB
#undef PG8_MMA
#undef PG8_WAIT_V
#undef PG8_WAIT_L
#undef PG8_BAR
#undef PG8_SCHED
}

typedef const f32x4 (&AccRef)[2][2][4][2];
#ifndef NAIVE_GEMM
#define NAIVE_GEMM 0
#endif
template <class Epi, class Sched>
__device__ __forceinline__ void gemm_phase_naive(const int tid, const int K, const int lda, const int ldb, const Sched& S, const Epi& E) {
    const int wid = tid >> 6, lane = tid & 63, wr = wid >> 2, wc = wid & 3, fr = lane & 15, fq = lane >> 4;
    Unit cur;
    for (int ui = 0; S.next(ui, cur); ++ui) {
        f32x4 acc[2][2][4][2];
#pragma unroll
        for (int ai = 0; ai < 2; ++ai)
#pragma unroll
            for (int m = 0; m < 4; ++m) {
                const bf16* arow = (const bf16*)cur.a + (size_t)(128 * ai + 64 * wr + 16 * m + fr) * lda;
#pragma unroll
                for (int bj = 0; bj < 2; ++bj)
#pragma unroll
                    for (int n = 0; n < 2; ++n) {
                        const int c0 = 128 * bj + 32 * wc + (Epi::PERM ? 8 * fq + 4 * n : 16 * n + 4 * fq);
                        const bf16* b0 = (const bf16*)cur.b + (size_t)c0 * ldb;
                        float s0 = 0.f, s1 = 0.f, s2 = 0.f, s3 = 0.f;
                        for (int k = 0; k < K; k += 8) { float a[8], w[8]; unpack8(*(const u32x4*)(arow + k), a);
                            unpack8(*(const u32x4*)(b0 + k), w);
#pragma unroll
                            for (int x = 0; x < 8; ++x) s0 += a[x] * w[x];
                            unpack8(*(const u32x4*)(b0 + ldb + k), w);
#pragma unroll
                            for (int x = 0; x < 8; ++x) s1 += a[x] * w[x];
                            unpack8(*(const u32x4*)(b0 + 2 * ldb + k), w);
#pragma unroll
                            for (int x = 0; x < 8; ++x) s2 += a[x] * w[x];
                            unpack8(*(const u32x4*)(b0 + 3 * ldb + k), w);
#pragma unroll
                            for (int x = 0; x < 8; ++x) s3 += a[x] * w[x]; }
                        acc[ai][bj][m][n] = (f32x4){s0, s1, s2, s3}; } }
        E(acc, cur, wr, wc, fr, fq);
    }
}


struct EpiSplit {
    static constexpr bool PERM = true;
    bf16 *pe, *po; long se, so; int le, lo_; int wshift;
    __device__ __forceinline__ void operator()(AccRef acc, const Unit& u, int wr, int wc, int fr, int fq) const {
        const int rowb = u.pm * BM + wr * 64 + fr; const int colt = u.pn * BM; const int di = colt >> wshift, dh = di >> 1;
        bf16* base = (di & 1) ? po + (long)dh * so : pe + (long)dh * se; const int ldd = (di & 1) ? lo_ : le;
        const int col0 = (colt & ((1 << wshift) - 1)) + wc * 32 + 8 * fq;
#pragma unroll
        for (int ai = 0; ai < 2; ++ai)
#pragma unroll
            for (int m = 0; m < 4; ++m) { bf16* rowp = base + (size_t)(rowb + ai * HALF + m * 16) * ldd + col0;
#pragma unroll
                for (int bj = 0; bj < 2; ++bj) { const f32x4 v0 = acc[ai][bj][m][0], v1 = acc[ai][bj][m][1];
                    u32x4 w; w.x = cvt_pk_bf16(v0[0], v0[1]); w.y = cvt_pk_bf16(v0[2], v0[3]); w.z = cvt_pk_bf16(v1[0], v1[1]); w.w = cvt_pk_bf16(v1[2], v1[3]);
                    *(u32x4*)(rowp + bj * HALF) = w; } }
    }
};
struct EpiGlu {
    static constexpr bool PERM = true;
    const bf16* YG; bf16* Y; const float* gb;
    __device__ __forceinline__ void operator()(AccRef acc, const Unit& u, int wr, int wc, int fr, int fq) const {
        int rowb = u.pm * BM + wr * 64 + fr; const int col0 = u.pn * BM + wc * 32 + 8 * fq; asm volatile("" : "+v"(rowb));
        u32x4 ly[2][4], lg[2][4];
#define GLU_LD(g_, S) _Pragma("unroll") for (int q = 0; q < 4; ++q) { const size_t row = (size_t)(rowb + ((g_) >> 1) * HALF + (2 * ((g_) & 1) + (q >> 1)) * 16); const int col = col0 + (q & 1) * HALF; \
            ly[S][q] = *(const u32x4*)(YG + row * 1024 + col); lg[S][q] = *(const u32x4*)(Y + row * 2048 + col); }
        GLU_LD(0, 0)
#pragma unroll
        for (int g = 0; g < 4; ++g) {
            if (g + 1 < 4) { if ((g & 1) == 0) { GLU_LD(g + 1, 1) } else { GLU_LD(g + 1, 0) } }
#pragma unroll
            for (int q = 0; q < 4; ++q) { const int ai = g >> 1, m = 2 * (g & 1) + (q >> 1), bj = q & 1; const size_t row = (size_t)(rowb + ai * HALF + m * 16); const int col = col0 + bj * HALF;
                float y[8], gg[8], o[8]; unpack8(ly[g & 1][q], y); unpack8(lg[g & 1][q], gg);
                const f32x4 v0 = acc[ai][bj][m][0], v1 = acc[ai][bj][m][1];
                const float* gbp = gb + col; asm volatile("" : "+v"(gbp));
                const f32x4 b0 = *(const f32x4*)gbp, b1 = *(const f32x4*)(gbp + 4);
#pragma unroll
                for (int j = 0; j < 4; ++j) { o[j] = y[j] * sigm(v0[j] + b0[j]) * silu(gg[j]); o[4 + j] = y[4 + j] * sigm(v1[j] + b1[j]) * silu(gg[4 + j]); }
                *(u32x4*)(Y + row * 2048 + col) = pack8(o); }
        }
#undef GLU_LD
    }
};
struct EpiGate {
    static constexpr bool PERM = true;
    const bf16* XC; bf16* OM; const float *ba, *bx, *lam;
    __device__ __forceinline__ void operator()(AccRef acc, const Unit& u, int wr, int wc, int fr, int fq) const {
        const int rowb = u.pm * BM + wr * 64 + fr; const int h = u.pn >> 2, q = u.pn & 3, d = q >> 1, hf = q & 1;
        const int ch = h * 256 + hf * 128 + wc * 32 + 8 * fq;
        const int bq = u.pm / TPB; const bool cx = (u.pm - bq * TPB == 0) && d == 0;
        constexpr long dstep = (long)(SLAB / 2);
        bf16* const OMC = (bf16*)((char*)OM - (long)(WS_SLAB + 2 * SLAB - WS_ST)); bf16* const BT = OM + 3 * dstep;
        bf16* om = (cx ? OMC + ((long)bq * 256 - (long)u.pm * BM) * 1024 : OM + (long)d * dstep) + ch; bf16* bt = BT + (long)d * dstep + ch;
        float bav[8], bxv[8], sp[8];
#pragma unroll
        for (int j = 0; j < 8; ++j) { bav[j] = ba[d * 1024 + ch + j]; bxv[j] = bx[d * 1024 + ch + j]; sp[j] = lam[d * 1024 + ch + j]; }
        u32x4 xl[2][4];
#pragma unroll
        for (int ai = 0; ai < 2; ++ai)
#pragma unroll
            for (int m = 0; m < 4; ++m) xl[ai][m] = *(const u32x4*)(XC + (size_t)(rowb + ai * HALF + m * 16) * 1024 + ch);
#pragma unroll
        for (int ai = 0; ai < 2; ++ai)
#pragma unroll
            for (int m = 0; m < 4; ++m) { const size_t row = (size_t)(rowb + ai * HALF + m * 16);
                const f32x4 r0 = acc[ai][0][m][0], r1 = acc[ai][0][m][1], i0 = acc[ai][1][m][0], i1 = acc[ai][1][m][1];
                float x[8], o1[8], o2[8]; unpack8(xl[ai][m], x);
#pragma unroll
                for (int j = 0; j < 8; ++j) { const float vr = j < 4 ? r0[j & 3] : r1[j & 3], vi = j < 4 ? i0[j & 3] : i1[j & 3];
                    const float la = sp[j] * sigm(vr + bav[j]); float omj, mj; rg_coefs(la, omj, mj);
                    o1[j] = omj; o2[j] = mj * sigm(vi + bxv[j]) * x[j]; }
                *(u32x4*)(om + row * 1024) = pack8(o1); *(u32x4*)(bt + row * 1024) = pack8(o2); }
    }
};
struct EpiOut {
    static constexpr bool PERM = false;
    const float *srcLat, *srcCtx; float *dstLat, *dstCtx; const float* modl;
    __device__ __forceinline__ void operator()(AccRef acc, const Unit& u, int wr, int wc, int fr, int fq) const {
        const int b = u.pm / TPB, ti = u.pm - b * TPB;
        const float* src; float* dst; const float* gt;
        if (ti == 0) { src = srcCtx + (size_t)b * LCTX * D; dst = dstCtx + (size_t)b * LCTX * D; gt = modl + 4 * 3072 + 2048; }
        else { const size_t o = ((size_t)b * LLAT + (size_t)(ti - 1) * 256) * D; src = srcLat + o; dst = dstLat + o; gt = modl + b * 3072 + 2048; }
        const int rowb = wr * 64 + fr, col0 = u.pn * BM + wc * 32 + 4 * fq;
        f32x4 gv[2][2];
#pragma unroll
        for (int bj = 0; bj < 2; ++bj)
#pragma unroll
            for (int n = 0; n < 2; ++n) gv[bj][n] = *(const f32x4*)(gt + col0 + bj * HALF + n * 16);
        f32x4 xl[2][8];
#define OUT_LD(g_, S) { const float* sp_ = src + (size_t)(rowb + ((g_) >> 1) * HALF + 2 * ((g_) & 1) * 16) * D + col0; asm volatile("" : "+v"(sp_));     \
            _Pragma("unroll") for (int q = 0; q < 8; ++q) xl[S][q] = *(const f32x4*)(sp_ + (q >> 2) * 16 * D + ((q >> 1) & 1) * HALF + (q & 1) * 16); }
        OUT_LD(0, 0)
#pragma unroll
        for (int g = 0; g < 4; ++g) {
            if (g + 1 < 4) { if ((g & 1) == 0) { OUT_LD(g + 1, 1) } else { OUT_LD(g + 1, 0) } }
            float* dp_ = dst + (size_t)(rowb + (g >> 1) * HALF + 2 * (g & 1) * 16) * D + col0; asm volatile("" : "+v"(dp_));
#pragma unroll
            for (int q = 0; q < 8; ++q) { const int ai = g >> 1, m = 2 * (g & 1) + (q >> 2), bj = (q >> 1) & 1, n = q & 1;
                *(f32x4*)(dp_ + (q >> 2) * 16 * D + bj * HALF + n * 16) = xl[g & 1][q] + gv[bj][n] * acc[ai][bj][m][n]; }
        }
#undef OUT_LD
    }
};
struct CtxKOrder {
    int G, c; const char* A; size_t a_tile; const char* B; size_t b_tile;
    __device__ __forceinline__ bool next(int i, Unit& u) const {
        const int L = i * G + c; if (L >= 128) return false;
        const int ks = L & 7, pn = (L >> 3) & 3, b = L >> 5;
        u.pm = b * TPB; u.pn = pn | (ks << 8);
        u.a = A + (size_t)u.pm * a_tile + (size_t)ks * 256 * 2; u.b = B + (size_t)pn * b_tile + (size_t)ks * 256 * 2; return true;
    }
    __device__ __forceinline__ void a_ready(const Unit&) const {}
    __device__ __forceinline__ void done(const Unit&) const {}
};
struct CtxOrder {
    int G, c, c0, nN; const char* A; size_t a_tile; const char* B; size_t b_tile;
    __device__ __forceinline__ bool next(int i, Unit& u) const {
        const int L = i * G + c - c0; if (c < c0 || L >= NB * nN) return false;
        const int b = L / nN, pn = L - b * nN;
        u.pm = b * TPB; u.pn = pn; u.a = A + (size_t)u.pm * a_tile; u.b = B + (size_t)pn * b_tile; return true;
    }
    __device__ __forceinline__ void a_ready(const Unit&) const {}
    __device__ __forceinline__ void done(const Unit&) const {}
};
struct EpiPart {
    static constexpr bool PERM = false;
    float* P;
    __device__ __forceinline__ void operator()(AccRef acc, const Unit& u, int wr, int wc, int fr, int fq) const {
        const int ks = u.pn >> 8, pn = u.pn & 255, b = u.pm / TPB;
        float* dst = P + ((size_t)(ks * 4 + b) * 256 + wr * 64 + fr) * 1024 + pn * BM + wc * 32 + 4 * fq;
#pragma unroll
        for (int ai = 0; ai < 2; ++ai)
#pragma unroll
            for (int m = 0; m < 4; ++m)
#pragma unroll
                for (int bj = 0; bj < 2; ++bj)
#pragma unroll
                    for (int n = 0; n < 2; ++n) *(f32x4*)(dst + (size_t)(ai * HALF + m * 16) * 1024 + bj * HALF + n * 16) = acc[ai][bj][m][n];
    }
};
}

struct Args { const float* in[38]; float* out; unsigned char* ws; int ph_lo, ph_hi; };
#define CAS __attribute__((address_space(4)))
struct Ctx {
    LAS unsigned char* lds; int tid, lane, wave, bid, G, gw, NGW;
    const CAS char* kp; float* out; unsigned char* ws;
    __device__ __forceinline__ const float* in(int k) const { return *(const float* const CAS*)(kp + 8 * k); }
};
enum { I_X = 0, I_C, I_CTX, I_CCTX, I_NORMG, I_MODW, I_MODB, I_FINALG, I_EWIN, I_EWOUT, I_S5ARE, I_S5AIM, I_S5LOGDT, I_S5BRE, I_S5BIM, I_S5CRE, I_S5CIM, I_S5D, I_GLUW, I_GLUB,
       I_RGCW, I_RGCB, I_RGWA, I_RGBA, I_RGWX, I_RGBX, I_RGLAM, I_OWIN, I_OWOUT, I_MLCW, I_MLCB, I_MLWQ, I_MLWK, I_MLWV, I_MLWIF, I_MLBIF, I_MLNG, I_MLSKIP };

__device__ __forceinline__ const float* xrow_src(const Ctx& F, int l, int r, int lc) {
    const int b = r / SEQL, s = r - b * SEQL;
    if (s < LCTX) return (lc == 0 ? F.in(I_CTX) : (const float*)(F.ws + WS_XCTX)) + ((size_t)b * LCTX + s) * D;
    return (l == 0 ? F.in(I_X) : (const float*)F.out) + ((size_t)b * LLAT + (s - LCTX)) * D;
}

__device__ __forceinline__ void ph_mod(const Ctx& F) {
    LAS float* sl = (LAS float*)F.lds;
    LAS float* red = sl + 5 * 1024;
    for (int i = F.tid; i < 5 * 1024; i += NTHR) { const int bb = i >> 10, k = i & 1023; const float v = bb < 4 ? F.in(I_C)[bb * 1024 + k] : F.in(I_CCTX)[k]; sl[i] = silu(v); }
    __syncthreads();
    float* modv = (float*)(F.ws + WS_MODV);
    for (int it = F.bid; it < DEPTH * 48; it += F.G) {
        const int l = it / 48, j = (it - l * 48) * 64 + (F.tid & 63), kp = F.tid >> 6;
        const float* w = F.in(I_MODW) + (size_t)l * 1024 * 3072 + (size_t)(kp * 128) * 3072 + j;
        float a0 = 0.f, a1 = 0.f, a2 = 0.f, a3 = 0.f, a4 = 0.f;
#pragma unroll 16
        for (int k = 0; k < 128; ++k) { const float wv = w[(size_t)k * 3072]; const int kk = kp * 128 + k; a0 += sl[kk] * wv; a1 += sl[1024 + kk] * wv; a2 += sl[2048 + kk] * wv; a3 += sl[3072 + kk] * wv; a4 += sl[4096 + kk] * wv; }
        __syncthreads();
        red[(kp * 5 + 0) * 64 + (F.tid & 63)] = a0; red[(kp * 5 + 1) * 64 + (F.tid & 63)] = a1; red[(kp * 5 + 2) * 64 + (F.tid & 63)] = a2; red[(kp * 5 + 3) * 64 + (F.tid & 63)] = a3; red[(kp * 5 + 4) * 64 + (F.tid & 63)] = a4;
        __syncthreads();
        if (F.tid < 320) { const int bb = F.tid >> 6, jj = F.tid & 63; float t = 0.f;
#pragma unroll
            for (int q = 0; q < 8; ++q) t += red[(q * 5 + bb) * 64 + jj];
            const int jo = (it - l * 48) * 64 + jj;
            modv[((size_t)l * 5 + bb) * 3072 + jo] = t + F.in(I_MODB)[l * 3072 + jo]; }
    }
    __syncthreads();
}

__device__ __forceinline__ void transpose_item(const float* W, int N, bf16* WT, int ldw, int row_off, LAS float* scr, int item, int lane) {
    const int nblk = N / 32, kb = item / nblk, nbk = item % nblk, k0 = 64 * kb, n0 = 32 * nbk;
#pragma unroll 8
    for (int i = 0; i < 32; ++i) { const int kk = 2 * i + (lane >> 5); scr[kk * 33 + (lane & 31)] = W[(size_t)(k0 + kk) * N + n0 + (lane & 31)]; }
    WAVE_SYNC();
    const int c = lane & 7;
#pragma unroll
    for (int j = 0; j < 4; ++j) { const int n = (lane >> 3) + 8 * j; const LAS float* s = scr + (8 * c) * 33 + n;
        u32x4 o; o.x = pk2(s[0 * 33], s[1 * 33]); o.y = pk2(s[2 * 33], s[3 * 33]); o.z = pk2(s[4 * 33], s[5 * 33]); o.w = pk2(s[6 * 33], s[7 * 33]);
        *(u32x4*)(WT + (size_t)(row_off + n0 + n) * ldw + k0 + 8 * c) = o; }
    WAVE_SYNC();
}
__device__ __forceinline__ void ph_wconv_even(const Ctx& F, int j) {
    { const float* lam = F.in(I_RGLAM) + (size_t)j * 2048; float* spt = (float*)(F.ws + WS_SPT);
      for (int i = F.bid * NTHR + F.tid; i < 2048; i += F.G * NTHR) spt[i] = -8.f * softplus(-lam[i]); }
    LAS float* scr = (LAS float*)(F.lds + F.wave * 16384);
    bf16* win = (bf16*)(F.ws + WS_W + W_IN); bf16* wout = (bf16*)(F.ws + WS_W + W_OUT); bf16* wglu = (bf16*)(F.ws + WS_W + W_GLU); bf16* wgate = (bf16*)(F.ws + WS_W + W_GATE);
    constexpr int I_1 = 16 * 128, I_2 = 16 * 32, I_3 = 32 * 32, I_4 = 16 * 32;
    for (int it = F.gw; it < I_1 + I_2 + I_3 + I_4; it += F.NGW) {
        int r = it;
        if (r < I_1) { transpose_item(F.in(I_EWIN) + (size_t)j * 1024 * 4096, 4096, win, 1024, 0, scr, r, F.lane); continue; } r -= I_1;
        if (r < I_2) { transpose_item(F.in(I_GLUW) + (size_t)j * 1024 * 1024, 1024, wglu, 1024, 0, scr, r, F.lane); continue; } r -= I_2;
        if (r < I_3) { transpose_item(F.in(I_EWOUT) + (size_t)j * 2048 * 1024, 1024, wout, 2048, 0, scr, r, F.lane); continue; } r -= I_3;
        { const int mat = r >> 5, sub = r & 31, h = mat >> 2, q = mat & 3, d = q >> 1, isx = q & 1;
          const float* W = (isx ? F.in(I_RGWX) : F.in(I_RGWA)) + ((size_t)((j * 2 + d) * 4 + h)) * 256 * 256;
          const int n0 = 32 * (sub & 7);
          transpose_item(W, 256, wgate, 256, (4 * h + 2 * d + (n0 >> 7)) * 256 + isx * 128 + (n0 & 127) - n0, scr, sub, F.lane); }
    }
}
__device__ __forceinline__ void ph_wconv_odd(const Ctx& F, int j) {
    LAS float* scr = (LAS float*)(F.lds + F.wave * 16384);
    bf16* win = (bf16*)(F.ws + WS_W + W_IN); bf16* wout = (bf16*)(F.ws + WS_W + W_OUT);
    constexpr int I_1 = 16 * 128, I_3 = 32 * 32;
    for (int it = F.gw; it < I_1 + I_3; it += F.NGW) {
        int r = it;
        if (r < I_1) { transpose_item(F.in(I_OWIN) + (size_t)j * 1024 * 4096, 4096, win, 1024, 0, scr, r, F.lane); continue; } r -= I_1;
        transpose_item(F.in(I_OWOUT) + (size_t)j * 2048 * 1024, 1024, wout, 2048, 0, scr, r, F.lane);
    }
    const float* wq = F.in(I_MLWQ) + (size_t)j * 512 * 16; const float* wk = F.in(I_MLWK) + (size_t)j * 512 * 16; const float* wv = F.in(I_MLWV) + (size_t)j * 512 * 16;
    float* mg = (float*)(F.ws + WS_MG);
    for (int idx = F.bid * NTHR + F.tid; idx < 512 * 16; idx += F.G * NTHR) { const int g = idx >> 4, i = (idx >> 2) & 3, jj = idx & 3; float a = 0.f;
#pragma unroll
        for (int o = 0; o < 4; ++o) a += wq[g * 16 + i * 4 + o] * wk[g * 16 + jj * 4 + o];
        mg[idx] = a * 0.04419417382415922f; }
    unsigned* wgt = (unsigned*)(F.ws + WS_WGT);
    const float* wif = F.in(I_MLWIF) + (size_t)j * 2 * 3 * 2048 * 8;
    for (int idx = F.bid * NTHR + F.tid; idx < 1024 * 32; idx += F.G * NTHR) {
        const int cp = idx >> 5, src = (idx >> 4) & 1, o = idx & 15, d = o >> 3, n8 = o & 7; float wv2[2];
#pragma unroll
        for (int half = 0; half < 2; ++half) { const int c = 2 * cp + half, g = c >> 2, i = c & 3; float a = 0.f;
#pragma unroll
            for (int oo = 0; oo < 4; ++oo) {
                if (src) a += wv[g * 16 + i * 4 + oo] * wif[((size_t)(d * 3 + 2) * 2048 + 4 * g + oo) * 8 + n8];
                else a += wq[g * 16 + i * 4 + oo] * wif[((size_t)(d * 3 + 0) * 2048 + 4 * g + oo) * 8 + n8] + wk[g * 16 + i * 4 + oo] * wif[((size_t)(d * 3 + 1) * 2048 + 4 * g + oo) * 8 + n8]; }
            wv2[half] = a; }
        const int c0 = 2 * cp, cq = c0 >> 9, rem = c0 & 511, kk = rem >> 7, g4 = (rem >> 5) & 3, i4 = (rem >> 3) & 3, e2 = (rem & 7) >> 1;
        wgt[((size_t)(((src * 4 + cq) * 16 + kk * 4 + i4) * 64 + g4 * 16 + o)) * 4 + e2] = pk2(wv2[0], wv2[1]);
    }
}

__device__ __forceinline__ void fold_ctx(const Ctx& F, const float* P, const float* gtc, int r, f32x4 (&v)[4]) {
    const int b = r / SEQL, s = r - b * SEQL;
    if (s >= LCTX) return;
    const int row = b * LCTX + s;
    const f32x4* p = (const f32x4*)(P + (size_t)row * 1024) + F.lane;
    f32x4 a[4];
#pragma unroll
    for (int jj = 0; jj < 4; ++jj) a[jj] = p[64 * jj];
#pragma unroll
    for (int ks = 1; ks < 8; ++ks)
#pragma unroll
        for (int jj = 0; jj < 4; ++jj) a[jj] += p[(size_t)ks * (1024 * 256) + 64 * jj];
    f32x4* xo = (f32x4*)((float*)(F.ws + WS_XCTX) + (size_t)row * 1024) + F.lane;
#pragma unroll
    for (int jj = 0; jj < 4; ++jj) { const f32x4 g = *(const f32x4*)(gtc + 4 * F.lane + 256 * jj); v[jj] = v[jj] + g * a[jj]; xo[64 * jj] = v[jj]; }
}
__device__ __forceinline__ void ph_norm(const Ctx& F, int l, int r0, int r1, bf16* HB, const float* P) {
    const float* modl = (const float*)(F.ws + WS_MODV) + (size_t)l * 5 * 3072;
    const float* ng = F.in(I_NORMG) + l * 1024;
    const float* gtc = modl - 5 * 3072 + 4 * 3072 + 2048;
    const int lc = P ? l - 1 : l;
    for (int ra = r0 + F.gw; ra < r1; ra += 2 * F.NGW) {
        const int rb = ra + F.NGW; const bool hasb = rb < r1; const int rbb = hasb ? rb : ra;
        const f32x4* xa = (const f32x4*)xrow_src(F, l, ra, lc) + F.lane; const f32x4* xb = (const f32x4*)xrow_src(F, l, rbb, lc) + F.lane;
        f32x4 va[4], vb[4]; float sa = 0.f, sb = 0.f;
#pragma unroll
        for (int jj = 0; jj < 4; ++jj) { va[jj] = xa[64 * jj]; vb[jj] = xb[64 * jj]; }
        if (P) { fold_ctx(F, P, gtc, ra, va); if (hasb) fold_ctx(F, P, gtc, rb, vb); }
#pragma unroll
        for (int jj = 0; jj < 4; ++jj) { sa += (va[jj].x * va[jj].x + va[jj].y * va[jj].y) + (va[jj].z * va[jj].z + va[jj].w * va[jj].w); sb += (vb[jj].x * vb[jj].x + vb[jj].y * vb[jj].y) + (vb[jj].z * vb[jj].z + vb[jj].w * vb[jj].w); }
        const float rsa = rsqrtf(wave_sum(sa) * (1.f / D) + EPS), rsb = rsqrtf(wave_sum(sb) * (1.f / D) + EPS);
#pragma unroll
        for (int w2 = 0; w2 < 2; ++w2) { if (w2 == 1 && !hasb) break;
            const int r = w2 ? rb : ra; const float rstd = w2 ? rsb : rsa;
            const int b = r / SEQL, s = r - b * SEQL, bb = s < LCTX ? 4 : b;
            const float* sh = modl + bb * 3072; const float* sc = sh + 1024;
            unsigned long long* o8 = (unsigned long long*)(HB + (size_t)(r - r0) * D) + F.lane;
#pragma unroll
            for (int jj = 0; jj < 4; ++jj) { const int c = 4 * F.lane + 256 * jj; const f32x4 v = w2 ? vb[jj] : va[jj];
                const f32x4 g = *(const f32x4*)(ng + c), a = *(const f32x4*)(sc + c), h = *(const f32x4*)(sh + c);
                const float y0 = v.x * rstd * g.x * (1.f + a.x) + h.x, y1 = v.y * rstd * g.y * (1.f + a.y) + h.y, y2 = v.z * rstd * g.z * (1.f + a.z) + h.z, y3 = v.w * rstd * g.w * (1.f + a.w) + h.w;
                o8[64 * jj] = (unsigned long long)pk2(y0, y1) | ((unsigned long long)pk2(y2, y3) << 32); } }
    }
}

__device__ __forceinline__ void ph_rgconv(const Ctx& F, int j, const bf16* XR, bf16* XC) {
    const float* cw = F.in(I_RGCW) + (size_t)j * 4 * 1024; const float* cb = F.in(I_RGCB) + (size_t)j * 1024;
    for (int it = F.bid * NTHR + F.tid; it < M * 128; it += F.G * NTHR) {
        const int r = it >> 7, c = (it & 127) * 8, b = r / SEQL, s = r - b * SEQL;
        float a[8];
#pragma unroll
        for (int e = 0; e < 8; ++e) a[e] = cb[c + e];
#pragma unroll
        for (int t = 0; t < 4; ++t) { const int sn = nb_even(s, t - 1);
            if (sn >= 0) { float x[8]; unpack8(*(const u32x4*)(XR + ((size_t)b * SEQL + sn) * 1024 + c), x);
#pragma unroll
                for (int e = 0; e < 8; ++e) a[e] += cw[t * 1024 + c + e] * x[e]; } }
        *(u32x4*)(XC + (size_t)r * 1024 + c) = pack8(a);
    }
}

__device__ __forceinline__ void ph_s5_naive(const Ctx& F, int j, const bf16* U, bf16* YS0, bf16* YS1) {
    if ((F.wave & 3) != 0) return;
    const int slot = F.wave >> 2;
    LAS float* xre = (LAS float*)(F.lds + slot * 65536);
    LAS float* xim = xre + 64 * 65;
    LAS float* cre = xim + 64 * 65;
    LAS float* cim = cre + 1024;
    LAS float* ub = cim + 1024;
    const int p = F.lane;
    for (int q = F.bid * 2 + slot; q < NB * 2 * 64; q += F.G * 2) {
        const int b = q >> 7, d = (q >> 6) & 1, g = q & 63;
        const size_t pg = (size_t)((j * 2 + d) * 64 + g);
        const float are = F.in(I_S5ARE)[pg * 64 + p], aim = F.in(I_S5AIM)[pg * 64 + p], dt = expf(F.in(I_S5LOGDT)[pg]);
        const float dar = dt * are, dai = dt * aim, mag = expf(dar);
        const float abr = mag * cosf(dai), abi = mag * sinf(dai);
        const float den = are * are + aim * aim, nr = abr - 1.f, ni = abi;
        const float cor = (nr * are + ni * aim) / den, coi = (ni * are - nr * aim) / den;
        float bbr[16], bbi[16];
#pragma unroll
        for (int h = 0; h < 16; ++h) { const float br = F.in(I_S5BRE)[(pg * 64 + p) * 16 + h], bi = F.in(I_S5BIM)[(pg * 64 + p) * 16 + h]; bbr[h] = cor * br - coi * bi; bbi[h] = cor * bi + coi * br; }
#pragma unroll
        for (int h = 0; h < 16; ++h) { cre[h * 64 + p] = F.in(I_S5CRE)[(pg * 16 + h) * 64 + p]; cim[h * 64 + p] = F.in(I_S5CIM)[(pg * 16 + h) * 64 + p]; }
        bf16* YS = d ? YS1 : YS0;
        float sr = 0.f, si = 0.f;
        for (int ck = 0; ck < SEQL / 64; ++ck) {
            const size_t myrow = (size_t)b * SEQL + pos2s_even(ck * 64 + F.lane, d);
            { float x[8]; unpack8(*(const u32x4*)(U + myrow * 1024 + 16 * g), x);
#pragma unroll
              for (int e = 0; e < 8; ++e) ub[F.lane * 16 + e] = x[e];
              unpack8(*(const u32x4*)(U + myrow * 1024 + 16 * g + 8), x);
#pragma unroll
              for (int e = 0; e < 8; ++e) ub[F.lane * 16 + 8 + e] = x[e]; }
            WAVE_SYNC();
            for (int t = 0; t < 64; ++t) {
                float bur = 0.f, bui = 0.f;
#pragma unroll
                for (int h4 = 0; h4 < 4; ++h4) { const f32x4 uv = *(const LAS f32x4*)(ub + t * 16 + h4 * 4);
                    bur += bbr[h4 * 4] * uv.x + bbr[h4 * 4 + 1] * uv.y + bbr[h4 * 4 + 2] * uv.z + bbr[h4 * 4 + 3] * uv.w;
                    bui += bbi[h4 * 4] * uv.x + bbi[h4 * 4 + 1] * uv.y + bbi[h4 * 4 + 2] * uv.z + bbi[h4 * 4 + 3] * uv.w; }
                const float nsr = abr * sr - abi * si + bur, nsi = abr * si + abi * sr + bui;
                sr = nsr; si = nsi;
                xre[p * 65 + t] = sr; xim[p * 65 + t] = si;
            }
            WAVE_SYNC();
            float y[16];
#pragma unroll
            for (int h = 0; h < 16; ++h) y[h] = 0.f;
            for (int pp = 0; pp < 64; ++pp) { const float vr = xre[pp * 65 + F.lane], vi = xim[pp * 65 + F.lane];
#pragma unroll
                for (int h = 0; h < 16; ++h) y[h] += vr * cre[h * 64 + pp] - vi * cim[h * 64 + pp]; }
            { float o[8];
#pragma unroll
              for (int e = 0; e < 8; ++e) o[e] = y[e];
              *(u32x4*)(YS + myrow * 1024 + 16 * g) = pack8(o);
#pragma unroll
              for (int e = 0; e < 8; ++e) o[e] = y[8 + e];
              *(u32x4*)(YS + myrow * 1024 + 16 * g + 8) = pack8(o); }
            WAVE_SYNC();
        }
    }
}
typedef float f32x16s __attribute__((ext_vector_type(16)));
__device__ __forceinline__ float xhalf(const float v, const int hh) { const auto r = __builtin_amdgcn_permlane32_swap(__float_as_uint(v), __float_as_uint(v), false, false); return __uint_as_float(hh ? r[0] : r[1]); }
__device__ __forceinline__ void ph_s5_mfma(const Ctx& F, int j, bf16* U, bf16* YS0) {
    const int qd = F.wave;
    constexpr int XS = 272;
    constexpr int NCQ = SEQL / 32 / 8;
    LAS unsigned char* const X = F.lds + F.wave * 8704;
    LAS bf16x8* const FRL = (LAS bf16x8*)(F.lds + 8 * 8704);
    LAS f32x4* const PWT = (LAS f32x4*)(F.lds + 8 * 8704 + 8192);
    LAS f32x4* const ES = (LAS f32x4*)(F.lds + 8 * 8704 + 24576);
    const float* dd = F.in(I_S5D) + (size_t)j * 1024;
    const int lane = F.lane, c = lane & 31, hh = lane >> 5;
    const int qb = (F.G == 256) ? ((F.bid & 7) * 32 + (F.bid >> 3)) : F.bid;
    for (int q = qb; q < NB * 64; q += F.G) {
        const int b = q >> 6, g = q & 63;
#pragma unroll 1
      for (int d = 0; d < 2; ++d) {
        const size_t pg = (size_t)((j * 2 + d) * 64 + g);
        const float dt = expf(F.in(I_S5LOGDT)[pg]);
        float abr[2], abi[2], cor[2], coi[2], a16r[2], a16i[2], aqr[2], aqi[2];
#pragma unroll
        for (int st = 0; st < 2; ++st) { const int pp = st * 32 + c; const float are = F.in(I_S5ARE)[pg * 64 + pp], aim = F.in(I_S5AIM)[pg * 64 + pp];
            const float dar = dt * are, dai = dt * aim, mag = expf(dar); abr[st] = mag * cosf(dai); abi[st] = mag * sinf(dai);
            const float den = are * are + aim * aim, nr = abr[st] - 1.f, ni = abi[st]; cor[st] = (nr * are + ni * aim) / den; coi[st] = (ni * are - nr * aim) / den;
            const float m16 = expf(16.f * dar); a16r[st] = m16 * cosf(16.f * dai); a16i[st] = m16 * sinf(16.f * dai);
            const float mq = expf((float)(NCQ * 32) * dar); aqr[st] = mq * cosf((float)(NCQ * 32) * dai); aqi[st] = mq * sinf((float)(NCQ * 32) * dai); }
        __syncthreads();
        if (qd == 0) {
            { float pr = abr[0], pi = abi[0], qr = abr[1], qi = abi[1];
#pragma unroll 1
              for (int i = 0; i < 16; ++i) { PWT[i * 64 + lane] = (f32x4){pr, pi, qr, qi};
                  const float npr = pr * abr[0] - pi * abi[0], npi = pr * abi[0] + pi * abr[0]; pr = npr; pi = npi;
                  const float nqr = qr * abr[1] - qi * abi[1], nqi = qr * abi[1] + qi * abr[1]; qr = nqr; qi = nqi; } }
#pragma unroll
            for (int st = 0; st < 2; ++st) { const int pp = st * 32 + c;
                const f32x4 br0 = *(const f32x4*)(F.in(I_S5BRE) + (pg * 64 + pp) * 16 + 8 * hh), br1 = *(const f32x4*)(F.in(I_S5BRE) + (pg * 64 + pp) * 16 + 8 * hh + 4);
                const f32x4 bi0 = *(const f32x4*)(F.in(I_S5BIM) + (pg * 64 + pp) * 16 + 8 * hh), bi1 = *(const f32x4*)(F.in(I_S5BIM) + (pg * 64 + pp) * 16 + 8 * hh + 4);
                const float brv[8] = {br0.x, br0.y, br0.z, br0.w, br1.x, br1.y, br1.z, br1.w}, biv[8] = {bi0.x, bi0.y, bi0.z, bi0.w, bi1.x, bi1.y, bi1.z, bi1.w};
                float vr[8], vi[8];
#pragma unroll
                for (int i = 0; i < 8; ++i) { vr[i] = cor[st] * brv[i] - coi[st] * biv[i]; vi[i] = cor[st] * biv[i] + coi[st] * brv[i]; }
                FRL[st * 64 + lane] = __builtin_bit_cast(bf16x8, pack8(vr)); FRL[(2 + st) * 64 + lane] = __builtin_bit_cast(bf16x8, pack8(vi)); }
#pragma unroll
            for (int ks = 0; ks < 4; ++ks) { const int c2a = 8 * ks + 2 * (lane >> 4); const size_t ro = (pg * 16 + (lane & 15)) * 64;
                const float2 r0 = *(const float2*)(F.in(I_S5CRE) + ro + c2a), r1 = *(const float2*)(F.in(I_S5CRE) + ro + 32 + c2a);
                const float2 m0 = *(const float2*)(F.in(I_S5CIM) + ro + c2a), m1 = *(const float2*)(F.in(I_S5CIM) + ro + 32 + c2a);
                const float v[8] = {r0.x, r1.x, -m0.x, -m1.x, r0.y, r1.y, -m0.y, -m1.y};
                FRL[(4 + ks) * 64 + lane] = __builtin_bit_cast(bf16x8, pack8(v)); }
        }
        __syncthreads();
        const int tau = 16 * ((c >> 2) & 1) + 4 * (c >> 3) + (c & 3);
        float cin[4] = {0.f, 0.f, 0.f, 0.f};
        const int ck0 = qd * NCQ;
#define S5_HEAD() \
                const bf16x8 ucur = unext; \
                if (ck + 1 < ck0 + NCQ) unext = *(const bf16x8*)(U + ((size_t)b * SEQL + pos2s_even(32 * (ck + 1) + tau, d)) * 1024 + 16 * g + 8 * hh); \
                f32x16s t0, t1, t2, t3; \
                _Pragma("unroll") for (int i = 0; i < 16; ++i) { t0[i] = 0.f; t1[i] = 0.f; t2[i] = 0.f; t3[i] = 0.f; } \
                t0 = __builtin_amdgcn_mfma_f32_32x32x16_bf16(ucur, FRL[lane], t0, 0, 0, 0); t1 = __builtin_amdgcn_mfma_f32_32x32x16_bf16(ucur, FRL[64 + lane], t1, 0, 0, 0); \
                t2 = __builtin_amdgcn_mfma_f32_32x32x16_bf16(ucur, FRL[128 + lane], t2, 0, 0, 0); t3 = __builtin_amdgcn_mfma_f32_32x32x16_bf16(ucur, FRL[192 + lane], t3, 0, 0, 0); \
                  \
                { float xr = 0.f, xi = 0.f, yr = 0.f, yi = 0.f; \
                  _Pragma("unroll") for (int i = 0; i < 16; ++i) { const float nr = abr[0] * xr - abi[0] * xi + t0[i], ni = abr[0] * xi + abi[0] * xr + t2[i]; t0[i] = nr; t2[i] = ni; xr = nr; xi = ni; \
                      const float mr = abr[1] * yr - abi[1] * yi + t1[i], mi = abr[1] * yi + abi[1] * yr + t3[i]; t1[i] = mr; t3[i] = mi; yr = mr; yi = mi; } } \
                __builtin_amdgcn_sched_barrier(0); \
                  \
                float ce[4]; \
                { const float l0 = xhalf(t0[15], hh), l2 = xhalf(t2[15], hh), l1 = xhalf(t1[15], hh), l3 = xhalf(t3[15], hh); \
                  const float e0 = l0 + (a16r[0] * cin[0] - a16i[0] * cin[1]), e1 = l2 + (a16r[0] * cin[1] + a16i[0] * cin[0]); \
                  const float e2 = l1 + (a16r[1] * cin[2] - a16i[1] * cin[3]), e3 = l3 + (a16r[1] * cin[3] + a16i[1] * cin[2]); \
                  ce[0] = hh ? e0 : cin[0]; ce[1] = hh ? e1 : cin[1]; ce[2] = hh ? e2 : cin[2]; ce[3] = hh ? e3 : cin[3]; }
        {
            bf16x8 unext = *(const bf16x8*)(U + ((size_t)b * SEQL + pos2s_even(32 * ck0 + tau, d)) * 1024 + 16 * g + 8 * hh);
#pragma unroll 1
            for (int ck = ck0; ck < ck0 + NCQ; ++ck) {
                S5_HEAD()
                const float n0 = t0[15] + (a16r[0] * ce[0] - a16i[0] * ce[1]), n1 = t2[15] + (a16r[0] * ce[1] + a16i[0] * ce[0]);
                const float n2 = t1[15] + (a16r[1] * ce[2] - a16i[1] * ce[3]), n3 = t3[15] + (a16r[1] * ce[3] + a16i[1] * ce[2]);
                const float o0 = xhalf(n0, hh), o1 = xhalf(n1, hh), o2 = xhalf(n2, hh), o3 = xhalf(n3, hh);
                cin[0] = hh ? n0 : o0; cin[1] = hh ? n1 : o1; cin[2] = hh ? n2 : o2; cin[3] = hh ? n3 : o3;
            }
            ES[qd * 64 + lane] = (f32x4){cin[0], cin[1], cin[2], cin[3]};
            __syncthreads();
            float c0 = 0.f, c1 = 0.f, c2 = 0.f, c3 = 0.f;
            for (int k = 0; k < qd; ++k) { const f32x4 e = ES[k * 64 + lane];
                const float n0 = aqr[0] * c0 - aqi[0] * c1 + e.x, n1 = aqr[0] * c1 + aqi[0] * c0 + e.y, n2 = aqr[1] * c2 - aqi[1] * c3 + e.z, n3 = aqr[1] * c3 + aqi[1] * c2 + e.w;
                c0 = n0; c1 = n1; c2 = n2; c3 = n3; }
            cin[0] = c0; cin[1] = c1; cin[2] = c2; cin[3] = c3;
        }
        {
            bf16x8 unext = *(const bf16x8*)(U + ((size_t)b * SEQL + pos2s_even(32 * ck0 + tau, d)) * 1024 + 16 * g + 8 * hh);
            unsigned long long pf0 = 0ull, pf1 = 0ull; u32x2 pu0 = (u32x2){0u, 0u}, pu1 = (u32x2){0u, 0u};
            const f32x4 dv = *(const f32x4*)(dd + 16 * g + 4 * (lane >> 4));
#define S5_PRE(ck_) do { const size_t p0_ = ((size_t)b * SEQL + pos2s_even(32 * (ck_) + (lane & 15), d)) * 1024 + 16 * g + 4 * (lane >> 4), p1_ = ((size_t)b * SEQL + pos2s_even(32 * (ck_) + 16 + (lane & 15), d)) * 1024 + 16 * g + 4 * (lane >> 4); \
                pf0 = __hip_atomic_load((const unsigned long long*)(YS0 + p0_), __ATOMIC_RELAXED, __HIP_MEMORY_SCOPE_AGENT); pf1 = __hip_atomic_load((const unsigned long long*)(YS0 + p1_), __ATOMIC_RELAXED, __HIP_MEMORY_SCOPE_AGENT); \
                pu0 = *(const u32x2*)(U + p0_); pu1 = *(const u32x2*)(U + p1_); } while (0)
            if (d == 1) S5_PRE(ck0);
#pragma unroll 1
            for (int ck = ck0; ck < ck0 + NCQ; ++ck) {
                S5_HEAD()
                const unsigned long long f0 = pf0, f1 = pf1; const u32x2 u0 = pu0, u1 = pu1;
                if (d == 1 && ck + 1 < ck0 + NCQ) S5_PRE(ck + 1);
#pragma unroll
                for (int i = 0; i < 16; ++i) { const f32x4 pw = PWT[i * 64 + lane];
                    t0[i] += pw.x * ce[0] - pw.y * ce[1]; t2[i] += pw.x * ce[1] + pw.y * ce[0]; t1[i] += pw.z * ce[2] - pw.w * ce[3]; t3[i] += pw.z * ce[3] + pw.w * ce[2]; }
                { const float o0 = xhalf(t0[15], hh), o1 = xhalf(t2[15], hh), o2 = xhalf(t1[15], hh), o3 = xhalf(t3[15], hh);
                  cin[0] = hh ? t0[15] : o0; cin[1] = hh ? t2[15] : o1; cin[2] = hh ? t1[15] : o2; cin[3] = hh ? t3[15] : o3; }
                __builtin_amdgcn_sched_barrier(0);
#pragma unroll
                for (int i = 0; i < 16; ++i) { u32x2 w; w.x = pk2(t0[i], t1[i]); w.y = pk2(t2[i], t3[i]); *(LAS u32x2*)(X + (16 * hh + i) * XS + 8 * c) = w; }
                WAVE_SYNC();
                __builtin_amdgcn_sched_barrier(0);
                f32x4 y0 = (f32x4){0.f, 0.f, 0.f, 0.f}, y1 = (f32x4){0.f, 0.f, 0.f, 0.f};
#pragma unroll
                for (int ks = 0; ks < 4; ++ks) { const bf16x8 x0 = *(const LAS bf16x8*)(X + (lane & 15) * XS + 64 * ks + 16 * (lane >> 4)), x1 = *(const LAS bf16x8*)(X + (16 + (lane & 15)) * XS + 64 * ks + 16 * (lane >> 4));
                    const bf16x8 cf = FRL[(4 + ks) * 64 + lane]; y0 = __builtin_amdgcn_mfma_f32_16x16x32_bf16(cf, x0, y0, 0, 0, 0); y1 = __builtin_amdgcn_mfma_f32_16x16x32_bf16(cf, x1, y1, 0, 0, 0); }
                { const size_t o0 = ((size_t)b * SEQL + pos2s_even(32 * ck + (lane & 15), d)) * 1024 + 16 * g + 4 * (lane >> 4), o1 = ((size_t)b * SEQL + pos2s_even(32 * ck + 16 + (lane & 15), d)) * 1024 + 16 * g + 4 * (lane >> 4);
                  if (d == 0) { u32x2 w; w.x = pk2(y0[0], y0[1]); w.y = pk2(y0[2], y0[3]); *(u32x2*)(YS0 + o0) = w;
                      w.x = pk2(y1[0], y1[1]); w.y = pk2(y1[2], y1[3]); *(u32x2*)(YS0 + o1) = w; }
                  else {
                      const unsigned fa0 = (unsigned)f0, fb0 = (unsigned)(f0 >> 32), fa1 = (unsigned)f1, fb1 = (unsigned)(f1 >> 32);
                      u32x2 w;
                      w.x = pk2(gelu_tanh(bf2f(fa0 & 0xffffu) + y0[0] + dv.x * bf2f(u0.x & 0xffffu)), gelu_tanh(bf2f(fa0 >> 16) + y0[1] + dv.y * bf2f(u0.x >> 16)));
                      w.y = pk2(gelu_tanh(bf2f(fb0 & 0xffffu) + y0[2] + dv.z * bf2f(u0.y & 0xffffu)), gelu_tanh(bf2f(fb0 >> 16) + y0[3] + dv.w * bf2f(u0.y >> 16)));
                      *(u32x2*)(U + o0) = w;
                      w.x = pk2(gelu_tanh(bf2f(fa1 & 0xffffu) + y1[0] + dv.x * bf2f(u1.x & 0xffffu)), gelu_tanh(bf2f(fa1 >> 16) + y1[1] + dv.y * bf2f(u1.x >> 16)));
                      w.y = pk2(gelu_tanh(bf2f(fb1 & 0xffffu) + y1[2] + dv.z * bf2f(u1.y & 0xffffu)), gelu_tanh(bf2f(fb1 >> 16) + y1[3] + dv.w * bf2f(u1.y >> 16)));
                      *(u32x2*)(U + o1) = w; } }
                WAVE_SYNC();
            }
        }
#undef S5_HEAD
#undef S5_PRE
      }
    }
    __syncthreads();
}
__device__ __forceinline__ void ph_s5_post(const Ctx& F, int j, bf16* U, const bf16* YS0, const bf16* YS1) {
    const float* dd = F.in(I_S5D) + (size_t)j * 1024;
    const int stride = F.G * NTHR;
    for (int it = F.bid * NTHR + F.tid; it < M * 128; it += 2 * stride) {
        const int it2 = it + stride; const bool has2 = it2 < M * 128;
        const size_t o1 = (size_t)it * 8, o2 = (size_t)(has2 ? it2 : it) * 8; const int c1 = (it & 127) * 8, c2 = ((has2 ? it2 : it) & 127) * 8;
        const u32x4 u1 = *(const u32x4*)(U + o1), a1 = *(const u32x4*)(YS0 + o1), b1 = *(const u32x4*)(YS1 + o1);
        const u32x4 u2 = *(const u32x4*)(U + o2), a2 = *(const u32x4*)(YS0 + o2), b2 = *(const u32x4*)(YS1 + o2);
        { float u[8], a[8], b[8], o[8]; unpack8(u1, u); unpack8(a1, a); unpack8(b1, b);
#pragma unroll
          for (int e = 0; e < 8; ++e) o[e] = gelu_tanh(a[e] + b[e] + dd[c1 + e] * u[e]);
          *(u32x4*)(U + o1) = pack8(o); }
        if (has2) { float u[8], a[8], b[8], o[8]; unpack8(u2, u); unpack8(a2, a); unpack8(b2, b);
#pragma unroll
          for (int e = 0; e < 8; ++e) o[e] = gelu_tanh(a[e] + b[e] + dd[c2 + e] * u[e]);
          *(u32x4*)(U + o2) = pack8(o); }
    }
}
__device__ __forceinline__ void ph_rgscan_a(const Ctx& F, const bf16* OM0, const bf16* OM1, const bf16* BT0, const bf16* BT1, float* RGE, float* RGP, const bf16* OMC) {
    for (int it = F.wave * F.G + F.bid; it < NB * 2 * TPB * 4; it += F.NGW) {
        const int cg = it & 3, k = (it >> 2) % TPB, bd = (it >> 2) / TPB, b = bd >> 1, d = bd & 1, ch = cg * 256 + 4 * F.lane;
        const int r0 = pos2s_even(256 * k, d); const long rs = d ? -1024 : 1024;
        const bf16* OM = (d ? OM1 + ((size_t)b * SEQL + r0) * 1024 : (k == 0 ? OMC + ((size_t)b * 256 + r0) * 1024 : OM0 + ((size_t)b * SEQL + r0) * 1024)) + ch;
        const bf16* BT = (d ? BT1 : BT0) + ((size_t)b * SEQL + r0) * 1024 + ch;
        float h0 = 0.f, h1 = 0.f, h2 = 0.f, h3 = 0.f, p0 = 1.f, p1 = 1.f, p2 = 1.f, p3 = 1.f;
        u32x2 ow[16], bw[16], on[16], bn[16];
#pragma unroll
        for (int e = 0; e < 16; ++e) { ow[e] = *(const u32x2*)(OM + e * rs); bw[e] = *(const u32x2*)(BT + e * rs); }
#pragma unroll 1
        for (int t = 0; t < 256; t += 16) {
            const int tn = t + 16 < 256 ? t + 16 : t;
#pragma unroll
            for (int e = 0; e < 16; ++e) { on[e] = *(const u32x2*)(OM + (tn + e) * rs); bn[e] = *(const u32x2*)(BT + (tn + e) * rs); }
#pragma unroll
            for (int e = 0; e < 16; ++e) {
                const float a0 = 1.f - bf2f(ow[e].x & 0xffffu), a1 = 1.f - bf2f(ow[e].x >> 16), a2 = 1.f - bf2f(ow[e].y & 0xffffu), a3 = 1.f - bf2f(ow[e].y >> 16);
                h0 = a0 * h0 + bf2f(bw[e].x & 0xffffu); p0 *= a0; h1 = a1 * h1 + bf2f(bw[e].x >> 16); p1 *= a1;
                h2 = a2 * h2 + bf2f(bw[e].y & 0xffffu); p2 *= a2; h3 = a3 * h3 + bf2f(bw[e].y >> 16); p3 *= a3; }
#pragma unroll
            for (int e = 0; e < 16; ++e) { ow[e] = on[e]; bw[e] = bn[e]; }
        }
        const size_t o = ((size_t)bd * TPB + k) * 1024 + ch;
        *(f32x4*)(RGE + o) = (f32x4){h0, h1, h2, h3}; *(f32x4*)(RGP + o) = (f32x4){p0, p1, p2, p3};
    }
}
__device__ __forceinline__ void rg_carry(const float* RGE, const float* RGP, const size_t o, const int nk, float& h0, float& h1) {
    h0 = 0.f; h1 = 0.f;
#pragma unroll 1
    for (int k0 = 0; k0 < nk; k0 += 8) {
        float2 e[8], p[8];
#pragma unroll
        for (int i = 0; i < 8; ++i) { const int kk = k0 + i < nk ? k0 + i : nk - 1; e[i] = *(const float2*)(RGE + o + (size_t)kk * 1024); p[i] = *(const float2*)(RGP + o + (size_t)kk * 1024); }
#pragma unroll
        for (int i = 0; i < 8; ++i) if (k0 + i < nk) { h0 = p[i].x * h0 + e[i].x; h1 = p[i].y * h1 + e[i].y; }
    }
}
__device__ __forceinline__ void ph_rgscan_c(const Ctx& F, const bf16* OM0, const bf16* OM1, bf16* BT0, const bf16* BT1, const float* RGE, const float* RGP, bf16* Y, const bf16* OMC) {
    for (int it = F.wave * F.G + F.bid; it < NB * TPB * 8; it += F.NGW) {
        const int cg = it & 7, ti = (it >> 3) % TPB, b = (it >> 3) / TPB, ch = cg * 128 + 2 * F.lane;
        const size_t rb = (size_t)b * SEQL + 256 * ti;
        float h0, h1;
        rg_carry(RGE, RGP, ((size_t)(b * 2 + 0) * TPB) * 1024 + ch, ti, h0, h1);
        {
            const bf16* OM = (ti == 0 ? OMC + (size_t)b * 256 * 1024 : OM0 + rb * 1024) + ch; bf16* BT = BT0 + rb * 1024 + ch;
            unsigned ow[16], bw[16], on[16], bn[16];
#pragma unroll
            for (int e = 0; e < 16; ++e) { ow[e] = *(const unsigned*)(OM + (size_t)e * 1024); bw[e] = *(const unsigned*)(BT + (size_t)e * 1024); }
#pragma unroll 1
            for (int t = 0; t < 256; t += 16) {
                const int tn = t + 16 < 256 ? t + 16 : t;
#pragma unroll
                for (int e = 0; e < 16; ++e) { on[e] = *(const unsigned*)(OM + (size_t)(tn + e) * 1024); bn[e] = *(const unsigned*)(BT + (size_t)(tn + e) * 1024); }
#pragma unroll
                for (int e = 0; e < 16; ++e) {
                    h0 = (1.f - bf2f(ow[e] & 0xffffu)) * h0 + bf2f(bw[e] & 0xffffu); h1 = (1.f - bf2f(ow[e] >> 16)) * h1 + bf2f(bw[e] >> 16);
                    *(unsigned*)(BT + (size_t)(t + e) * 1024) = pk2(h0, h1); }
#pragma unroll
                for (int e = 0; e < 16; ++e) { ow[e] = on[e]; bw[e] = bn[e]; }
            }
        }
        const int kb = ti == 0 ? 0 : TPB - ti;
        rg_carry(RGE, RGP, ((size_t)(b * 2 + 1) * TPB) * 1024 + ch, kb, h0, h1);
        {
            const bf16* OM = OM1 + (rb + 255) * 1024 + ch; const bf16* BT = BT1 + (rb + 255) * 1024 + ch; const bf16* HF = BT0 + (rb + 255) * 1024 + ch; bf16* YR = Y + (rb + 255) * 2048 + 1024 + ch;
            unsigned ow[16], bw[16], hw[16], gw_[16], on[16], bn[16], hn[16], gn[16];
#define RGC_LD(t_, O, B, H, G) _Pragma("unroll") for (int e = 0; e < 16; ++e) { const long ro_ = -(long)((t_) + e); O[e] = *(const unsigned*)(OM + ro_ * 1024); B[e] = *(const unsigned*)(BT + ro_ * 1024); \
                H[e] = __hip_atomic_load((const unsigned*)(HF + ro_ * 1024), __ATOMIC_RELAXED, __HIP_MEMORY_SCOPE_AGENT); G[e] = *(const unsigned*)(YR + ro_ * 2048); }
            RGC_LD(0, ow, bw, hw, gw_)
#pragma unroll 1
            for (int t = 0; t < 256; t += 16) {
                const int tn = t + 16 < 256 ? t + 16 : t;
                RGC_LD(tn, on, bn, hn, gn)
#pragma unroll
                for (int e = 0; e < 16; ++e) {
                    h0 = (1.f - bf2f(ow[e] & 0xffffu)) * h0 + bf2f(bw[e] & 0xffffu); h1 = (1.f - bf2f(ow[e] >> 16)) * h1 + bf2f(bw[e] >> 16);
                    const float o0 = (bf2f(hw[e] & 0xffffu) + h0) * silu(bf2f(gw_[e] & 0xffffu)), o1 = (bf2f(hw[e] >> 16) + h1) * silu(bf2f(gw_[e] >> 16));
                    *(unsigned*)(YR - (long)(t + e) * 2048) = pk2(o0, o1); }
#pragma unroll
                for (int e = 0; e < 16; ++e) { ow[e] = on[e]; bw[e] = bn[e]; hw[e] = hn[e]; gw_[e] = gn[e]; }
            }
#undef RGC_LD
        }
    }
}

typedef __bf16 v2bf __attribute__((ext_vector_type(2)));
__device__ __forceinline__ float dot2bf(const unsigned a, const unsigned b, const float c) { return __builtin_amdgcn_fdot2_f32_bf16(__builtin_bit_cast(v2bf, a), __builtin_bit_cast(v2bf, b), c, false); }
__device__ __forceinline__ void ph_convq(const Ctx& F, int j, int hb, const bf16* XM, bf16* XCV, bf16* QP) {
    constexpr int NT = MH / 16, NTX = NT / 8;
    const bool xmap = (F.G & 7) == 0;
    const int xq = F.bid & 7, cu = F.bid >> 3, cpx = F.G >> 3;
    int ntile = xmap ? (NTX - cu + cpx - 1) / cpx : (NT - F.bid + F.G - 1) / F.G; ntile = ntile < 0 ? 0 : ntile;
#define CQ_TILE(slot_) (xmap ? 4 * (cu + cpx * (slot_) + NTX * (xq >> 2)) + (xq & 3) : F.bid + F.G * (slot_))
    const float* cw = F.in(I_MLCW) + (size_t)j * 4 * 2048; const float* cb = F.in(I_MLCB) + (size_t)j * 2048;
    const float* mg = (const float*)(F.ws + WS_MG);
    const float* bif = F.in(I_MLBIF) + (size_t)j * 16;
    float* gate = (float*)(F.ws + WS_GATE);
    const int nrows = 2 * ntile;
    {
        LAS f32x4* const WQ = (LAS f32x4*)F.lds;
        for (int i = F.tid; i < 4 * 18 * 64; i += NTHR) { const int ln = i & 63, q = (i >> 6) % 18, k = i / (18 * 64), c = 8 * ln + 512 * k;
            const float* src = q < 8 ? cw + (q >> 1) * 2048 + c + 4 * (q & 1) : (q < 10 ? cb + c + 4 * (q - 8) : mg + (size_t)((c >> 2) + ((q - 10) >> 2)) * 16 + 4 * ((q - 10) & 3));
            WQ[i] = *(const f32x4*)src; }
        __syncthreads();
        u32x4 cur[4][4]; float ma[4], mn[4]; int nrw[4];
#define CQ_NEXT(n_) do { const int nn_ = (n_); const int rl_ = CQ_TILE(nn_ >> 1) * 16 + 2 * F.wave + (nn_ & 1); const int r_ = hb * MH + rl_, b_ = r_ / SEQL, s2_ = r_ - b_ * SEQL; \
            _Pragma("unroll") for (int t = 0; t < 4; ++t) { const int sn = nb_odd(s2_, t - 1); const bool ok = sn >= 0; nrw[t] = ok ? (b_ * SEQL + sn - hb * MH) : rl_; mn[t] = ok ? 1.f : 0.f; } } while (0)
        if (nrows > 0) { CQ_NEXT(0);
#pragma unroll
            for (int k = 0; k < 4; ++k)
#pragma unroll
                for (int t = 0; t < 4; ++t) cur[k][t] = *(const u32x4*)(XM + (size_t)nrw[t] * 2048 + 8 * F.lane + 512 * k); }
#pragma unroll 1
        for (int n = 0; n < nrows; ++n) {
#pragma unroll
            for (int t = 0; t < 4; ++t) ma[t] = mn[t];
            const int rl = CQ_TILE(n >> 1) * 16 + 2 * F.wave + (n & 1);
            CQ_NEXT(n + 1 < nrows ? n + 1 : n);
#pragma unroll
            for (int k = 0; k < 4; ++k) {
                const int c = 8 * F.lane + 512 * k;
                const LAS f32x4* wl = WQ + (k * 18) * 64 + F.lane;
                float a[8];
                { const f32x4 b0 = wl[8 * 64], b1 = wl[9 * 64]; a[0] = b0.x; a[1] = b0.y; a[2] = b0.z; a[3] = b0.w; a[4] = b1.x; a[5] = b1.y; a[6] = b1.z; a[7] = b1.w; }
#pragma unroll
                for (int t = 0; t < 4; ++t) { float x[8]; unpack8(cur[k][t], x); const f32x4 w0 = wl[(2 * t) * 64], w1 = wl[(2 * t + 1) * 64];
                    a[0] += w0.x * (ma[t] * x[0]); a[1] += w0.y * (ma[t] * x[1]); a[2] += w0.z * (ma[t] * x[2]); a[3] += w0.w * (ma[t] * x[3]);
                    a[4] += w1.x * (ma[t] * x[4]); a[5] += w1.y * (ma[t] * x[5]); a[6] += w1.z * (ma[t] * x[6]); a[7] += w1.w * (ma[t] * x[7]); }
#pragma unroll
                for (int e = 0; e < 8; ++e) a[e] = silu(a[e]);
                *(u32x4*)(XCV + (size_t)rl * 2048 + c) = pack8(a);
                float qv[8];
#pragma unroll
                for (int blk = 0; blk < 2; ++blk) { const f32x4 m0 = wl[(10 + blk * 4 + 0) * 64], m1 = wl[(10 + blk * 4 + 1) * 64], m2 = wl[(10 + blk * 4 + 2) * 64], m3 = wl[(10 + blk * 4 + 3) * 64];
#pragma unroll
                    for (int jj = 0; jj < 4; ++jj) qv[blk * 4 + jj] = a[blk * 4 + 0] * m0[jj] + a[blk * 4 + 1] * m1[jj] + a[blk * 4 + 2] * m2[jj] + a[blk * 4 + 3] * m3[jj]; }
                { const int half = (c >> 3) & 1; bf16* qb = QP + (size_t)rl * 2048 + (c & ~15) + 4 * half;
                  u32x2 w0, w1; w0.x = pk2(qv[0], qv[1]); w0.y = pk2(qv[2], qv[3]); w1.x = pk2(qv[4], qv[5]); w1.y = pk2(qv[6], qv[7]);
                  *(u32x2*)qb = w0; *(u32x2*)(qb + 8) = w1; }
#pragma unroll
                for (int t = 0; t < 4; ++t) cur[k][t] = *(const u32x4*)(XM + (size_t)nrw[t] * 2048 + c);
                __builtin_amdgcn_sched_barrier(0);
            }
        }
#undef CQ_NEXT
    }
    __builtin_amdgcn_fence(__ATOMIC_RELEASE, "workgroup");
    asm volatile("s_waitcnt vmcnt(0)" ::: "memory");
    __syncthreads();
    __builtin_amdgcn_fence(__ATOMIC_ACQUIRE, "workgroup");
    {
        const int w = F.wave; const bf16* SRC = (w >> 2) ? XM : XCV;
        const u32x4* tb = (const u32x4*)(F.ws + WS_WGT) + (size_t)(w * 16) * 64 + F.lane;
        bf16x8 bfr[16];
#pragma unroll
        for (int st = 0; st < 16; ++st) bfr[st] = __builtin_bit_cast(bf16x8, tb[st * 64]);
        const bf16* cbase = SRC + (size_t)(F.lane & 15) * 2048 + (w & 3) * 512 + (F.lane >> 4) * 32;
        LAS f32x4* part = (LAS f32x4*)F.lds;
        bf16x8 cur[16], nxt[16];
#define CQ_LOADT(slot_, AV) do { const bf16* rp_ = cbase + (size_t)CQ_TILE(slot_) * 16 * 2048; \
            _Pragma("unroll") for (int st = 0; st < 16; ++st) AV[st] = *(const bf16x8*)(rp_ + (st >> 2) * 128 + (st & 3) * 8); } while (0)
        if (ntile > 0) CQ_LOADT(0, cur);
#pragma unroll 1
        for (int slot = 0; slot < ntile; ++slot) {
            { const int sn = slot + 1 < ntile ? slot + 1 : ntile - 1; CQ_LOADT(sn, nxt); }
            f32x4 acc = (f32x4){0.f, 0.f, 0.f, 0.f};
#pragma unroll
            for (int st = 0; st < 16; ++st) acc = __builtin_amdgcn_mfma_f32_16x16x32_bf16(cur[st], bfr[st], acc, 0, 0, 0);
            part[(slot * 8 + w) * 64 + F.lane] = acc;
#pragma unroll
            for (int st = 0; st < 16; ++st) cur[st] = nxt[st];
        }
#undef CQ_LOADT
        __syncthreads();
        for (int idx = F.tid; idx < ntile * 256; idx += NTHR) { const int slot = idx >> 8, o = idx & 255, ln = o & 63, i = o >> 6;
            float v = 0.f;
#pragma unroll
            for (int ww = 0; ww < 8; ++ww) v += ((const LAS float*)part)[((slot * 8 + ww) * 64 + ln) * 4 + i];
            const int n = ln & 15, m = 4 * (ln >> 4) + i, r = hb * MH + CQ_TILE(slot) * 16 + m, d = n >> 3, n8 = n & 7;
            v += bif[n];
            gate[((size_t)d * M + r) * 8 + n8] = n8 >= 4 ? logsigmoid(v) : v; }
    }
#undef CQ_TILE
    __syncthreads();
}

__device__ __forceinline__ void odd_chunk_rows(const int ck, const int d, int& rb, int& rs) {
    if (ck < LCTX / 64) { rb = d == 0 ? ck * 64 : LCTX - 1 - ck * 64; rs = d == 0 ? 1 : -1; }
    else { const int q0 = ck * 64 - LCTX, lo = q0 & 127, hi = q0 >> 7;
        if (d == 0) { rb = LCTX + lo * 64 + hi; rs = 64; } else { rb = LCTX + (127 - lo) * 64 + 63 - hi; rs = -64; } }
}
__device__ __forceinline__ void ph_mscan(const Ctx& F, int hb) {
    if (F.bid >= 16) return;
    const int sq = F.bid, b = hb * 2 + (sq >> 3), n = (sq >> 1) & 3, d = sq & 1;
    const float* gate = (const float*)(F.ws + WS_GATE) + (size_t)d * M * 8;
    LAS float* be = (LAS float*)F.lds; LAS float* um = be + 192; LAS float* ms = um + 192;
    const int ck = F.tid; const bool act = ck < NCH;
    float li[64], lf[64];
    if (act) {
        int rb, rs; odd_chunk_rows(ck, d, rb, rs);
        const float* gp = gate + ((size_t)b * SEQL + rb) * 8 + n; const long gs = (long)rs * 8;
#pragma unroll
        for (int e = 0; e < 64; ++e) { li[e] = gp[e * gs]; lf[e] = gp[e * gs + 4]; }
        float bs = 0.f, umax = -3.0e38f;
#pragma unroll
        for (int e = 0; e < 64; ++e) { bs += lf[e]; umax = fmaxf(umax, li[e] - bs); }
        be[ck] = bs; um[ck] = umax;
    }
    __syncthreads();
    if (F.tid == 0) { float m = 0.f;
#pragma unroll
        for (int c4 = 0; c4 < NCH; c4 += 4) { const f32x4 b4 = *(const LAS f32x4*)(be + c4), u4 = *(const LAS f32x4*)(um + c4); f32x4 m4;
            m4.x = m; m = b4.x + fmaxf(m, u4.x); m4.y = m; m = b4.y + fmaxf(m, u4.y); m4.z = m; m = b4.z + fmaxf(m, u4.z); m4.w = m; m = b4.w + fmaxf(m, u4.w);
            *(LAS f32x4*)(ms + c4) = m4; } }
    __syncthreads();
    if (act) {
        float* ps = (float*)(F.ws + WS_PS) + (size_t)sq * SEQL * 4; float* pc = (float*)(F.ws + WS_PC) + (size_t)sq * NCH * 4;
        const float m = ms[ck]; float bs = 0.f, cm = m, mt = 0.f;
#pragma unroll
        for (int e = 0; e < 64; ++e) { bs += lf[e]; const float u = li[e] - bs; cm = fmaxf(cm, u); mt = bs + cm;
            *(f32x4*)(ps + (size_t)(ck * 64 + e) * 4) = (f32x4){bs - mt, u, __expf(m - cm), mt}; }
        *(f32x4*)(pc + (size_t)ck * 4) = (f32x4){bs, mt, __expf(bs + m - mt), m};
    }
    __syncthreads();
}

__device__ __forceinline__ void ph_stilde(const Ctx& F, int hb, const bf16* QP, const bf16* XCV) {
    constexpr int LDR = 520;
    LAS bf16* ql = (LAS bf16*)F.lds; LAS bf16* kl = ql + 64 * LDR;
    LAS float* red = (LAS float*)(kl + 64 * LDR);
    LAS float* rsum = red + 4 * 16 * 64;
    LAS float* cwl = rsum + 128;
    bf16* DN = (bf16*)(F.ws + WS_DN);
    const float* PC = (const float*)(F.ws + WS_PC);
    bf16* ST = (bf16*)(F.ws + WS_ST); float* DS = (float*)(F.ws + WS_DS); const float* PS = (const float*)(F.ws + WS_PS);
    const int lane = F.lane, w = F.wave, r = lane & 31, h = lane >> 5;
    const int tile = w & 3, st = tile & 1, tt = tile >> 1, kh = w >> 2;
    u32x4 qg[8], kg[8]; float pc0n = 0.f, pc1n = 0.f, psn = 0.f;
#define ST_SQ(it_) ((((it_) >> 2) & 1) * 8 + ((it_) & 3) * 2 + (((it_) >> 3) & 1))
#define ST_CK(it_) (((((it_) >> 3) & 1) == 0) ? ((it_) >> 4) : (((it_) >> 4) < LCTX / 64 ? LCTX / 64 - 1 - ((it_) >> 4) : NCH + LCTX / 64 - 1 - ((it_) >> 4)))
#define ST_LOAD(it_) do { const int sq_ = ST_SQ(it_), ck_ = ST_CK(it_); int rb_, rs_; odd_chunk_rows(ck_, sq_ & 1, rb_, rs_); \
        const size_t o_ = (size_t)((sq_ >> 3) * SEQL + rb_ + w * rs_) * 2048 + ((sq_ >> 1) & 3) * 512 + 8 * lane; const long st_ = (long)rs_ * (8 * 2048); \
        _Pragma("unroll") for (int k_ = 0; k_ < 8; ++k_) { qg[k_] = *(const u32x4*)(QP + o_ + k_ * st_); kg[k_] = *(const u32x4*)(XCV + o_ + k_ * st_); } \
        if (w == 0) { const float* pcq_ = PC + ((size_t)sq_ * NCH + ck_) * 4; pc0n = pcq_[0]; pc1n = pcq_[1]; psn = PS[((size_t)sq_ * SEQL + ck_ * 64 + lane) * 4 + 1]; } } while (0)
    if (F.bid < 16 * NCH) ST_LOAD(F.bid);
    for (int it = F.bid; it < 16 * NCH; it += F.G) {
        const int sq = ST_SQ(it), ck = ST_CK(it);
        __syncthreads();
        { const int c8 = 8 * lane, hq = (c8 >> 3) & 1, g16 = c8 & ~15;
#pragma unroll
          for (int k_ = 0; k_ < 8; ++k_) { const int t = w + 8 * k_; u32x2 lo, hi; lo.x = qg[k_].x; lo.y = qg[k_].y; hi.x = qg[k_].z; hi.y = qg[k_].w;
              *(LAS u32x2*)(ql + t * LDR + g16 + 4 * hq) = lo; *(LAS u32x2*)(ql + t * LDR + g16 + 8 + 4 * hq) = hi;
              *(LAS u32x4*)(kl + t * LDR + c8) = kg[k_]; } }
        if (w == 0) cwl[lane] = __expf(pc0n + psn - pc1n);
        __syncthreads();
        const float* psq = PS + ((size_t)sq * SEQL + ck * 64) * 4;
        const int t = 32 * tt + r; const float am = psq[t * 4 + 0];
        float us[16];
#pragma unroll
        for (int j = 0; j < 16; ++j) us[j] = psq[(32 * st + 8 * (j >> 2) + 4 * h + (j & 3)) * 4 + 1];
        if (it + F.G < 16 * NCH) ST_LOAD(it + F.G);
        f32x16s acc;
#pragma unroll
        for (int j = 0; j < 16; ++j) acc[j] = 0.f;
        { const LAS bf16* ka = kl + (32 * st + r) * LDR + 256 * kh + 8 * h; const LAS bf16* qb = ql + (32 * tt + r) * LDR + 256 * kh + 8 * h;
#pragma unroll
          for (int ks = 0; ks < 16; ++ks) acc = __builtin_amdgcn_mfma_f32_32x32x16_bf16(*(const LAS bf16x8*)(ka + 16 * ks), *(const LAS bf16x8*)(qb + 16 * ks), acc, 0, 0, 0); }
        if (kh == 1) {
#pragma unroll
            for (int j = 0; j < 16; ++j) red[(tile * 16 + j) * 64 + lane] = acc[j]; }
        __syncthreads();
        if (kh == 0) {
            float rs = 0.f;
#pragma unroll
            for (int q4 = 0; q4 < 4; ++q4) { float o[4];
#pragma unroll
                for (int i = 0; i < 4; ++i) { const int j = 4 * q4 + i, s_ = 32 * st + 8 * q4 + 4 * h + i; const float v = acc[j] + red[(tile * 16 + j) * 64 + lane];
                    o[i] = s_ <= t ? v * __expf(am + us[j]) : 0.f; rs += o[i]; }
                u32x2 ow; ow.x = pk2(o[0], o[1]); ow.y = pk2(o[2], o[3]);
                *(u32x2*)(ST + ((size_t)(sq * NCH + ck) * 64 + t) * 64 + 32 * st + 8 * q4 + 4 * h) = ow; }
            rs += xhalf(rs, h);
            if (h == 0) rsum[st * 64 + t] = rs;
        } else {
            const int d2 = 2 * (F.tid - 256); float dn0 = 0.f, dn1 = 0.f;
#pragma unroll 4
            for (int s4 = 0; s4 < 64; s4 += 4) { const f32x4 c4 = *(const LAS f32x4*)(cwl + s4);
#pragma unroll
                for (int i = 0; i < 4; ++i) { const unsigned kk = *(const LAS unsigned*)(kl + (s4 + i) * LDR + d2); dn0 += c4[i] * bf2f(kk & 0xffffu); dn1 += c4[i] * bf2f(kk >> 16); } }
            *(unsigned*)(DN + ((size_t)sq * NCH + ck) * 512 + d2) = pk2(dn0, dn1); }
        __syncthreads();
        if (F.tid < 64) DS[(size_t)sq * SEQL + ck * 64 + F.tid] = rsum[F.tid] + rsum[64 + F.tid];
    }
#undef ST_LOAD
#undef ST_SQ
#undef ST_CK
    __syncthreads();
}

typedef float f32x16 __attribute__((ext_vector_type(16)));
__device__ __forceinline__ bf16x8 pack_bf16x8(const f32x16& c, const int o) {
    u32x4 w; w.x = pg8::cvt_pk_bf16(c[o], c[o + 1]); w.y = pg8::cvt_pk_bf16(c[o + 2], c[o + 3]); w.z = pg8::cvt_pk_bf16(c[o + 4], c[o + 5]); w.w = pg8::cvt_pk_bf16(c[o + 6], c[o + 7]);
    return __builtin_bit_cast(bf16x8, w);
}
__device__ __forceinline__ void ph_mlstm_r(const Ctx& F, int hb, const bf16* QP, const bf16* XCV, const bf16* XM, bf16* HM0, int ld0, bf16* HM1, int ld1) {
    constexpr int RV = 128, RS = 144;
    LAS unsigned char* const VT = F.lds;
    LAS unsigned char* const VW = VT + 32 * RV;
    LAS unsigned char* const SB = VW + 32 * RV;
    LAS float* const QNP = (LAS float*)(SB + 64 * RS);
    LAS float* const SCL = QNP + 64 * 16;
    LAS unsigned* const NSB = (LAS unsigned*)(SCL + 384);
    LAS unsigned char* const KR = (LAS unsigned char*)(NSB + 256);
    LAS float* const PART = (LAS float*)(KR + 8 * 8192);
    const bf16* ST = (const bf16*)(F.ws + WS_ST); const float* DS = (const float*)(F.ws + WS_DS); const float* PS = (const float*)(F.ws + WS_PS); const float* PC = (const float*)(F.ws + WS_PC);
    const bf16* DN = (const bf16*)(F.ws + WS_DN);
    const int tid = F.tid, lane = F.lane, w = F.wave, r = lane & 31, h = lane >> 5;
#define R_BAR() do { asm volatile("s_waitcnt lgkmcnt(0)" ::: "memory"); __builtin_amdgcn_s_barrier(); asm volatile("" ::: "memory"); } while (0)
    for (int it0 = F.bid; it0 < 256; it0 += F.G) {
        const int it = (F.G == 256) ? (((it0 & 7) * 2 + ((it0 >> 3) >> 4)) * 16 + ((it0 >> 3) & 15)) : it0;
        const int sq = it >> 4, eb = it & 15, bh = sq >> 3, n = (sq >> 1) & 3, d = sq & 1;
        bf16* HM = d ? HM1 : HM0; const int ldh = d ? ld1 : ld0;
        const int colv = n * 512 + eb * 32;
        f32x16 C0, C1;
#pragma unroll
        for (int j = 0; j < 16; ++j) { C0[j] = 0.f; C1[j] = 0.f; }
        float nreg = 0.f, dec_cur = 0.f;
        u32x4 kreg[8]; u32x2 vreg; u32x4 sreg; bf16x8 Qf[8]; f32x4 pvn, pcn; float dsn, dnv;
        int rbn, rsn, rowtn, rbk, rsk;
#define R_PREFETCH_K(ck_) do { const bf16* kb_ = XCV + (size_t)(bh * SEQL + rbk + (lane >> 3) * rsk) * 2048 + n * 512 + 64 * w + 8 * (lane & 7); const long ks_ = (long)rsk * (8 * 2048); \
            _Pragma("unroll") for (int k_ = 0; k_ < 8; ++k_) kreg[k_] = *(const u32x4*)(kb_ + k_ * ks_); } while (0)
#define R_KWRITE() do { LAS unsigned char* kp0_ = KR + w * 8192 + (lane >> 3) * 128 + (((lane & 7) ^ (((lane >> 4) & 1) << 2)) * 16); asm volatile("" : "+v"(kp0_)); \
            _Pragma("unroll") for (int k_ = 0; k_ < 8; ++k_) *(LAS u32x4*)(kp0_ + k_ * 1024) = kreg[k_]; } while (0)
#define R_PREFETCH_VS(ck_) do { const int p0_ = (ck_) * 64; rowtn = bh * SEQL + rbn + (tid >> 3) * rsn; \
            const size_t rv_ = (size_t)rowtn * 2048; vreg = *(const u32x2*)(XM + rv_ + colv + (tid & 7) * 4); \
            sreg = *(const u32x4*)(ST + ((size_t)(sq * NCH + (ck_))) * 4096 + (size_t)tid * 8); \
            pvn = *(const f32x4*)(PS + ((size_t)sq * SEQL + p0_ + (tid >> 3)) * 4); dsn = DS[(size_t)sq * SEQL + p0_ + (tid >> 3)]; dnv = bf2f(DN[((size_t)sq * NCH + (ck_)) * 512 + tid]); pcn = *(const f32x4*)(PC + ((size_t)sq * NCH + (ck_)) * 4); } while (0)
#define R_PREFETCH_Q(ck_) do { \
            _Pragma("unroll") for (int tt_ = 0; tt_ < 2; ++tt_) { const bf16* qr_ = QP + (size_t)(bh * SEQL + rbn + (32 * tt_ + r) * rsn) * 2048 + n * 512 + 64 * w + 8 * h; \
                _Pragma("unroll") for (int i_ = 0; i_ < 2; ++i_) _Pragma("unroll") for (int s_ = 0; s_ < 2; ++s_) Qf[(tt_ * 2 + i_) * 2 + s_] = *(const bf16x8*)(qr_ + 32 * i_ + 16 * s_); } } while (0)
#define R_STAGE(ck_) do { const f32x4 pc_ = pcn; asm volatile("" :: "v"(pc_.w), "v"(pvn.x));     \
            ((LAS bf16*)NSB)[tid] = (bf16)f2bf(nreg); nreg = pc_.z * nreg + dnv; dec_cur = pc_.z; \
            const int s_ = tid >> 3, e4_ = (tid & 7) * 4; const float cw_ = __expf(pc_.x + pvn.y - pc_.y); \
            if ((tid & 7) == 0) { LAS float* sc_ = SCL + ((ck_) & 1) * 192; sc_[s_] = pvn.z; sc_[64 + s_] = __expf(-pvn.w); sc_[128 + s_] = dsn; } \
            *(LAS u32x4*)(SB + s_ * RS + (tid & 7) * 16) = sreg; \
            const float v0_ = bf2f(vreg.x & 0xffffu), v1_ = bf2f(vreg.x >> 16), v2_ = bf2f(vreg.y & 0xffffu), v3_ = bf2f(vreg.y >> 16); (void)e4_; \
            *(LAS u32x2*)(VT + s_ * 64 + (tid & 7) * 8) = vreg; \
            { u32x2 wv_; wv_.x = pk2(cw_ * v0_, cw_ * v1_); wv_.y = pk2(cw_ * v2_, cw_ * v3_); *(LAS u32x2*)(VW + s_ * 64 + (tid & 7) * 8) = wv_; } } while (0)
        odd_chunk_rows(0, d, rbn, rsn); rbk = rbn; rsk = rsn;
        R_PREFETCH_K(0); R_PREFETCH_VS(0); R_PREFETCH_Q(0);
        __syncthreads();
        R_KWRITE(); odd_chunk_rows(1, d, rbk, rsk); R_PREFETCH_K(1);
        R_STAGE(0);
        for (int ck = 0; ck < NCH; ++ck) {
            const float decay = dec_cur;
            int vlo = (8 * h + ((lane & 15) >> 2)) * 64 + (16 * ((lane >> 4) & 1) + 4 * (lane & 3)) * 2; asm volatile("" : "+v"(vlo));
            const int rowt = rowtn;
            const LAS float* const scl = SCL + (ck & 1) * 192;
            if (ck + 1 < NCH) odd_chunk_rows(ck + 1, d, rbn, rsn);
            if (ck + 2 < NCH) odd_chunk_rows(ck + 2, d, rbk, rsk);
            R_BAR();
            s16x4 kf[16];
            {
                const int swz = (lane >> 3) & 1;
                const LAS unsigned char* krb = KR + w * 8192 + (8 * h + ((lane & 15) >> 2)) * 128 + (8 * swz + 4 * ((lane >> 4) & 1) + (lane & 3)) * 8;
                const LAS unsigned char* krc = krb + 64 - 128 * swz; asm volatile("" : "+v"(krb), "+v"(krc));
#pragma unroll
                for (int ks = 0; ks < 4; ++ks) {
                    kf[4 * ks + 0] = __builtin_amdgcn_ds_read_tr16_b64_v4i16((LAS s16x4*)(krb + (16 * ks) * 128)); kf[4 * ks + 1] = __builtin_amdgcn_ds_read_tr16_b64_v4i16((LAS s16x4*)(krb + (16 * ks + 4) * 128));
                    kf[4 * ks + 2] = __builtin_amdgcn_ds_read_tr16_b64_v4i16((LAS s16x4*)(krc + (16 * ks) * 128)); kf[4 * ks + 3] = __builtin_amdgcn_ds_read_tr16_b64_v4i16((LAS s16x4*)(krc + (16 * ks + 4) * 128)); }
            }
            __builtin_amdgcn_sched_barrier(0);
            if (ck + 1 < NCH) R_KWRITE();
            __builtin_amdgcn_sched_barrier(0);
            f32x16 P0, P1;
#pragma unroll
            for (int j = 0; j < 16; ++j) { P0[j] = 0.f; P1[j] = 0.f; }
            { const bf16x8 c00 = pack_bf16x8(C0, 0), c01 = pack_bf16x8(C0, 8), c10 = pack_bf16x8(C1, 0), c11 = pack_bf16x8(C1, 8);
              P0 = __builtin_amdgcn_mfma_f32_32x32x16_bf16(Qf[0], c00, P0, 0, 0, 0); P1 = __builtin_amdgcn_mfma_f32_32x32x16_bf16(Qf[4], c00, P1, 0, 0, 0);
              P0 = __builtin_amdgcn_mfma_f32_32x32x16_bf16(Qf[1], c01, P0, 0, 0, 0); P1 = __builtin_amdgcn_mfma_f32_32x32x16_bf16(Qf[5], c01, P1, 0, 0, 0);
              P0 = __builtin_amdgcn_mfma_f32_32x32x16_bf16(Qf[2], c10, P0, 0, 0, 0); P1 = __builtin_amdgcn_mfma_f32_32x32x16_bf16(Qf[6], c10, P1, 0, 0, 0);
              P0 = __builtin_amdgcn_mfma_f32_32x32x16_bf16(Qf[3], c11, P0, 0, 0, 0); P1 = __builtin_amdgcn_mfma_f32_32x32x16_bf16(Qf[7], c11, P1, 0, 0, 0); }
            __builtin_amdgcn_sched_barrier(0);
            {
                const LAS unsigned char* vwb = VT + vlo + 32 * RV;
#pragma unroll
                for (int j = 0; j < 16; ++j) { C0[j] *= decay; C1[j] *= decay; }
#pragma unroll
                for (int kh = 0; kh < 2; ++kh) {
                    bf16x8 vw2[2];
#pragma unroll
                    for (int k2 = 0; k2 < 2; ++k2) { const int ks = 2 * kh + k2;
                        const s16x4 f0 = __builtin_amdgcn_ds_read_tr16_b64_v4i16((LAS s16x4*)(vwb + (16 * ks) * 64)), f1 = __builtin_amdgcn_ds_read_tr16_b64_v4i16((LAS s16x4*)(vwb + (16 * ks + 4) * 64));
                        vw2[k2] = (bf16x8){f0.x, f0.y, f0.z, f0.w, f1.x, f1.y, f1.z, f1.w}; }
#pragma unroll
                    for (int k2 = 0; k2 < 2; ++k2) { const int ks = 2 * kh + k2;
                        const bf16x8 ka0 = (bf16x8){kf[4 * ks].x, kf[4 * ks].y, kf[4 * ks].z, kf[4 * ks].w, kf[4 * ks + 1].x, kf[4 * ks + 1].y, kf[4 * ks + 1].z, kf[4 * ks + 1].w};
                        const bf16x8 ka1 = (bf16x8){kf[4 * ks + 2].x, kf[4 * ks + 2].y, kf[4 * ks + 2].z, kf[4 * ks + 2].w, kf[4 * ks + 3].x, kf[4 * ks + 3].y, kf[4 * ks + 3].z, kf[4 * ks + 3].w};
                        C0 = __builtin_amdgcn_mfma_f32_32x32x16_bf16(ka0, vw2[k2], C0, 0, 0, 0); C1 = __builtin_amdgcn_mfma_f32_32x32x16_bf16(ka1, vw2[k2], C1, 0, 0, 0); }
                    __builtin_amdgcn_sched_barrier(0);
                }
            }
            __builtin_amdgcn_sched_barrier(0);
            u32x2 nsa[4], nsb[4];
#pragma unroll
            for (int i = 0; i < 2; ++i)
#pragma unroll
                for (int sx = 0; sx < 2; ++sx) { const int db = 64 * w + 32 * i + 16 * sx + 4 * h; nsa[i * 2 + sx] = *(const LAS u32x2*)(NSB + (db >> 1)); nsb[i * 2 + sx] = *(const LAS u32x2*)(NSB + ((db + 8) >> 1)); }
            if (ck + 2 < NCH) R_PREFETCH_K(ck + 2);
            if (ck + 1 < NCH) R_PREFETCH_VS(ck + 1);
            __builtin_amdgcn_sched_barrier(0);
            {
                float qn0 = 0.f, qn1 = 0.f;
#pragma unroll
                for (int i = 0; i < 2; ++i)
#pragma unroll
                    for (int sx = 0; sx < 2; ++sx) { const u32x2 na = nsa[i * 2 + sx], nb = nsb[i * 2 + sx];
                        const u32x4 qa = __builtin_bit_cast(u32x4, Qf[i * 2 + sx]), qb = __builtin_bit_cast(u32x4, Qf[4 + i * 2 + sx]);
                        qn0 = dot2bf(qa.x, na.x, qn0); qn0 = dot2bf(qa.y, na.y, qn0); qn0 = dot2bf(qa.z, nb.x, qn0); qn0 = dot2bf(qa.w, nb.y, qn0);
                        qn1 = dot2bf(qb.x, na.x, qn1); qn1 = dot2bf(qb.y, na.y, qn1); qn1 = dot2bf(qb.z, nb.x, qn1); qn1 = dot2bf(qb.w, nb.y, qn1); }
                qn0 += xhalf(qn0, h); qn1 += xhalf(qn1, h);
                if (h == 0) { QNP[w * 64 + r] = qn0; QNP[w * 64 + 32 + r] = qn1; }
                __builtin_amdgcn_sched_barrier(0);
                if (ck + 1 < NCH) R_PREFETCH_Q(ck + 1);
#pragma unroll
                for (int q4 = 0; q4 < 4; ++q4) { const f32x4 s0 = *(const LAS f32x4*)(scl + 8 * q4 + 4 * h), s1 = *(const LAS f32x4*)(scl + 32 + 8 * q4 + 4 * h);
                    P0[4 * q4] *= s0.x; P0[4 * q4 + 1] *= s0.y; P0[4 * q4 + 2] *= s0.z; P0[4 * q4 + 3] *= s0.w;
                    P1[4 * q4] *= s1.x; P1[4 * q4 + 1] *= s1.y; P1[4 * q4 + 2] *= s1.z; P1[4 * q4 + 3] *= s1.w; }
                if (w < 4) { const LAS unsigned char* vtb = VT + vlo + 16 * 64 * w;
                    const s16x4 f0 = __builtin_amdgcn_ds_read_tr16_b64_v4i16((LAS s16x4*)vtb), f1 = __builtin_amdgcn_ds_read_tr16_b64_v4i16((LAS s16x4*)(vtb + 4 * 64));
                    const bf16x8 vb = (bf16x8){f0.x, f0.y, f0.z, f0.w, f1.x, f1.y, f1.z, f1.w};
                    const bf16x8 sa0 = *(const LAS bf16x8*)(SB + r * RS + 32 * w + 16 * h), sa1 = *(const LAS bf16x8*)(SB + (32 + r) * RS + 32 * w + 16 * h);
                    P0 = __builtin_amdgcn_mfma_f32_32x32x16_bf16(sa0, vb, P0, 0, 0, 0); P1 = __builtin_amdgcn_mfma_f32_32x32x16_bf16(sa1, vb, P1, 0, 0, 0); }
                { LAS float* pb = PART + (w * 64 + 4 * h) * 32 + r; asm volatile("" : "+v"(pb));
#pragma unroll
                  for (int j = 0; j < 16; ++j) { pb[((j & 3) + 8 * (j >> 2)) * 32] = P0[j]; pb[(32 + (j & 3) + 8 * (j >> 2)) * 32] = P1[j]; } }
            }
            __builtin_amdgcn_sched_barrier(0);
            R_BAR();
            {
                const int t = tid >> 3, eg = tid & 7;
                const LAS float* pr = PART + t * 32 + eg * 4; asm volatile("" : "+v"(pr));
                f32x4 num = *(const LAS f32x4*)pr;
#pragma unroll
                for (int ww = 1; ww < 8; ++ww) num += *(const LAS f32x4*)(pr + ww * 64 * 32);
                const float qn = ((QNP[t] + QNP[64 + t]) + (QNP[128 + t] + QNP[192 + t])) + ((QNP[256 + t] + QNP[320 + t]) + (QNP[384 + t] + QNP[448 + t]));
                const float den = scl[128 + t] + scl[t] * qn, dn = fmaxf(fabsf(den), scl[64 + t]);
                const f32x4 hv = num * __builtin_amdgcn_rcpf(dn);
                u32x2 ow; ow.x = pk2(hv.x, hv.y); ow.y = pk2(hv.z, hv.w);
                *(u32x2*)(HM + (size_t)rowt * ldh + colv + eg * 4) = ow;
            }
            __builtin_amdgcn_sched_barrier(0);
            if (ck + 1 < NCH) R_STAGE(ck + 1);
        }
#undef R_PREFETCH_K
#undef R_KWRITE
#undef R_PREFETCH_VS
#undef R_PREFETCH_Q
#undef R_STAGE
    }
#undef R_BAR
    __syncthreads();
}

__device__ __forceinline__ void ph_mlpost(const Ctx& F, int j, int hb, bf16* PA, const bf16* HMB, const bf16* XCV, const bf16* ZG) {
    const float* wv = F.in(I_MLWV) + (size_t)j * 512 * 16; const float* ng = F.in(I_MLNG) + (size_t)j * 2048; const float* sk = F.in(I_MLSKIP) + (size_t)j * 2048;
    bf16* PH = PA + (size_t)hb * MH * 2048;
    LAS f32x4* const WL = (LAS f32x4*)F.lds;
    for (int i = F.tid; i < 4 * 12 * 64; i += NTHR) { const int ln = i & 63, q = (i >> 6) % 12, k = i / 768, c = 8 * ln + 512 * k;
        const float* src = q < 8 ? wv + (size_t)((c >> 2) + (q >> 2)) * 16 + 4 * (q & 3) : (q < 10 ? ng + c + 4 * (q - 8) : sk + c + 4 * (q - 10));
        WL[i] = *(const f32x4*)src; }
    __syncthreads();
    const int nrows = (MH - F.gw + F.NGW - 1) / F.NGW;
    u32x4 cur[4][4];
#define MP_ISSUE(n_, L) do { const size_t o_ = (size_t)(F.gw + (n_) * F.NGW) * 2048 + 8 * F.lane; \
        _Pragma("unroll") for (int k = 0; k < 4; ++k) { L[k][0] = *(const u32x4*)(PH + o_ + 512 * k); L[k][1] = *(const u32x4*)(HMB + o_ + 512 * k); L[k][2] = *(const u32x4*)(XCV + o_ + 512 * k); L[k][3] = *(const u32x4*)(ZG + o_ + 512 * k); } } while (0)
    if (nrows > 0) MP_ISSUE(0, cur);
#pragma unroll 1
    for (int n = 0; n < nrows; ++n) {
        const size_t on_ = (size_t)(F.gw + (n + 1 < nrows ? n + 1 : n) * F.NGW) * 2048 + 8 * F.lane;
        bf16* const prow = PH + (size_t)(F.gw + n * F.NGW) * 2048 + 8 * F.lane;
#pragma unroll
        for (int k = 0; k < 4; ++k) {
            const LAS f32x4* wl = WL + (k * 12) * 64 + F.lane;
            float a[8], b[8], h[8]; unpack8(cur[k][0], a); unpack8(cur[k][1], b);
#pragma unroll
            for (int e = 0; e < 8; ++e) a[e] += b[e];
#pragma unroll
            for (int blk = 0; blk < 2; ++blk) { const f32x4 w0 = wl[(blk * 4 + 0) * 64], w1 = wl[(blk * 4 + 1) * 64], w2 = wl[(blk * 4 + 2) * 64], w3 = wl[(blk * 4 + 3) * 64];
#pragma unroll
                for (int o = 0; o < 4; ++o) h[blk * 4 + o] = a[blk * 4 + 0] * w0[o] + a[blk * 4 + 1] * w1[o] + a[blk * 4 + 2] * w2[o] + a[blk * 4 + 3] * w3[o]; }
            float s1 = 0.f;
#pragma unroll
            for (int e = 0; e < 8; ++e) s1 += h[e];
            const float mu = wave_sum(s1) * (1.f / 512.f); float s2 = 0.f;
#pragma unroll
            for (int e = 0; e < 8; ++e) { h[e] -= mu; s2 += h[e] * h[e]; }
            const float rstd = rsqrtf(wave_sum(s2) * (1.f / 512.f) + EPS);
            const f32x4 g0 = wl[8 * 64], g1 = wl[9 * 64], k0 = wl[10 * 64], k1 = wl[11 * 64];
            const float ngv[8] = {g0.x, g0.y, g0.z, g0.w, g1.x, g1.y, g1.z, g1.w}, skv[8] = {k0.x, k0.y, k0.z, k0.w, k1.x, k1.y, k1.z, k1.w};
            float x[8], z[8], o[8]; unpack8(cur[k][2], x); unpack8(cur[k][3], z);
#pragma unroll
            for (int e = 0; e < 8; ++e) o[e] = (h[e] * rstd * ngv[e] + skv[e] * x[e]) * silu(z[e]);
            *(u32x4*)(prow + 512 * k) = pack8(o);
            cur[k][0] = *(const u32x4*)(PH + on_ + 512 * k); cur[k][1] = *(const u32x4*)(HMB + on_ + 512 * k); cur[k][2] = *(const u32x4*)(XCV + on_ + 512 * k); cur[k][3] = *(const u32x4*)(ZG + on_ + 512 * k);
            __builtin_amdgcn_sched_barrier(0);
        }
    }
#undef MP_ISSUE
    __syncthreads();
}

__device__ __forceinline__ void ph_ctx_reduce(const Ctx& F, const float* P, const float* src, float* dst, const float* gtc, int i0, int i1) {
    for (int i = i0 + F.bid * NTHR + F.tid; i < i1; i += F.G * NTHR) {
        const int c4 = (i & 255) * 4, row = i >> 8;
        f32x4 a = *(const f32x4*)(P + (size_t)row * 1024 + c4);
#pragma unroll
        for (int ks = 1; ks < 8; ++ks) a += *(const f32x4*)(P + ((size_t)ks * 1024 + row) * 1024 + c4);
        const f32x4 x = *(const f32x4*)(src + (size_t)row * 1024 + c4), g = *(const f32x4*)(gtc + c4);
        *(f32x4*)(dst + (size_t)row * 1024 + c4) = x + g * a;
    }
}
__device__ __forceinline__ void ph_final(const Ctx& F) {
    const float* fg = F.in(I_FINALG);
    for (int r = F.gw; r < NB * LLAT; r += F.NGW) {
        f32x4* xr = (f32x4*)(F.out + (size_t)r * D) + F.lane;
        f32x4 v[4]; float ss = 0.f;
#pragma unroll
        for (int jj = 0; jj < 4; ++jj) { v[jj] = xr[64 * jj]; ss += (v[jj].x * v[jj].x + v[jj].y * v[jj].y) + (v[jj].z * v[jj].z + v[jj].w * v[jj].w); }
        const float rstd = rsqrtf(wave_sum(ss) * (1.f / D) + EPS);
#pragma unroll
        for (int jj = 0; jj < 4; ++jj) { const f32x4 g = *(const f32x4*)(fg + 4 * F.lane + 256 * jj); xr[64 * jj] = v[jj] * rstd * g; }
    }
}

constexpr int NPH = 1 + 2 * 8 + 14 + 14 + 1;

__global__ void __launch_bounds__(NTHR, 2) fwd_kernel(Args args) {
    extern __shared__ __attribute__((aligned(16))) unsigned char lds_raw[];
    volatile LAS unsigned* MISC = (volatile LAS unsigned*)((LAS unsigned char*)lds_raw + MISC_OFF);
    if (threadIdx.x < 64) MISC[threadIdx.x] = 0u;
    __syncthreads();
    const int lo = args.ph_lo, hi = args.ph_hi;
    const int wv0 = __builtin_amdgcn_readfirstlane((int)threadIdx.x >> 6);
    XcdBarrier bar; bar.bar = (unsigned*)(args.ws + WS_CTL); bar.x = 0; bar.st = MISC;
    if (hi - lo > 1) bar = xcd_barrier_post((unsigned*)(args.ws + WS_CTL), MISC);
    int ph = 0;
#define PH_BEGIN if (ph >= lo && ph < hi) { Ctx F; { const CAS char* kp_ = (const CAS char*)__builtin_amdgcn_kernarg_segment_ptr(); asm volatile("" : "+s"(kp_)); F.kp = kp_; \
        F.lds = (LAS unsigned char*)lds_raw; { int w_ = wv0, b_ = blockIdx.x, g_ = gridDim.x, ln_; asm volatile("v_mbcnt_lo_u32_b32 %0, -1, 0\n\tv_mbcnt_hi_u32_b32 %0, -1, %0" : "=v"(ln_)); asm volatile("" : "+s"(w_), "+s"(b_), "+s"(g_)); F.tid = (w_ << 6) | ln_; F.wave = w_; F.bid = b_; F.G = g_; } \
        F.lane = F.tid & 63; \
        F.gw = F.bid * NWAVES + F.wave; F.NGW = F.G * NWAVES; F.out = *(float* const CAS*)(kp_ + 304); F.ws = *(unsigned char* const CAS*)(kp_ + 312); } \
        unsigned char* const ws = F.ws; bf16* const SL0 = (bf16*)(ws + WS_SLAB); bf16* const SL1 = (bf16*)(ws + WS_SLAB + SLAB); bf16* const SL2 = (bf16*)(ws + WS_SLAB + 2 * SLAB); bf16* const SL3 = (bf16*)(ws + WS_SLAB + 3 * SLAB); \
        bf16* const SL4 = (bf16*)(ws + WS_SLAB + 4 * SLAB); bf16* const SL5 = (bf16*)(ws + WS_SLAB + 5 * SLAB); bf16* const SL6 = (bf16*)(ws + WS_SLAB + 6 * SLAB); \
        bf16* const WIN = (bf16*)(ws + WS_W + W_IN); bf16* const WOUT = (bf16*)(ws + WS_W + W_OUT); bf16* const WGLU = (bf16*)(ws + WS_W + W_GLU); bf16* const WGATE = (bf16*)(ws + WS_W + W_GATE); \
        const float* const modv = (const float*)(ws + WS_MODV); float* const xctx = (float*)(ws + WS_XCTX); (void)SL0; (void)SL1; (void)SL2; (void)SL3; (void)SL4; (void)SL5; (void)SL6; (void)WIN; (void)WOUT; (void)WGLU; (void)WGATE; (void)modv; (void)xctx;
#define PH_END if (ph + 1 < hi) { int ln2_; asm volatile("v_mbcnt_lo_u32_b32 %0, -1, 0\n\tv_mbcnt_hi_u32_b32 %0, -1, %0" : "=v"(ln2_)); xcd_barrier(bar, (ln2_ == 0) & (wv0 == 0)); } } ++ph;

    PH_BEGIN ph_mod(F); PH_END

#pragma unroll 1
    for (int l = 0; l < DEPTH; ++l) {
        const int j = l >> 1;
        if ((l & 1) == 0) {
#define Y SL0
#define U SL2
#define XR SL3
#define HB SL4
#define XC SL4
#define YS0 SL5
#define YS1 SL6
            PH_BEGIN { int l_ = l; asm volatile("" : "+s"(l_)); ph_norm(F, l_, 0, M, HB, l_ > 0 ? (const float*)SL2 : (const float*)nullptr); } ph_wconv_even(F, j); PH_END
            PH_BEGIN { pg8::TileOrder S; S.init(NTILE, 16, F.G, F.bid, HB, (size_t)256 * 1024 * 2, WIN, (size_t)256 * 1024 * 2);
                       pg8::EpiSplit E{U, Y, (long)(XR - U), 1024, 1024, 2048, 10};
                       GEMM_CALL(1024, 1024, 1024, S, E); } PH_END
            PH_BEGIN ph_rgconv(F, j, XR, XC); __syncthreads(); ph_s5_mfma(F, j, U, YS0); PH_END
            PH_BEGIN { pg8::TileOrder S; S.init(NTILE - NB, 4, F.G, F.bid, U, (size_t)256 * 1024 * 2, WGLU, (size_t)256 * 1024 * 2); S.skipctx = 1;
                       pg8::EpiGlu E{U, Y, F.in(I_GLUB) + (size_t)j * 1024};
                       GEMM_CALL(1024, 1024, 1024, S, E); } PH_END
            PH_BEGIN {
                       { pg8::CtxOrder S3{F.G, F.bid, 64, 4, (const char*)U, (size_t)256 * 1024 * 2, (const char*)WGLU, (size_t)256 * 1024 * 2}; pg8::EpiGlu E3{U, Y, F.in(I_GLUB) + (size_t)j * 1024};
                         int tid3 = F.tid; asm volatile("" : "+v"(tid3)); pg8::gemm_phase(F.lds, tid3, 1024, 1024, 1024, S3, E3); }
                       __syncthreads();
                       pg8::TileOrder S; S.init(NTILE, 16, F.G, F.bid, XC, (size_t)256 * 1024 * 2, WGATE, (size_t)256 * 256 * 2, 2, (size_t)256 * 2);
                       pg8::EpiGate E{XC, SL2, F.in(I_RGBA) + (size_t)j * 2048, F.in(I_RGBX) + (size_t)j * 2048, (const float*)(ws + WS_SPT)};
                       GEMM_CALL(256, 1024, 256, S, E); } PH_END
            PH_BEGIN ph_rgscan_a(F, SL2, SL3, SL5, SL6, (float*)(ws + WS_PS), (float*)(ws + WS_GATE), (const bf16*)(ws + WS_ST)); PH_END
            PH_BEGIN ph_rgscan_c(F, SL2, SL3, SL5, SL6, (const float*)(ws + WS_PS), (const float*)(ws + WS_GATE), Y, (const bf16*)(ws + WS_ST)); PH_END
            PH_BEGIN { pg8::TileOrder S; S.init(NTILE - NB, 4, F.G, F.bid, Y, (size_t)256 * 2048 * 2, WOUT, (size_t)256 * 2048 * 2); S.skipctx = 1;
                       pg8::EpiOut E{l == 0 ? F.in(I_X) : (const float*)F.out, l == 0 ? F.in(I_CTX) : (const float*)xctx, F.out, xctx, modv + (size_t)l * 5 * 3072};
                       GEMM_CALL(2048, 2048, 2048, S, E);
                       __syncthreads();
                       { pg8::CtxKOrder S2{F.G, F.bid, (const char*)Y, (size_t)256 * 2048 * 2, (const char*)WOUT, (size_t)256 * 2048 * 2}; pg8::EpiPart E2{(float*)SL2};
                         { int tid2 = F.tid; asm volatile("" : "+v"(tid2)); pg8::gemm_phase(F.lds, tid2, 256, 2048, 2048, S2, E2); }     } } PH_END
        } else {
#undef Y
#undef U
#undef XR
#undef HB
#undef XC
#undef YS0
#undef YS1
#define PA SL0
#define HMB SL2
#define XM SL3
#define ZG SL4
#define XCV SL5
#define QP SL6
#define HB SL6
#pragma unroll 1
            for (int hb = 0; hb < 2; ++hb) {
                if (hb == 0) { PH_BEGIN { int l_ = l; asm volatile("" : "+s"(l_)); ph_norm(F, l_, 0, MH, HB, (const float*)SL2);
                                          ph_ctx_reduce(F, (const float*)SL2, l_ == 1 ? F.in(I_CTX) : (const float*)xctx, xctx, modv + (size_t)(l_ - 1) * 5 * 3072 + 4 * 3072 + 2048, (NB / 2) * LCTX * D / 4, NB * LCTX * D / 4); } ph_wconv_odd(F, j); PH_END }
                PH_BEGIN { pg8::TileOrder S; S.init(NTILE / 2, 16, F.G, F.bid, HB, (size_t)256 * 1024 * 2, WIN, (size_t)256 * 1024 * 2);
                           pg8::EpiSplit E{XM, ZG, 0, 0, 2048, 2048, 11};
                           GEMM_CALL(1024, 1024, 1024, S, E); } PH_END
                PH_BEGIN ph_convq(F, j, hb, XM, XCV, QP); PH_END
                PH_BEGIN ph_mscan(F, hb); PH_END
                PH_BEGIN ph_stilde(F, hb, QP, XCV); PH_END
                PH_BEGIN ph_mlstm_r(F, hb, QP, XCV, XM, PA + (size_t)hb * MH * 2048, 2048, HMB, 2048); PH_END
                PH_BEGIN ph_mlpost(F, j, hb, PA, HMB, XCV, ZG);
                         if (hb == 0) { int l_ = l; asm volatile("" : "+s"(l_)); ph_norm(F, l_, MH, 2 * MH, HB, (const float*)nullptr); }
                PH_END
            }
            PH_BEGIN { pg8::TileOrder S; S.init(NTILE - NB, 4, F.G, F.bid, PA, (size_t)256 * 2048 * 2, WOUT, (size_t)256 * 2048 * 2); S.skipctx = 1;
                       pg8::EpiOut E{l == 0 ? F.in(I_X) : (const float*)F.out, l == 0 ? F.in(I_CTX) : (const float*)xctx, F.out, xctx, modv + (size_t)l * 5 * 3072};
                       GEMM_CALL(2048, 2048, 2048, S, E);
                       if (l < DEPTH - 1) { __syncthreads();
                         pg8::CtxKOrder S2{F.G, F.bid, (const char*)PA, (size_t)256 * 2048 * 2, (const char*)WOUT, (size_t)256 * 2048 * 2}; pg8::EpiPart E2{(float*)SL2};
                         { int tid2 = F.tid; asm volatile("" : "+v"(tid2)); pg8::gemm_phase(F.lds, tid2, 256, 2048, 2048, S2, E2); }     } } PH_END
        }
    }
    PH_BEGIN ph_final(F); PH_END
#undef PH_BEGIN
#undef PH_END
#undef PA
#undef HMB
#undef XM
#undef ZG
#undef XCV
#undef QP
#undef HB
}

extern "C" void kernel_launch(void* const* d_in, const int* in_sizes, int n_in, void* d_out, int out_size, void* d_ws, size_t ws_size, hipStream_t stream) {
    static int grid = 0;
    if (grid == 0) {
        int dev = 0, cus = 0, per_cu = 0;
        if (hipGetDevice(&dev) != hipSuccess || hipDeviceGetAttribute(&cus, hipDeviceAttributeMultiprocessorCount, dev) != hipSuccess) { fprintf(stderr, "kernel_launch: device query failed\n"); grid = -1; return; }
        if (hipFuncSetAttribute((const void*)fwd_kernel, hipFuncAttributeMaxDynamicSharedMemorySize, LDS_BYTES) != hipSuccess) { fprintf(stderr, "kernel_launch: hipFuncSetAttribute failed\n"); grid = -1; return; }
        if (hipOccupancyMaxActiveBlocksPerMultiprocessor(&per_cu, (const void*)fwd_kernel, NTHR, LDS_BYTES) != hipSuccess || per_cu < 1) fprintf(stderr, "kernel_launch: occupancy query says %d\n", per_cu);
        (void)hipGetLastError();
        grid = cus;
        if (n_in != 38 || out_size != NB * LLAT * D || ws_size < WS_END) fprintf(stderr, "kernel_launch: unexpected shapes: n_in %d out %d ws %zu\n", n_in, out_size, ws_size);
    }
    if (grid < 0) return;
    (void)hipMemsetAsync((char*)d_ws + WS_CTL, 0, CTL_ZERO_BYTES, stream);
    Args a{};
    for (int i = 0; i < 38; ++i) a.in[i] = (const float*)d_in[i];
    a.out = (float*)d_out; a.ws = (unsigned char*)d_ws;
#if ONE_LAUNCH
    a.ph_lo = 0; a.ph_hi = NPH;
    hipLaunchKernelGGL(fwd_kernel, dim3(grid), dim3(NTHR), LDS_BYTES, stream, a);
#else
    for (int p = 0; p < NPH; ++p) { a.ph_lo = p; a.ph_hi = p + 1; hipLaunchKernelGGL(fwd_kernel, dim3(grid), dim3(NTHR), LDS_BYTES, stream, a); }
#endif
}
```

```cpp
#include <hip/hip_runtime.h>
#include <cstdio>
#include <cstdint>

#ifndef NAIVE_GEMM
#define NAIVE_GEMM 0
#endif
#if NAIVE_GEMM
#define GEMM_CALL(K_, la_, lb_, S_, E_) pg8::gemm_phase_naive(F.tid, K_, la_, lb_, S_, E_)
#else
#define GEMM_CALL(K_, la_, lb_, S_, E_) pg8::gemm_phase(F.lds, F.tid, K_, la_, lb_, S_, E_)
#endif
#ifndef ONE_LAUNCH
#define ONE_LAUNCH 1
#endif

#define LAS __attribute__((address_space(3)))
#define GAS __attribute__((address_space(1)))
typedef unsigned short bf16;
typedef short bf16x8 __attribute__((ext_vector_type(8)));
typedef float f32x4 __attribute__((ext_vector_type(4)));
typedef unsigned u32x4 __attribute__((ext_vector_type(4)));
typedef unsigned u32x2 __attribute__((ext_vector_type(2)));
typedef short s16x4 __attribute__((ext_vector_type(4)));

constexpr int NB = 4, LLAT = 8192, LCTX = 256, SEQL = LLAT + LCTX;
constexpr int M = NB * SEQL;
constexpr int D = 1024, DEPTH = 4;
constexpr int MH = M / 2;
constexpr int NTILE = M / 256, TPB = SEQL / 256;
constexpr float EPS = 1e-6f;
constexpr int NCH = SEQL / 64;

constexpr size_t MiB = 1u << 20;
constexpr size_t WS_CTL = 0, CTL_ZERO_BYTES = 64 * 1024;
constexpr size_t WS_MODV = 1 * MiB;
constexpr size_t WS_MG = WS_MODV + 256 * 1024;
constexpr size_t WS_WGT = WS_MG + 64 * 1024;
constexpr size_t WS_PC = WS_WGT + 128 * 1024;
constexpr size_t WS_SPT = WS_MODV + 512 * 1024;
constexpr size_t WS_DS = 2 * MiB;
constexpr size_t WS_PS = 3 * MiB;
constexpr size_t WS_GATE = 6 * MiB;
constexpr size_t WS_XCTX = 9 * MiB;
constexpr size_t WS_DN = 13 * MiB;
constexpr size_t WS_W = 16 * MiB;
constexpr size_t W_IN = 0, W_OUT = 8 * MiB, W_GLU = 12 * MiB, W_GATE = 14 * MiB;
constexpr size_t WS_ST = 32 * MiB;
constexpr size_t WS_SLAB = 50 * MiB;
constexpr size_t SLAB = (size_t)M * 1024 * 2;
static_assert(SLAB == 66 * MiB, "slab");
constexpr size_t WS_END = WS_SLAB + 7 * SLAB;
static_assert(WS_END == 512 * MiB, "ws map");

constexpr int LDS_BYTES = 163840;
constexpr int MISC_OFF = 163840 - 256;
constexpr int NWAVES = 8, NTHR = 512;

__device__ __forceinline__ float bf2f(unsigned b) { return __uint_as_float(b << 16); }
typedef __bf16 bf2v_t __attribute__((ext_vector_type(2)));
__device__ __forceinline__ unsigned f2bf(float f) { return (unsigned)__builtin_bit_cast(unsigned short, (__bf16)f); }
__device__ __forceinline__ unsigned pk2(float lo, float hi) { bf2v_t v; v.x = (__bf16)lo; v.y = (__bf16)hi; return __builtin_bit_cast(unsigned, v); }
__device__ __forceinline__ float sigm(float x) { return __builtin_amdgcn_rcpf(1.f + __expf(-x)); }
__device__ __forceinline__ float silu(float x) { return x * __builtin_amdgcn_rcpf(1.f + __expf(-x)); }
__device__ __forceinline__ float softplus(float x) { return x > 20.f ? x : __logf(1.f + __expf(x)); }
__device__ __forceinline__ float logsigmoid(float x) { return fminf(x, 0.f) - __logf(1.f + __expf(-fabsf(x))); }
__device__ __forceinline__ float gelu_tanh(float x) { return x * sigm(1.5957691216057308f * (x + 0.044715f * x * x * x)); }
__device__ __forceinline__ void unpack8(const u32x4 w, float (&v)[8]) {
    v[0] = bf2f(w.x & 0xffffu); v[1] = bf2f(w.x >> 16); v[2] = bf2f(w.y & 0xffffu); v[3] = bf2f(w.y >> 16);
    v[4] = bf2f(w.z & 0xffffu); v[5] = bf2f(w.z >> 16); v[6] = bf2f(w.w & 0xffffu); v[7] = bf2f(w.w >> 16);
}
__device__ __forceinline__ u32x4 pack8(const float (&v)[8]) { u32x4 w; w.x = pk2(v[0], v[1]); w.y = pk2(v[2], v[3]); w.z = pk2(v[4], v[5]); w.w = pk2(v[6], v[7]); return w; }
#define SWZX(v, m) __int_as_float(__builtin_amdgcn_ds_swizzle(__float_as_int(v), (((m) << 10) | 0x1f)))
__device__ __forceinline__ float wave_sum(float v) {
    v += SWZX(v, 1); v += SWZX(v, 2); v += SWZX(v, 4); v += SWZX(v, 8); v += SWZX(v, 16);
    return __int_as_float(__builtin_amdgcn_readlane(__float_as_int(v), 0)) + __int_as_float(__builtin_amdgcn_readlane(__float_as_int(v), 32));
}
__device__ __forceinline__ float sum8(float v) { v += SWZX(v, 1); v += SWZX(v, 2); v += SWZX(v, 4); return v; }
#define LDS_WAIT() asm volatile("s_waitcnt lgkmcnt(0)" ::: "memory")
#define VM_WAIT() asm volatile("s_waitcnt vmcnt(0)" ::: "memory")
#define WAVE_SYNC() do { asm volatile("s_waitcnt lgkmcnt(0)" ::: "memory"); __builtin_amdgcn_wave_barrier(); } while (0)

__device__ __forceinline__ int pos2s_even(int pos, int d) { return d == 0 ? pos : (pos < LCTX ? LCTX - 1 - pos : (SEQL + LCTX - 1) - pos); }
__device__ __forceinline__ int pos2s_odd(int pos, int d) {
    if (pos < LCTX) return d == 0 ? pos : LCTX - 1 - pos;
    const int p = d == 0 ? pos - LCTX : LLAT - 1 - (pos - LCTX);
    return LCTX + (p & 127) * 64 + (p >> 7);
}
__device__ __forceinline__ int nb_even(int s, int o) { const int t = s + o; return s < LCTX ? ((t >= 0 && t < LCTX) ? t : -1) : ((t >= LCTX && t < SEQL) ? t : -1); }
__device__ __forceinline__ int nb_odd(int s, int o) {
    if (s < LCTX) { const int t = s + o; return (t >= 0 && t < LCTX) ? t : -1; }
    const int i = s - LCTX, p = (i & 63) * 128 + (i >> 6) + o;
    if (p < 0 || p >= LLAT) return -1;
    return LCTX + (p & 127) * 64 + (p >> 7);
}

#define XB_TMO      128
#define XB_XCNT(j)  (256  + 64 * (j))
#define XB_XSUB(j)  (1280 + 64 * (j))
#define XB_XGEN(j)  (2304 + 64 * (j))
#define XB_TOP      3328
#define XB_TOPGEN   3392
#define XCD_BAR_WORDS 3456
#define XB_SPIN_CAP (1u << 22)
__device__ __forceinline__ unsigned xb_ld(unsigned* p)              { return __hip_atomic_load(p, __ATOMIC_RELAXED, __HIP_MEMORY_SCOPE_AGENT); }
__device__ __forceinline__ unsigned xb_add(unsigned* p, unsigned v) { return __hip_atomic_fetch_add(p, v, __ATOMIC_RELAXED, __HIP_MEMORY_SCOPE_AGENT); }
__device__ __forceinline__ unsigned xb_xcc_id() { return (unsigned)__builtin_amdgcn_s_getreg((3 << 11) | 20) & 0xFu; }
#define XB_SPIN(cond, bar) do { unsigned _sp = 0; while (cond) { __builtin_amdgcn_s_sleep(1); \
    if ((++_sp & 255u) == 0u) { if (xb_ld(&(bar)[XB_TMO])) break; if (_sp > XB_SPIN_CAP) { atomicAdd(&(bar)[XB_TMO], 1u); break; } } } } while (0)
struct XcdBarrier { unsigned* bar; unsigned x; volatile LAS unsigned* st; };
__device__ __forceinline__ XcdBarrier xcd_barrier_post(unsigned* bar, volatile LAS unsigned* st) {
    XcdBarrier b; b.bar = bar; b.x = xb_xcc_id(); b.st = st;
    if (threadIdx.x == 0) (void)xb_add(&bar[XB_XCNT(b.x)], 1u);
    return b;
}
__device__ __forceinline__ void xcd_barrier_complete(unsigned* bar, unsigned x, unsigned& nloc, unsigned& nx) {
    const unsigned G = gridDim.x * gridDim.y * gridDim.z;
    unsigned sum, cnt, mine, sp = 0u;
    for (;;) {
        sum = 0u; cnt = 0u; mine = 0u;
#pragma unroll
        for (unsigned j = 0; j < 16; ++j) { const unsigned c = xb_ld(&bar[XB_XCNT(j)]); sum += c; cnt += (c > 0u) ? 1u : 0u; mine = (j == x) ? c : mine; }
        if (sum == G) break;
        __builtin_amdgcn_s_sleep(1);
        if ((++sp & 255u) == 0u) { if (xb_ld(&bar[XB_TMO])) break; if (sp > XB_SPIN_CAP) { atomicAdd(&bar[XB_TMO], 1u); break; } }
    }
    nloc = mine > 0u ? mine : 1u; nx = cnt > 0u ? cnt : 1u;
}
__device__ __forceinline__ void xcd_barrier(const XcdBarrier& b, const bool leader) {
    asm volatile("s_waitcnt vmcnt(0)" ::: "memory");
    __syncthreads();
    if (leader) {
        unsigned* bar = b.bar;
        __builtin_amdgcn_s_waitcnt(0);
        unsigned nloc = b.st[0], nx = b.st[1];
        if (nloc == 0u) { xcd_barrier_complete(bar, b.x, nloc, nx); b.st[0] = nloc; b.st[1] = nx; }
        const unsigned old = xb_add(&bar[XB_XSUB(b.x)], 1u);
        const unsigned gen = old / nloc;
        if (old + 1u == (gen + 1u) * nloc) {
            __builtin_amdgcn_fence(__ATOMIC_RELEASE, "agent");
            asm volatile("s_waitcnt vmcnt(0)" ::: "memory");
            const unsigned og = xb_add(&bar[XB_TOP], 1u);
            const unsigned tg = og / nx;
            if (og + 1u == (tg + 1u) * nx) xb_add(&bar[XB_TOPGEN], 1u);
            else XB_SPIN(xb_ld(&bar[XB_TOPGEN]) == tg, bar);
            __builtin_amdgcn_fence(__ATOMIC_ACQUIRE, "agent");
            xb_add(&bar[XB_XGEN(b.x)], 1u);
            asm volatile("s_waitcnt vmcnt(0)" ::: "memory");
        } else {
            XB_SPIN(xb_ld(&bar[XB_XGEN(b.x)]) == gen, bar);
            __builtin_amdgcn_fence(__ATOMIC_ACQUIRE, "agent");
            asm volatile("s_waitcnt vmcnt(0)" ::: "memory");
        }
    }
    __syncthreads();
}

__device__ __forceinline__ void rg_coefs(const float la, float& om, float& mlt) {
    const float a = __expf(la);
    const float pom = -la * (1.f + la * (0.5f + la * (0.16666667f + la * 0.041666668f)));
    om = la > -0.125f ? pom : 1.f - a;
    mlt = __builtin_amdgcn_sqrtf(fmaxf(om * (2.f - om), 0.f));
}
namespace pg8 {
constexpr int BM = 256, BK = 64, HALF = 128, HTB = HALF * BK * 2, STAGE_BYTES = 8 * HTB, NXCD = 8, WGM = 8;
__host__ __device__ __forceinline__ int lds_byte(int r, int c) { const int st = (r >> 4) * 2 + (c >> 5), rr = r & 15, cc = c & 31, ob = rr * 64 + cc * 2; return st * 1024 + (ob ^ (((ob >> 9) & 1) << 5)); }
__host__ __device__ __forceinline__ void stage_rc(int b, int& R, int& C) { const int st = b / 1024, sb = b % 1024, swz = sb ^ (((sb >> 9) & 1) << 5); R = (st >> 1) * 16 + swz / 64; C = (st & 1) * 32 + (swz % 64) / 2; }
__host__ __device__ __forceinline__ int perm32(int rho) { const int n = rho >> 4, i = rho & 15; return 8 * (i >> 2) + 4 * n + (i & 3); }
struct Unit { int pm, pn; const char* a; const char* b; };
struct TileOrder {
    int nM, nN, nwg, G, c, skipctx;
    const char* A; size_t a_tile; int a_sh; size_t a_pn; const char* B; size_t b_tile;
    __device__ __forceinline__ void init(int nM_, int nN_, int G_, int c_, const void* A_, size_t a_tile_, const void* B_, size_t b_tile_, int a_sh_ = 0, size_t a_pn_ = 0) {
        nM = nM_; nN = nN_; nwg = nM * nN; G = G_; c = c_; skipctx = 0; A = (const char*)A_; a_tile = a_tile_; a_sh = a_sh_; a_pn = a_pn_; B = (const char*)B_; b_tile = b_tile_; }
    __device__ __forceinline__ bool next(int i, Unit& u) const {
        const long L = (long)i * G + c; if (L >= nwg) return false;
        int wgid = (int)L; { const int q = nwg / NXCD, r = nwg % NXCD, xcd = wgid % NXCD, off = wgid / NXCD; wgid = (xcd < r ? xcd * (q + 1) : r * (q + 1) + (xcd - r) * q) + off; }
        const int nig = WGM * nN, gid = wgid / nig, fm = gid * WGM, gsz = (nM - fm) < WGM ? (nM - fm) : WGM;
        u.pm = fm + ((wgid % nig) % gsz); u.pn = (wgid % nig) / gsz;
        if (skipctx) u.pm += u.pm / (TPB - 1) + 1;
        u.a = A + (size_t)u.pm * a_tile + (size_t)(u.pn >> a_sh) * a_pn; u.b = B + (size_t)u.pn * b_tile; return true;
    }
    __device__ __forceinline__ void a_ready(const Unit&) const {}
    __device__ __forceinline__ void done(const Unit&) const {}
};
__device__ __forceinline__ unsigned cvt_pk_bf16(float lo, float hi) { unsigned r; asm volatile("v_cvt_pk_bf16_f32 %0, %1, %2" : "=v"(r) : "v"(lo), "v"(hi)); return r; }

template <class Epi, class Sched>
__device__ __forceinline__ void gemm_phase(LAS unsigned char* lds, const int tid, const int K_, const int lda, const int ldb, const Sched& S, const Epi& E) {
    int K = K_; asm volatile("" : "+s"(K));
    const int wid = __builtin_amdgcn_readfirstlane(tid >> 6), lane = tid & 63, wr = wid >> 2, wc = wid & 3, fr = lane & 15, fq = lane >> 4;
    const int nt = K / BK;
    unsigned voffA[2], voffB[2];
#pragma unroll
    for (int i = 0; i < 2; ++i) { int R, C; stage_rc(tid * 16 + i * 8192, R, C); const int Rb = Epi::PERM ? ((R & ~31) + perm32(R & 31)) : R;
        voffA[i] = (unsigned)(R * lda + C) * 2u; voffB[i] = (unsigned)(Rb * ldb + C) * 2u; }
    const size_t kstep = (size_t)(BK * 2);
    const size_t hstepA = (size_t)HALF * lda * 2, hstepB = (size_t)HALF * ldb * 2;
    const unsigned ldsw = (unsigned)wid * 1024u;
    const int aoff = lds_byte(wr * 64 + fr, fq * 8), boff = lds_byte(wc * 32 + fr, fq * 8);
#define PG8_SA(b, h) (((b) * 2 + (h)) * HTB)
#define PG8_SB(b, h) ((4 + (b) * 2 + (h)) * HTB)
#define PG8_STAGE(bufoff, gbase, voff) do { _Pragma("unroll") for (int _i = 0; _i < 2; ++_i) \
        __builtin_amdgcn_global_load_lds((const unsigned*)((const char*)(gbase) + (voff)[_i]), (LAS unsigned*)(lds + (bufoff) + ldsw + _i * 8192), 16, 0, 0); } while (0)
#define PG8_LDA(dst, b, h) do { _Pragma("unroll") for (int m = 0; m < 4; ++m) _Pragma("unroll") for (int k = 0; k < 2; ++k) dst[m][k] = *(const LAS bf16x8*)(lds + PG8_SA(b, h) + aoff + m * 2048 + k * 1024); } while (0)
#define PG8_LDB(dst, b, h) do { _Pragma("unroll") for (int n = 0; n < 2; ++n) _Pragma("unroll") for (int k = 0; k < 2; ++k) dst[n][k] = *(const LAS bf16x8*)(lds + PG8_SB(b, h) + boff + n * 2048 + k * 1024); } while (0)
#define PG8_MMA(ai, bj, At, Bt) do { __builtin_amdgcn_s_setprio(1); _Pragma("unroll") for (int m = 0; m < 4; ++m) _Pragma("unroll") for (int n = 0; n < 2; ++n) _Pragma("unroll") for (int k = 0; k < 2; ++k) \
        acc[ai][bj][m][n] = __builtin_amdgcn_mfma_f32_16x16x32_bf16(Bt[n][k], At[m][k], acc[ai][bj][m][n], 0, 0, 0); __builtin_amdgcn_s_setprio(0); } while (0)
#define PG8_WAIT_V(n) asm volatile("s_waitcnt vmcnt(" #n ")" ::: "memory")
#define PG8_WAIT_L(n) asm volatile("s_waitcnt lgkmcnt(" #n ")" ::: "memory")
#define PG8_BAR __builtin_amdgcn_s_barrier()
#define PG8_SCHED __builtin_amdgcn_sched_barrier(0)
    Unit cur, nxt; int ui = 0;
    if (!S.next(0, cur)) return;
    f32x4 acc[2][2][4][2];
#pragma unroll
    for (int a = 0; a < 2; ++a)
#pragma unroll
        for (int b = 0; b < 2; ++b)
#pragma unroll
            for (int m = 0; m < 4; ++m)
#pragma unroll
                for (int n = 0; n < 2; ++n) acc[a][b][m][n] = (f32x4){0.f, 0.f, 0.f, 0.f};
    bf16x8 At[4][2], B0[2][2], B1[2][2];
    const char* cA = cur.a; const char* cB = cur.b;
    S.a_ready(cur);
    PG8_STAGE(PG8_SB(0, 0), cB, voffB); PG8_STAGE(PG8_SA(0, 0), cA, voffA); PG8_STAGE(PG8_SB(0, 1), cB + hstepB, voffB); PG8_STAGE(PG8_SA(0, 1), cA + hstepA, voffA);
    if (wr == 1) PG8_BAR;
    PG8_WAIT_V(4); PG8_BAR;
    PG8_STAGE(PG8_SB(1, 0), cB + kstep, voffB); PG8_STAGE(PG8_SA(1, 0), cA + kstep, voffA); PG8_STAGE(PG8_SB(1, 1), cB + hstepB + kstep, voffB);
    PG8_WAIT_V(6); PG8_BAR;
    for (;;) {
        const bool has_next = S.next(ui + 1, nxt);
        const char* nA = has_next ? nxt.a : cA; const char* nB = has_next ? nxt.b : cB;
        for (int t = 0; t < nt; t += 2) {
            const bool last = (t == nt - 2);
            const char* a1 = cA + (size_t)(t + 1) * kstep;
            const char* a2 = last ? nA : cA + (size_t)(t + 2) * kstep; const char* b2 = last ? nB : cB + (size_t)(t + 2) * kstep;
            const char* a3 = a2 + kstep; const char* b3 = b2 + kstep;
            if (last && has_next) S.a_ready(nxt);
            PG8_LDB(B0, 0, 0); PG8_SCHED; PG8_LDA(At, 0, 0); PG8_STAGE(PG8_SA(1, 1), a1 + hstepA, voffA);
            PG8_WAIT_L(8); PG8_BAR; PG8_WAIT_L(0); PG8_MMA(0, 0, At, B0); PG8_BAR; PG8_SCHED;
            PG8_LDB(B1, 0, 1); PG8_STAGE(PG8_SB(0, 0), b2, voffB);
            PG8_BAR; PG8_WAIT_L(0); PG8_MMA(0, 1, At, B1); PG8_BAR;
            PG8_LDA(At, 0, 1); PG8_STAGE(PG8_SA(0, 0), a2, voffA);
            PG8_BAR; PG8_WAIT_L(0); PG8_MMA(1, 0, At, B0); PG8_BAR; PG8_SCHED;
            PG8_STAGE(PG8_SB(0, 1), b2 + hstepB, voffB);
            PG8_WAIT_V(6); PG8_BAR; PG8_MMA(1, 1, At, B1); PG8_BAR;
            PG8_LDB(B0, 1, 0); PG8_SCHED; PG8_LDA(At, 1, 0); PG8_STAGE(PG8_SA(0, 1), a2 + hstepA, voffA);
            PG8_WAIT_L(8); PG8_BAR; PG8_WAIT_L(0); PG8_MMA(0, 0, At, B0); PG8_BAR; PG8_SCHED;
            PG8_LDB(B1, 1, 1); PG8_STAGE(PG8_SB(1, 0), b3, voffB);
            PG8_BAR; PG8_WAIT_L(0); PG8_MMA(0, 1, At, B1); PG8_BAR;
            PG8_LDA(At, 1, 1); PG8_STAGE(PG8_SA(1, 0), a3, voffA);
            PG8_BAR; PG8_WAIT_L(0); PG8_MMA(1, 0, At, B0); PG8_BAR; PG8_SCHED;
            PG8_STAGE(PG8_SB(1, 1), b3 + hstepB, voffB);
            PG8_WAIT_V(6); PG8_BAR; PG8_MMA(1, 1, At, B1); PG8_BAR;
        }
        E(acc, cur, wr, wc, fr, fq); S.done(cur);
        if (!has_next) break;
#pragma unroll
        for (int a = 0; a < 2; ++a)
#pragma unroll
            for (int b = 0; b < 2; ++b)
#pragma unroll
                for (int m = 0; m < 4; ++m)
#pragma unroll
                    for (int n = 0; n < 2; ++n) acc[a][b][m][n] = (f32x4){0.f, 0.f, 0.f, 0.f};
        cur = nxt; cA = nA; cB = nB; ++ui;
    }
    PG8_WAIT_V(0);
    if (wr == 0) PG8_BAR;
    PG8_BAR;
#undef PG8_SA
#undef PG8_SB
#undef PG8_STAGE
#undef PG8_LDA
#undef PG8_LDB
#undef PG8_MMA
#undef PG8_WAIT_V
#undef PG8_WAIT_L
#undef PG8_BAR
#undef PG8_SCHED
}

typedef const f32x4 (&AccRef)[2][2][4][2];
#ifndef NAIVE_GEMM
#define NAIVE_GEMM 0
#endif
template <class Epi, class Sched>
__device__ __forceinline__ void gemm_phase_naive(const int tid, const int K, const int lda, const int ldb, const Sched& S, const Epi& E) {
    const int wid = tid >> 6, lane = tid & 63, wr = wid >> 2, wc = wid & 3, fr = lane & 15, fq = lane >> 4;
    Unit cur;
    for (int ui = 0; S.next(ui, cur); ++ui) {
        f32x4 acc[2][2][4][2];
#pragma unroll
        for (int ai = 0; ai < 2; ++ai)
#pragma unroll
            for (int m = 0; m < 4; ++m) {
                const bf16* arow = (const bf16*)cur.a + (size_t)(128 * ai + 64 * wr + 16 * m + fr) * lda;
#pragma unroll
                for (int bj = 0; bj < 2; ++bj)
#pragma unroll
                    for (int n = 0; n < 2; ++n) {
                        const int c0 = 128 * bj + 32 * wc + (Epi::PERM ? 8 * fq + 4 * n : 16 * n + 4 * fq);
                        const bf16* b0 = (const bf16*)cur.b + (size_t)c0 * ldb;
                        float s0 = 0.f, s1 = 0.f, s2 = 0.f, s3 = 0.f;
                        for (int k = 0; k < K; k += 8) { float a[8], w[8]; unpack8(*(const u32x4*)(arow + k), a);
                            unpack8(*(const u32x4*)(b0 + k), w);
#pragma unroll
                            for (int x = 0; x < 8; ++x) s0 += a[x] * w[x];
                            unpack8(*(const u32x4*)(b0 + ldb + k), w);
#pragma unroll
                            for (int x = 0; x < 8; ++x) s1 += a[x] * w[x];
                            unpack8(*(const u32x4*)(b0 + 2 * ldb + k), w);
#pragma unroll
                            for (int x = 0; x < 8; ++x) s2 += a[x] * w[x];
                            unpack8(*(const u32x4*)(b0 + 3 * ldb + k), w);
#pragma unroll
                            for (int x = 0; x < 8; ++x) s3 += a[x] * w[x]; }
                        acc[ai][bj][m][n] = (f32x4){s0, s1, s2, s3}; } }
        E(acc, cur, wr, wc, fr, fq);
    }
}


struct EpiSplit {
    static constexpr bool PERM = true;
    bf16 *pe, *po; long se, so; int le, lo_; int wshift;
    __device__ __forceinline__ void operator()(AccRef acc, const Unit& u, int wr, int wc, int fr, int fq) const {
        const int rowb = u.pm * BM + wr * 64 + fr; const int colt = u.pn * BM; const int di = colt >> wshift, dh = di >> 1;
        bf16* base = (di & 1) ? po + (long)dh * so : pe + (long)dh * se; const int ldd = (di & 1) ? lo_ : le;
        const int col0 = (colt & ((1 << wshift) - 1)) + wc * 32 + 8 * fq;
#pragma unroll
        for (int ai = 0; ai < 2; ++ai)
#pragma unroll
            for (int m = 0; m < 4; ++m) { bf16* rowp = base + (size_t)(rowb + ai * HALF + m * 16) * ldd + col0;
#pragma unroll
                for (int bj = 0; bj < 2; ++bj) { const f32x4 v0 = acc[ai][bj][m][0], v1 = acc[ai][bj][m][1];
                    u32x4 w; w.x = cvt_pk_bf16(v0[0], v0[1]); w.y = cvt_pk_bf16(v0[2], v0[3]); w.z = cvt_pk_bf16(v1[0], v1[1]); w.w = cvt_pk_bf16(v1[2], v1[3]);
                    *(u32x4*)(rowp + bj * HALF) = w; } }
    }
};
struct EpiGlu {
    static constexpr bool PERM = true;
    const bf16* YG; bf16* Y; const float* gb;
    __device__ __forceinline__ void operator()(AccRef acc, const Unit& u, int wr, int wc, int fr, int fq) const {
        int rowb = u.pm * BM + wr * 64 + fr; const int col0 = u.pn * BM + wc * 32 + 8 * fq; asm volatile("" : "+v"(rowb));
        u32x4 ly[2][4], lg[2][4];
#define GLU_LD(g_, S) _Pragma("unroll") for (int q = 0; q < 4; ++q) { const size_t row = (size_t)(rowb + ((g_) >> 1) * HALF + (2 * ((g_) & 1) + (q >> 1)) * 16); const int col = col0 + (q & 1) * HALF; \
            ly[S][q] = *(const u32x4*)(YG + row * 1024 + col); lg[S][q] = *(const u32x4*)(Y + row * 2048 + col); }
        GLU_LD(0, 0)
#pragma unroll
        for (int g = 0; g < 4; ++g) {
            if (g + 1 < 4) { if ((g & 1) == 0) { GLU_LD(g + 1, 1) } else { GLU_LD(g + 1, 0) } }
#pragma unroll
            for (int q = 0; q < 4; ++q) { const int ai = g >> 1, m = 2 * (g & 1) + (q >> 1), bj = q & 1; const size_t row = (size_t)(rowb + ai * HALF + m * 16); const int col = col0 + bj * HALF;
                float y[8], gg[8], o[8]; unpack8(ly[g & 1][q], y); unpack8(lg[g & 1][q], gg);
                const f32x4 v0 = acc[ai][bj][m][0], v1 = acc[ai][bj][m][1];
                const float* gbp = gb + col; asm volatile("" : "+v"(gbp));
                const f32x4 b0 = *(const f32x4*)gbp, b1 = *(const f32x4*)(gbp + 4);
#pragma unroll
                for (int j = 0; j < 4; ++j) { o[j] = y[j] * sigm(v0[j] + b0[j]) * silu(gg[j]); o[4 + j] = y[4 + j] * sigm(v1[j] + b1[j]) * silu(gg[4 + j]); }
                *(u32x4*)(Y + row * 2048 + col) = pack8(o); }
        }
#undef GLU_LD
    }
};
struct EpiGate {
    static constexpr bool PERM = true;
    const bf16* XC; bf16* OM; const float *ba, *bx, *lam;
    __device__ __forceinline__ void operator()(AccRef acc, const Unit& u, int wr, int wc, int fr, int fq) const {
        const int rowb = u.pm * BM + wr * 64 + fr; const int h = u.pn >> 2, q = u.pn & 3, d = q >> 1, hf = q & 1;
        const int ch = h * 256 + hf * 128 + wc * 32 + 8 * fq;
        const int bq = u.pm / TPB; const bool cx = (u.pm - bq * TPB == 0) && d == 0;
        constexpr long dstep = (long)(SLAB / 2);
        bf16* const OMC = (bf16*)((char*)OM - (long)(WS_SLAB + 2 * SLAB - WS_ST)); bf16* const BT = OM + 3 * dstep;
        bf16* om = (cx ? OMC + ((long)bq * 256 - (long)u.pm * BM) * 1024 : OM + (long)d * dstep) + ch; bf16* bt = BT + (long)d * dstep + ch;
        float bav[8], bxv[8], sp[8];
#pragma unroll
        for (int j = 0; j < 8; ++j) { bav[j] = ba[d * 1024 + ch + j]; bxv[j] = bx[d * 1024 + ch + j]; sp[j] = lam[d * 1024 + ch + j]; }
        u32x4 xl[2][4];
#pragma unroll
        for (int ai = 0; ai < 2; ++ai)
#pragma unroll
            for (int m = 0; m < 4; ++m) xl[ai][m] = *(const u32x4*)(XC + (size_t)(rowb + ai * HALF + m * 16) * 1024 + ch);
#pragma unroll
        for (int ai = 0; ai < 2; ++ai)
#pragma unroll
            for (int m = 0; m < 4; ++m) { const size_t row = (size_t)(rowb + ai * HALF + m * 16);
                const f32x4 r0 = acc[ai][0][m][0], r1 = acc[ai][0][m][1], i0 = acc[ai][1][m][0], i1 = acc[ai][1][m][1];
                float x[8], o1[8], o2[8]; unpack8(xl[ai][m], x);
#pragma unroll
                for (int j = 0; j < 8; ++j) { const float vr = j < 4 ? r0[j & 3] : r1[j & 3], vi = j < 4 ? i0[j & 3] : i1[j & 3];
                    const float la = sp[j] * sigm(vr + bav[j]); float omj, mj; rg_coefs(la, omj, mj);
                    o1[j] = omj; o2[j] = mj * sigm(vi + bxv[j]) * x[j]; }
                *(u32x4*)(om + row * 1024) = pack8(o1); *(u32x4*)(bt + row * 1024) = pack8(o2); }
    }
};
struct EpiOut {
    static constexpr bool PERM = false;
    const float *srcLat, *srcCtx; float *dstLat, *dstCtx; const float* modl;
    __device__ __forceinline__ void operator()(AccRef acc, const Unit& u, int wr, int wc, int fr, int fq) const {
        const int b = u.pm / TPB, ti = u.pm - b * TPB;
        const float* src; float* dst; const float* gt;
        if (ti == 0) { src = srcCtx + (size_t)b * LCTX * D; dst = dstCtx + (size_t)b * LCTX * D; gt = modl + 4 * 3072 + 2048; }
        else { const size_t o = ((size_t)b * LLAT + (size_t)(ti - 1) * 256) * D; src = srcLat + o; dst = dstLat + o; gt = modl + b * 3072 + 2048; }
        const int rowb = wr * 64 + fr, col0 = u.pn * BM + wc * 32 + 4 * fq;
        f32x4 gv[2][2];
#pragma unroll
        for (int bj = 0; bj < 2; ++bj)
#pragma unroll
            for (int n = 0; n < 2; ++n) gv[bj][n] = *(const f32x4*)(gt + col0 + bj * HALF + n * 16);
        f32x4 xl[2][8];
#define OUT_LD(g_, S) { const float* sp_ = src + (size_t)(rowb + ((g_) >> 1) * HALF + 2 * ((g_) & 1) * 16) * D + col0; asm volatile("" : "+v"(sp_));     \
            _Pragma("unroll") for (int q = 0; q < 8; ++q) xl[S][q] = *(const f32x4*)(sp_ + (q >> 2) * 16 * D + ((q >> 1) & 1) * HALF + (q & 1) * 16); }
        OUT_LD(0, 0)
#pragma unroll
        for (int g = 0; g < 4; ++g) {
            if (g + 1 < 4) { if ((g & 1) == 0) { OUT_LD(g + 1, 1) } else { OUT_LD(g + 1, 0) } }
            float* dp_ = dst + (size_t)(rowb + (g >> 1) * HALF + 2 * (g & 1) * 16) * D + col0; asm volatile("" : "+v"(dp_));
#pragma unroll
            for (int q = 0; q < 8; ++q) { const int ai = g >> 1, m = 2 * (g & 1) + (q >> 2), bj = (q >> 1) & 1, n = q & 1;
                *(f32x4*)(dp_ + (q >> 2) * 16 * D + bj * HALF + n * 16) = xl[g & 1][q] + gv[bj][n] * acc[ai][bj][m][n]; }
        }
#undef OUT_LD
    }
};
struct CtxKOrder {
    int G, c; const char* A; size_t a_tile; const char* B; size_t b_tile;
    __device__ __forceinline__ bool next(int i, Unit& u) const {
        const int L = i * G + c; if (L >= 128) return false;
        const int ks = L & 7, pn = (L >> 3) & 3, b = L >> 5;
        u.pm = b * TPB; u.pn = pn | (ks << 8);
        u.a = A + (size_t)u.pm * a_tile + (size_t)ks * 256 * 2; u.b = B + (size_t)pn * b_tile + (size_t)ks * 256 * 2; return true;
    }
    __device__ __forceinline__ void a_ready(const Unit&) const {}
    __device__ __forceinline__ void done(const Unit&) const {}
};
struct CtxOrder {
    int G, c, c0, nN; const char* A; size_t a_tile; const char* B; size_t b_tile;
    __device__ __forceinline__ bool next(int i, Unit& u) const {
        const int L = i * G + c - c0; if (c < c0 || L >= NB * nN) return false;
        const int b = L / nN, pn = L - b * nN;
        u.pm = b * TPB; u.pn = pn; u.a = A + (size_t)u.pm * a_tile; u.b = B + (size_t)pn * b_tile; return true;
    }
    __device__ __forceinline__ void a_ready(const Unit&) const {}
    __device__ __forceinline__ void done(const Unit&) const {}
};
struct EpiPart {
    static constexpr bool PERM = false;
    float* P;
    __device__ __forceinline__ void operator()(AccRef acc, const Unit& u, int wr, int wc, int fr, int fq) const {
        const int ks = u.pn >> 8, pn = u.pn & 255, b = u.pm / TPB;
        float* dst = P + ((size_t)(ks * 4 + b) * 256 + wr * 64 + fr) * 1024 + pn * BM + wc * 32 + 4 * fq;
#pragma unroll
        for (int ai = 0; ai < 2; ++ai)
#pragma unroll
            for (int m = 0; m < 4; ++m)
#pragma unroll
                for (int bj = 0; bj < 2; ++bj)
#pragma unroll
                    for (int n = 0; n < 2; ++n) *(f32x4*)(dst + (size_t)(ai * HALF + m * 16) * 1024 + bj * HALF + n * 16) = acc[ai][bj][m][n];
    }
};
}

struct Args { const float* in[38]; float* out; unsigned char* ws; int ph_lo, ph_hi; };
#define CAS __attribute__((address_space(4)))
struct Ctx {
    LAS unsigned char* lds; int tid, lane, wave, bid, G, gw, NGW;
    const CAS char* kp; float* out; unsigned char* ws;
    __device__ __forceinline__ const float* in(int k) const { return *(const float* const CAS*)(kp + 8 * k); }
};
enum { I_X = 0, I_C, I_CTX, I_CCTX, I_NORMG, I_MODW, I_MODB, I_FINALG, I_EWIN, I_EWOUT, I_S5ARE, I_S5AIM, I_S5LOGDT, I_S5BRE, I_S5BIM, I_S5CRE, I_S5CIM, I_S5D, I_GLUW, I_GLUB,
       I_RGCW, I_RGCB, I_RGWA, I_RGBA, I_RGWX, I_RGBX, I_RGLAM, I_OWIN, I_OWOUT, I_MLCW, I_MLCB, I_MLWQ, I_MLWK, I_MLWV, I_MLWIF, I_MLBIF, I_MLNG, I_MLSKIP };

__device__ __forceinline__ const float* xrow_src(const Ctx& F, int l, int r, int lc) {
    const int b = r / SEQL, s = r - b * SEQL;
    if (s < LCTX) return (lc == 0 ? F.in(I_CTX) : (const float*)(F.ws + WS_XCTX)) + ((size_t)b * LCTX + s) * D;
    return (l == 0 ? F.in(I_X) : (const float*)F.out) + ((size_t)b * LLAT + (s - LCTX)) * D;
}

__device__ __forceinline__ void ph_mod(const Ctx& F) {
    LAS float* sl = (LAS float*)F.lds;
    LAS float* red = sl + 5 * 1024;
    for (int i = F.tid; i < 5 * 1024; i += NTHR) { const int bb = i >> 10, k = i & 1023; const float v = bb < 4 ? F.in(I_C)[bb * 1024 + k] : F.in(I_CCTX)[k]; sl[i] = silu(v); }
    __syncthreads();
    float* modv = (float*)(F.ws + WS_MODV);
    for (int it = F.bid; it < DEPTH * 48; it += F.G) {
        const int l = it / 48, j = (it - l * 48) * 64 + (F.tid & 63), kp = F.tid >> 6;
        const float* w = F.in(I_MODW) + (size_t)l * 1024 * 3072 + (size_t)(kp * 128) * 3072 + j;
        float a0 = 0.f, a1 = 0.f, a2 = 0.f, a3 = 0.f, a4 = 0.f;
#pragma unroll 16
        for (int k = 0; k < 128; ++k) { const float wv = w[(size_t)k * 3072]; const int kk = kp * 128 + k; a0 += sl[kk] * wv; a1 += sl[1024 + kk] * wv; a2 += sl[2048 + kk] * wv; a3 += sl[3072 + kk] * wv; a4 += sl[4096 + kk] * wv; }
        __syncthreads();
        red[(kp * 5 + 0) * 64 + (F.tid & 63)] = a0; red[(kp * 5 + 1) * 64 + (F.tid & 63)] = a1; red[(kp * 5 + 2) * 64 + (F.tid & 63)] = a2; red[(kp * 5 + 3) * 64 + (F.tid & 63)] = a3; red[(kp * 5 + 4) * 64 + (F.tid & 63)] = a4;
        __syncthreads();
        if (F.tid < 320) { const int bb = F.tid >> 6, jj = F.tid & 63; float t = 0.f;
#pragma unroll
            for (int q = 0; q < 8; ++q) t += red[(q * 5 + bb) * 64 + jj];
            const int jo = (it - l * 48) * 64 + jj;
            modv[((size_t)l * 5 + bb) * 3072 + jo] = t + F.in(I_MODB)[l * 3072 + jo]; }
    }
    __syncthreads();
}

__device__ __forceinline__ void transpose_item(const float* W, int N, bf16* WT, int ldw, int row_off, LAS float* scr, int item, int lane) {
    const int nblk = N / 32, kb = item / nblk, nbk = item % nblk, k0 = 64 * kb, n0 = 32 * nbk;
#pragma unroll 8
    for (int i = 0; i < 32; ++i) { const int kk = 2 * i + (lane >> 5); scr[kk * 33 + (lane & 31)] = W[(size_t)(k0 + kk) * N + n0 + (lane & 31)]; }
    WAVE_SYNC();
    const int c = lane & 7;
#pragma unroll
    for (int j = 0; j < 4; ++j) { const int n = (lane >> 3) + 8 * j; const LAS float* s = scr + (8 * c) * 33 + n;
        u32x4 o; o.x = pk2(s[0 * 33], s[1 * 33]); o.y = pk2(s[2 * 33], s[3 * 33]); o.z = pk2(s[4 * 33], s[5 * 33]); o.w = pk2(s[6 * 33], s[7 * 33]);
        *(u32x4*)(WT + (size_t)(row_off + n0 + n) * ldw + k0 + 8 * c) = o; }
    WAVE_SYNC();
}
__device__ __forceinline__ void ph_wconv_even(const Ctx& F, int j) {
    { const float* lam = F.in(I_RGLAM) + (size_t)j * 2048; float* spt = (float*)(F.ws + WS_SPT);
      for (int i = F.bid * NTHR + F.tid; i < 2048; i += F.G * NTHR) spt[i] = -8.f * softplus(-lam[i]); }
    LAS float* scr = (LAS float*)(F.lds + F.wave * 16384);
    bf16* win = (bf16*)(F.ws + WS_W + W_IN); bf16* wout = (bf16*)(F.ws + WS_W + W_OUT); bf16* wglu = (bf16*)(F.ws + WS_W + W_GLU); bf16* wgate = (bf16*)(F.ws + WS_W + W_GATE);
    constexpr int I_1 = 16 * 128, I_2 = 16 * 32, I_3 = 32 * 32, I_4 = 16 * 32;
    for (int it = F.gw; it < I_1 + I_2 + I_3 + I_4; it += F.NGW) {
        int r = it;
        if (r < I_1) { transpose_item(F.in(I_EWIN) + (size_t)j * 1024 * 4096, 4096, win, 1024, 0, scr, r, F.lane); continue; } r -= I_1;
        if (r < I_2) { transpose_item(F.in(I_GLUW) + (size_t)j * 1024 * 1024, 1024, wglu, 1024, 0, scr, r, F.lane); continue; } r -= I_2;
        if (r < I_3) { transpose_item(F.in(I_EWOUT) + (size_t)j * 2048 * 1024, 1024, wout, 2048, 0, scr, r, F.lane); continue; } r -= I_3;
        { const int mat = r >> 5, sub = r & 31, h = mat >> 2, q = mat & 3, d = q >> 1, isx = q & 1;
          const float* W = (isx ? F.in(I_RGWX) : F.in(I_RGWA)) + ((size_t)((j * 2 + d) * 4 + h)) * 256 * 256;
          const int n0 = 32 * (sub & 7);
          transpose_item(W, 256, wgate, 256, (4 * h + 2 * d + (n0 >> 7)) * 256 + isx * 128 + (n0 & 127) - n0, scr, sub, F.lane); }
    }
}
__device__ __forceinline__ void ph_wconv_odd(const Ctx& F, int j) {
    LAS float* scr = (LAS float*)(F.lds + F.wave * 16384);
    bf16* win = (bf16*)(F.ws + WS_W + W_IN); bf16* wout = (bf16*)(F.ws + WS_W + W_OUT);
    constexpr int I_1 = 16 * 128, I_3 = 32 * 32;
    for (int it = F.gw; it < I_1 + I_3; it += F.NGW) {
        int r = it;
        if (r < I_1) { transpose_item(F.in(I_OWIN) + (size_t)j * 1024 * 4096, 4096, win, 1024, 0, scr, r, F.lane); continue; } r -= I_1;
        transpose_item(F.in(I_OWOUT) + (size_t)j * 2048 * 1024, 1024, wout, 2048, 0, scr, r, F.lane);
    }
    const float* wq = F.in(I_MLWQ) + (size_t)j * 512 * 16; const float* wk = F.in(I_MLWK) + (size_t)j * 512 * 16; const float* wv = F.in(I_MLWV) + (size_t)j * 512 * 16;
    float* mg = (float*)(F.ws + WS_MG);
    for (int idx = F.bid * NTHR + F.tid; idx < 512 * 16; idx += F.G * NTHR) { const int g = idx >> 4, i = (idx >> 2) & 3, jj = idx & 3; float a = 0.f;
#pragma unroll
        for (int o = 0; o < 4; ++o) a += wq[g * 16 + i * 4 + o] * wk[g * 16 + jj * 4 + o];
        mg[idx] = a * 0.04419417382415922f; }
    unsigned* wgt = (unsigned*)(F.ws + WS_WGT);
    const float* wif = F.in(I_MLWIF) + (size_t)j * 2 * 3 * 2048 * 8;
    for (int idx = F.bid * NTHR + F.tid; idx < 1024 * 32; idx += F.G * NTHR) {
        const int cp = idx >> 5, src = (idx >> 4) & 1, o = idx & 15, d = o >> 3, n8 = o & 7; float wv2[2];
#pragma unroll
        for (int half = 0; half < 2; ++half) { const int c = 2 * cp + half, g = c >> 2, i = c & 3; float a = 0.f;
#pragma unroll
            for (int oo = 0; oo < 4; ++oo) {
                if (src) a += wv[g * 16 + i * 4 + oo] * wif[((size_t)(d * 3 + 2) * 2048 + 4 * g + oo) * 8 + n8];
                else a += wq[g * 16 + i * 4 + oo] * wif[((size_t)(d * 3 + 0) * 2048 + 4 * g + oo) * 8 + n8] + wk[g * 16 + i * 4 + oo] * wif[((size_t)(d * 3 + 1) * 2048 + 4 * g + oo) * 8 + n8]; }
            wv2[half] = a; }
        const int c0 = 2 * cp, cq = c0 >> 9, rem = c0 & 511, kk = rem >> 7, g4 = (rem >> 5) & 3, i4 = (rem >> 3) & 3, e2 = (rem & 7) >> 1;
        wgt[((size_t)(((src * 4 + cq) * 16 + kk * 4 + i4) * 64 + g4 * 16 + o)) * 4 + e2] = pk2(wv2[0], wv2[1]);
    }
}

__device__ __forceinline__ void fold_ctx(const Ctx& F, const float* P, const float* gtc, int r, f32x4 (&v)[4]) {
    const int b = r / SEQL, s = r - b * SEQL;
    if (s >= LCTX) return;
    const int row = b * LCTX + s;
    const f32x4* p = (const f32x4*)(P + (size_t)row * 1024) + F.lane;
    f32x4 a[4];
#pragma unroll
    for (int jj = 0; jj < 4; ++jj) a[jj] = p[64 * jj];
#pragma unroll
    for (int ks = 1; ks < 8; ++ks)
#pragma unroll
        for (int jj = 0; jj < 4; ++jj) a[jj] += p[(size_t)ks * (1024 * 256) + 64 * jj];
    f32x4* xo = (f32x4*)((float*)(F.ws + WS_XCTX) + (size_t)row * 1024) + F.lane;
#pragma unroll
    for (int jj = 0; jj < 4; ++jj) { const f32x4 g = *(const f32x4*)(gtc + 4 * F.lane + 256 * jj); v[jj] = v[jj] + g * a[jj]; xo[64 * jj] = v[jj]; }
}
__device__ __forceinline__ void ph_norm(const Ctx& F, int l, int r0, int r1, bf16* HB, const float* P) {
    const float* modl = (const float*)(F.ws + WS_MODV) + (size_t)l * 5 * 3072;
    const float* ng = F.in(I_NORMG) + l * 1024;
    const float* gtc = modl - 5 * 3072 + 4 * 3072 + 2048;
    const int lc = P ? l - 1 : l;
    for (int ra = r0 + F.gw; ra < r1; ra += 2 * F.NGW) {
        const int rb = ra + F.NGW; const bool hasb = rb < r1; const int rbb = hasb ? rb : ra;
        const f32x4* xa = (const f32x4*)xrow_src(F, l, ra, lc) + F.lane; const f32x4* xb = (const f32x4*)xrow_src(F, l, rbb, lc) + F.lane;
        f32x4 va[4], vb[4]; float sa = 0.f, sb = 0.f;
#pragma unroll
        for (int jj = 0; jj < 4; ++jj) { va[jj] = xa[64 * jj]; vb[jj] = xb[64 * jj]; }
        if (P) { fold_ctx(F, P, gtc, ra, va); if (hasb) fold_ctx(F, P, gtc, rb, vb); }
#pragma unroll
        for (int jj = 0; jj < 4; ++jj) { sa += (va[jj].x * va[jj].x + va[jj].y * va[jj].y) + (va[jj].z * va[jj].z + va[jj].w * va[jj].w); sb += (vb[jj].x * vb[jj].x + vb[jj].y * vb[jj].y) + (vb[jj].z * vb[jj].z + vb[jj].w * vb[jj].w); }
        const float rsa = rsqrtf(wave_sum(sa) * (1.f / D) + EPS), rsb = rsqrtf(wave_sum(sb) * (1.f / D) + EPS);
#pragma unroll
        for (int w2 = 0; w2 < 2; ++w2) { if (w2 == 1 && !hasb) break;
            const int r = w2 ? rb : ra; const float rstd = w2 ? rsb : rsa;
            const int b = r / SEQL, s = r - b * SEQL, bb = s < LCTX ? 4 : b;
            const float* sh = modl + bb * 3072; const float* sc = sh + 1024;
            unsigned long long* o8 = (unsigned long long*)(HB + (size_t)(r - r0) * D) + F.lane;
#pragma unroll
            for (int jj = 0; jj < 4; ++jj) { const int c = 4 * F.lane + 256 * jj; const f32x4 v = w2 ? vb[jj] : va[jj];
                const f32x4 g = *(const f32x4*)(ng + c), a = *(const f32x4*)(sc + c), h = *(const f32x4*)(sh + c);
                const float y0 = v.x * rstd * g.x * (1.f + a.x) + h.x, y1 = v.y * rstd * g.y * (1.f + a.y) + h.y, y2 = v.z * rstd * g.z * (1.f + a.z) + h.z, y3 = v.w * rstd * g.w * (1.f + a.w) + h.w;
                o8[64 * jj] = (unsigned long long)pk2(y0, y1) | ((unsigned long long)pk2(y2, y3) << 32); } }
    }
}

__device__ __forceinline__ void ph_rgconv(const Ctx& F, int j, const bf16* XR, bf16* XC) {
    const float* cw = F.in(I_RGCW) + (size_t)j * 4 * 1024; const float* cb = F.in(I_RGCB) + (size_t)j * 1024;
    for (int it = F.bid * NTHR + F.tid; it < M * 128; it += F.G * NTHR) {
        const int r = it >> 7, c = (it & 127) * 8, b = r / SEQL, s = r - b * SEQL;
        float a[8];
#pragma unroll
        for (int e = 0; e < 8; ++e) a[e] = cb[c + e];
#pragma unroll
        for (int t = 0; t < 4; ++t) { const int sn = nb_even(s, t - 1);
            if (sn >= 0) { float x[8]; unpack8(*(const u32x4*)(XR + ((size_t)b * SEQL + sn) * 1024 + c), x);
#pragma unroll
                for (int e = 0; e < 8; ++e) a[e] += cw[t * 1024 + c + e] * x[e]; } }
        *(u32x4*)(XC + (size_t)r * 1024 + c) = pack8(a);
    }
}

__device__ __forceinline__ void ph_s5_naive(const Ctx& F, int j, const bf16* U, bf16* YS0, bf16* YS1) {
    if ((F.wave & 3) != 0) return;
    const int slot = F.wave >> 2;
    LAS float* xre = (LAS float*)(F.lds + slot * 65536);
    LAS float* xim = xre + 64 * 65;
    LAS float* cre = xim + 64 * 65;
    LAS float* cim = cre + 1024;
    LAS float* ub = cim + 1024;
    const int p = F.lane;
    for (int q = F.bid * 2 + slot; q < NB * 2 * 64; q += F.G * 2) {
        const int b = q >> 7, d = (q >> 6) & 1, g = q & 63;
        const size_t pg = (size_t)((j * 2 + d) * 64 + g);
        const float are = F.in(I_S5ARE)[pg * 64 + p], aim = F.in(I_S5AIM)[pg * 64 + p], dt = expf(F.in(I_S5LOGDT)[pg]);
        const float dar = dt * are, dai = dt * aim, mag = expf(dar);
        const float abr = mag * cosf(dai), abi = mag * sinf(dai);
        const float den = are * are + aim * aim, nr = abr - 1.f, ni = abi;
        const float cor = (nr * are + ni * aim) / den, coi = (ni * are - nr * aim) / den;
        float bbr[16], bbi[16];
#pragma unroll
        for (int h = 0; h < 16; ++h) { const float br = F.in(I_S5BRE)[(pg * 64 + p) * 16 + h], bi = F.in(I_S5BIM)[(pg * 64 + p) * 16 + h]; bbr[h] = cor * br - coi * bi; bbi[h] = cor * bi + coi * br; }
#pragma unroll
        for (int h = 0; h < 16; ++h) { cre[h * 64 + p] = F.in(I_S5CRE)[(pg * 16 + h) * 64 + p]; cim[h * 64 + p] = F.in(I_S5CIM)[(pg * 16 + h) * 64 + p]; }
        bf16* YS = d ? YS1 : YS0;
        float sr = 0.f, si = 0.f;
        for (int ck = 0; ck < SEQL / 64; ++ck) {
            const size_t myrow = (size_t)b * SEQL + pos2s_even(ck * 64 + F.lane, d);
            { float x[8]; unpack8(*(const u32x4*)(U + myrow * 1024 + 16 * g), x);
#pragma unroll
              for (int e = 0; e < 8; ++e) ub[F.lane * 16 + e] = x[e];
              unpack8(*(const u32x4*)(U + myrow * 1024 + 16 * g + 8), x);
#pragma unroll
              for (int e = 0; e < 8; ++e) ub[F.lane * 16 + 8 + e] = x[e]; }
            WAVE_SYNC();
            for (int t = 0; t < 64; ++t) {
                float bur = 0.f, bui = 0.f;
#pragma unroll
                for (int h4 = 0; h4 < 4; ++h4) { const f32x4 uv = *(const LAS f32x4*)(ub + t * 16 + h4 * 4);
                    bur += bbr[h4 * 4] * uv.x + bbr[h4 * 4 + 1] * uv.y + bbr[h4 * 4 + 2] * uv.z + bbr[h4 * 4 + 3] * uv.w;
                    bui += bbi[h4 * 4] * uv.x + bbi[h4 * 4 + 1] * uv.y + bbi[h4 * 4 + 2] * uv.z + bbi[h4 * 4 + 3] * uv.w; }
                const float nsr = abr * sr - abi * si + bur, nsi = abr * si + abi * sr + bui;
                sr = nsr; si = nsi;
                xre[p * 65 + t] = sr; xim[p * 65 + t] = si;
            }
            WAVE_SYNC();
            float y[16];
#pragma unroll
            for (int h = 0; h < 16; ++h) y[h] = 0.f;
            for (int pp = 0; pp < 64; ++pp) { const float vr = xre[pp * 65 + F.lane], vi = xim[pp * 65 + F.lane];
#pragma unroll
                for (int h = 0; h < 16; ++h) y[h] += vr * cre[h * 64 + pp] - vi * cim[h * 64 + pp]; }
            { float o[8];
#pragma unroll
              for (int e = 0; e < 8; ++e) o[e] = y[e];
              *(u32x4*)(YS + myrow * 1024 + 16 * g) = pack8(o);
#pragma unroll
              for (int e = 0; e < 8; ++e) o[e] = y[8 + e];
              *(u32x4*)(YS + myrow * 1024 + 16 * g + 8) = pack8(o); }
            WAVE_SYNC();
        }
    }
}
typedef float f32x16s __attribute__((ext_vector_type(16)));
__device__ __forceinline__ float xhalf(const float v, const int hh) { const auto r = __builtin_amdgcn_permlane32_swap(__float_as_uint(v), __float_as_uint(v), false, false); return __uint_as_float(hh ? r[0] : r[1]); }
__device__ __forceinline__ void ph_s5_mfma(const Ctx& F, int j, bf16* U, bf16* YS0, const bf16* XR, bf16* XC) {
    const float* rcw = F.in(I_RGCW) + (size_t)j * 4 * 1024; const float* rcb = F.in(I_RGCB) + (size_t)j * 1024;
    const int rg_it0 = F.bid * NTHR + F.tid, rg_stride = F.G * NTHR; int rg_done = 0;
    const int qd = F.wave;
    constexpr int XS = 272;
    constexpr int NCQ = SEQL / 32 / 8;
    LAS unsigned char* const X = F.lds + F.wave * 8704;
    LAS bf16x8* const FRL = (LAS bf16x8*)(F.lds + 8 * 8704);
    LAS f32x4* const PWT = (LAS f32x4*)(F.lds + 8 * 8704 + 8192);
    LAS f32x4* const ES = (LAS f32x4*)(F.lds + 8 * 8704 + 24576);
    const float* dd = F.in(I_S5D) + (size_t)j * 1024;
    const int lane = F.lane, c = lane & 31, hh = lane >> 5;
    const int qb = (F.G == 256) ? ((F.bid & 7) * 32 + (F.bid >> 3)) : F.bid;
    for (int q = qb; q < NB * 64; q += F.G) {
        const int b = q >> 6, g = q & 63;
#pragma unroll 1
      for (int d = 0; d < 2; ++d) {
        const size_t pg = (size_t)((j * 2 + d) * 64 + g);
        const float dt = expf(F.in(I_S5LOGDT)[pg]);
        float abr[2], abi[2], cor[2], coi[2], a16r[2], a16i[2], aqr[2], aqi[2];
#pragma unroll
        for (int st = 0; st < 2; ++st) { const int pp = st * 32 + c; const float are = F.in(I_S5ARE)[pg * 64 + pp], aim = F.in(I_S5AIM)[pg * 64 + pp];
            const float dar = dt * are, dai = dt * aim, mag = expf(dar); abr[st] = mag * cosf(dai); abi[st] = mag * sinf(dai);
            const float den = are * are + aim * aim, nr = abr[st] - 1.f, ni = abi[st]; cor[st] = (nr * are + ni * aim) / den; coi[st] = (ni * are - nr * aim) / den;
            const float m16 = expf(16.f * dar); a16r[st] = m16 * cosf(16.f * dai); a16i[st] = m16 * sinf(16.f * dai);
            const float mq = expf((float)(NCQ * 32) * dar); aqr[st] = mq * cosf((float)(NCQ * 32) * dai); aqi[st] = mq * sinf((float)(NCQ * 32) * dai); }
        __syncthreads();
        if (qd == 0) {
            { float pr = abr[0], pi = abi[0], qr = abr[1], qi = abi[1];
#pragma unroll 1
              for (int i = 0; i < 16; ++i) { PWT[i * 64 + lane] = (f32x4){pr, pi, qr, qi};
                  const float npr = pr * abr[0] - pi * abi[0], npi = pr * abi[0] + pi * abr[0]; pr = npr; pi = npi;
                  const float nqr = qr * abr[1] - qi * abi[1], nqi = qr * abi[1] + qi * abr[1]; qr = nqr; qi = nqi; } }
#pragma unroll
            for (int st = 0; st < 2; ++st) { const int pp = st * 32 + c;
                const f32x4 br0 = *(const f32x4*)(F.in(I_S5BRE) + (pg * 64 + pp) * 16 + 8 * hh), br1 = *(const f32x4*)(F.in(I_S5BRE) + (pg * 64 + pp) * 16 + 8 * hh + 4);
                const f32x4 bi0 = *(const f32x4*)(F.in(I_S5BIM) + (pg * 64 + pp) * 16 + 8 * hh), bi1 = *(const f32x4*)(F.in(I_S5BIM) + (pg * 64 + pp) * 16 + 8 * hh + 4);
                const float brv[8] = {br0.x, br0.y, br0.z, br0.w, br1.x, br1.y, br1.z, br1.w}, biv[8] = {bi0.x, bi0.y, bi0.z, bi0.w, bi1.x, bi1.y, bi1.z, bi1.w};
                float vr[8], vi[8];
#pragma unroll
                for (int i = 0; i < 8; ++i) { vr[i] = cor[st] * brv[i] - coi[st] * biv[i]; vi[i] = cor[st] * biv[i] + coi[st] * brv[i]; }
                FRL[st * 64 + lane] = __builtin_bit_cast(bf16x8, pack8(vr)); FRL[(2 + st) * 64 + lane] = __builtin_bit_cast(bf16x8, pack8(vi)); }
#pragma unroll
            for (int ks = 0; ks < 4; ++ks) { const int c2a = 8 * ks + 2 * (lane >> 4); const size_t ro = (pg * 16 + (lane & 15)) * 64;
                const float2 r0 = *(const float2*)(F.in(I_S5CRE) + ro + c2a), r1 = *(const float2*)(F.in(I_S5CRE) + ro + 32 + c2a);
                const float2 m0 = *(const float2*)(F.in(I_S5CIM) + ro + c2a), m1 = *(const float2*)(F.in(I_S5CIM) + ro + 32 + c2a);
                const float v[8] = {r0.x, r1.x, -m0.x, -m1.x, r0.y, r1.y, -m0.y, -m1.y};
                FRL[(4 + ks) * 64 + lane] = __builtin_bit_cast(bf16x8, pack8(v)); }
        }
        __syncthreads();
        const int tau = 16 * ((c >> 2) & 1) + 4 * (c >> 3) + (c & 3);
        float cin[4] = {0.f, 0.f, 0.f, 0.f};
        const int ck0 = qd * NCQ;
#define S5_HEAD() \
                const bf16x8 ucur = unext; \
                if (ck + 1 < ck0 + NCQ) unext = *(const bf16x8*)(U + ((size_t)b * SEQL + pos2s_even(32 * (ck + 1) + tau, d)) * 1024 + 16 * g + 8 * hh); \
                f32x16s t0, t1, t2, t3; \
                _Pragma("unroll") for (int i = 0; i < 16; ++i) { t0[i] = 0.f; t1[i] = 0.f; t2[i] = 0.f; t3[i] = 0.f; } \
                t0 = __builtin_amdgcn_mfma_f32_32x32x16_bf16(ucur, FRL[lane], t0, 0, 0, 0); t1 = __builtin_amdgcn_mfma_f32_32x32x16_bf16(ucur, FRL[64 + lane], t1, 0, 0, 0); \
                t2 = __builtin_amdgcn_mfma_f32_32x32x16_bf16(ucur, FRL[128 + lane], t2, 0, 0, 0); t3 = __builtin_amdgcn_mfma_f32_32x32x16_bf16(ucur, FRL[192 + lane], t3, 0, 0, 0); \
                  \
                { float xr = 0.f, xi = 0.f, yr = 0.f, yi = 0.f; \
                  _Pragma("unroll") for (int i = 0; i < 16; ++i) { const float nr = abr[0] * xr - abi[0] * xi + t0[i], ni = abr[0] * xi + abi[0] * xr + t2[i]; t0[i] = nr; t2[i] = ni; xr = nr; xi = ni; \
                      const float mr = abr[1] * yr - abi[1] * yi + t1[i], mi = abr[1] * yi + abi[1] * yr + t3[i]; t1[i] = mr; t3[i] = mi; yr = mr; yi = mi; } } \
                __builtin_amdgcn_sched_barrier(0); \
                  \
                float ce[4]; \
                { const float l0 = xhalf(t0[15], hh), l2 = xhalf(t2[15], hh), l1 = xhalf(t1[15], hh), l3 = xhalf(t3[15], hh); \
                  const float e0 = l0 + (a16r[0] * cin[0] - a16i[0] * cin[1]), e1 = l2 + (a16r[0] * cin[1] + a16i[0] * cin[0]); \
                  const float e2 = l1 + (a16r[1] * cin[2] - a16i[1] * cin[3]), e3 = l3 + (a16r[1] * cin[3] + a16i[1] * cin[2]); \
                  ce[0] = hh ? e0 : cin[0]; ce[1] = hh ? e1 : cin[1]; ce[2] = hh ? e2 : cin[2]; ce[3] = hh ? e3 : cin[3]; }
        {
            bf16x8 unext = *(const bf16x8*)(U + ((size_t)b * SEQL + pos2s_even(32 * ck0 + tau, d)) * 1024 + 16 * g + 8 * hh);
            const bool rgride = (d == 0) && (q == qb);
#pragma unroll 1
            for (int ck = ck0; ck < ck0 + NCQ; ++ck) {
                const int rit = rg_it0 + (ck - ck0) * rg_stride; const bool rgo = rgride && rit < M * 128;
                const int rr = rit >> 7, rc = (rit & 127) * 8, rbt = rr / SEQL, rs_ = rr - rbt * SEQL;
                u32x4 rx[4];
#pragma unroll
                for (int t = 0; t < 4; ++t) rx[t] = (u32x4){0u, 0u, 0u, 0u};
                if (rgo) {
#pragma unroll
                    for (int t = 0; t < 4; ++t) { const int sn = nb_even(rs_, t - 1); if (sn >= 0) rx[t] = *(const u32x4*)(XR + ((size_t)rbt * SEQL + sn) * 1024 + rc); } }
                S5_HEAD()
                const float n0 = t0[15] + (a16r[0] * ce[0] - a16i[0] * ce[1]), n1 = t2[15] + (a16r[0] * ce[1] + a16i[0] * ce[0]);
                const float n2 = t1[15] + (a16r[1] * ce[2] - a16i[1] * ce[3]), n3 = t3[15] + (a16r[1] * ce[3] + a16i[1] * ce[2]);
                const float o0 = xhalf(n0, hh), o1 = xhalf(n1, hh), o2 = xhalf(n2, hh), o3 = xhalf(n3, hh);
                cin[0] = hh ? n0 : o0; cin[1] = hh ? n1 : o1; cin[2] = hh ? n2 : o2; cin[3] = hh ? n3 : o3;
                if (rgo) { float a[8];
#pragma unroll
                    for (int e = 0; e < 8; ++e) a[e] = rcb[rc + e];
#pragma unroll
                    for (int t = 0; t < 4; ++t) { float x[8]; unpack8(rx[t], x);
#pragma unroll
                        for (int e = 0; e < 8; ++e) a[e] += rcw[t * 1024 + rc + e] * x[e]; }
                    *(u32x4*)(XC + (size_t)rr * 1024 + rc) = pack8(a); }
            }
            if (rgride) rg_done = NCQ;
            ES[qd * 64 + lane] = (f32x4){cin[0], cin[1], cin[2], cin[3]};
            __syncthreads();
            float c0 = 0.f, c1 = 0.f, c2 = 0.f, c3 = 0.f;
            for (int k = 0; k < qd; ++k) { const f32x4 e = ES[k * 64 + lane];
                const float n0 = aqr[0] * c0 - aqi[0] * c1 + e.x, n1 = aqr[0] * c1 + aqi[0] * c0 + e.y, n2 = aqr[1] * c2 - aqi[1] * c3 + e.z, n3 = aqr[1] * c3 + aqi[1] * c2 + e.w;
                c0 = n0; c1 = n1; c2 = n2; c3 = n3; }
            cin[0] = c0; cin[1] = c1; cin[2] = c2; cin[3] = c3;
        }
        {
            bf16x8 unext = *(const bf16x8*)(U + ((size_t)b * SEQL + pos2s_even(32 * ck0 + tau, d)) * 1024 + 16 * g + 8 * hh);
#pragma unroll 1
            for (int ck = ck0; ck < ck0 + NCQ; ++ck) {
                S5_HEAD()
#pragma unroll
                for (int i = 0; i < 16; ++i) { const f32x4 pw = PWT[i * 64 + lane];
                    t0[i] += pw.x * ce[0] - pw.y * ce[1]; t2[i] += pw.x * ce[1] + pw.y * ce[0]; t1[i] += pw.z * ce[2] - pw.w * ce[3]; t3[i] += pw.z * ce[3] + pw.w * ce[2]; }
                { const float o0 = xhalf(t0[15], hh), o1 = xhalf(t2[15], hh), o2 = xhalf(t1[15], hh), o3 = xhalf(t3[15], hh);
                  cin[0] = hh ? t0[15] : o0; cin[1] = hh ? t2[15] : o1; cin[2] = hh ? t1[15] : o2; cin[3] = hh ? t3[15] : o3; }
                __builtin_amdgcn_sched_barrier(0);
#pragma unroll
                for (int i = 0; i < 16; ++i) { u32x2 w; w.x = pk2(t0[i], t1[i]); w.y = pk2(t2[i], t3[i]); *(LAS u32x2*)(X + (16 * hh + i) * XS + 8 * c) = w; }
                WAVE_SYNC();
                __builtin_amdgcn_sched_barrier(0);
                f32x4 y0 = (f32x4){0.f, 0.f, 0.f, 0.f}, y1 = (f32x4){0.f, 0.f, 0.f, 0.f};
#pragma unroll
                for (int ks = 0; ks < 4; ++ks) { const bf16x8 x0 = *(const LAS bf16x8*)(X + (lane & 15) * XS + 64 * ks + 16 * (lane >> 4)), x1 = *(const LAS bf16x8*)(X + (16 + (lane & 15)) * XS + 64 * ks + 16 * (lane >> 4));
                    const bf16x8 cf = FRL[(4 + ks) * 64 + lane]; y0 = __builtin_amdgcn_mfma_f32_16x16x32_bf16(cf, x0, y0, 0, 0, 0); y1 = __builtin_amdgcn_mfma_f32_16x16x32_bf16(cf, x1, y1, 0, 0, 0); }
                { const size_t o0 = ((size_t)b * SEQL + pos2s_even(32 * ck + (lane & 15), d)) * 1024 + 16 * g + 4 * (lane >> 4), o1 = ((size_t)b * SEQL + pos2s_even(32 * ck + 16 + (lane & 15), d)) * 1024 + 16 * g + 4 * (lane >> 4);
                  if (d == 0) { u32x2 w; w.x = pk2(y0[0], y0[1]); w.y = pk2(y0[2], y0[3]); *(u32x2*)(YS0 + o0) = w;
                      w.x = pk2(y1[0], y1[1]); w.y = pk2(y1[2], y1[3]); *(u32x2*)(YS0 + o1) = w; }
                  else {
                      const unsigned long long f0 = __hip_atomic_load((const unsigned long long*)(YS0 + o0), __ATOMIC_RELAXED, __HIP_MEMORY_SCOPE_AGENT), f1 = __hip_atomic_load((const unsigned long long*)(YS0 + o1), __ATOMIC_RELAXED, __HIP_MEMORY_SCOPE_AGENT);
                      const u32x2 u0 = *(const u32x2*)(U + o0), u1 = *(const u32x2*)(U + o1);
                      const f32x4 dv = *(const f32x4*)(dd + 16 * g + 4 * (lane >> 4));
                      const unsigned fa0 = (unsigned)f0, fb0 = (unsigned)(f0 >> 32), fa1 = (unsigned)f1, fb1 = (unsigned)(f1 >> 32);
                      u32x2 w;
                      w.x = pk2(gelu_tanh(bf2f(fa0 & 0xffffu) + y0[0] + dv.x * bf2f(u0.x & 0xffffu)), gelu_tanh(bf2f(fa0 >> 16) + y0[1] + dv.y * bf2f(u0.x >> 16)));
                      w.y = pk2(gelu_tanh(bf2f(fb0 & 0xffffu) + y0[2] + dv.z * bf2f(u0.y & 0xffffu)), gelu_tanh(bf2f(fb0 >> 16) + y0[3] + dv.w * bf2f(u0.y >> 16)));
                      *(u32x2*)(U + o0) = w;
                      w.x = pk2(gelu_tanh(bf2f(fa1 & 0xffffu) + y1[0] + dv.x * bf2f(u1.x & 0xffffu)), gelu_tanh(bf2f(fa1 >> 16) + y1[1] + dv.y * bf2f(u1.x >> 16)));
                      w.y = pk2(gelu_tanh(bf2f(fb1 & 0xffffu) + y1[2] + dv.z * bf2f(u1.y & 0xffffu)), gelu_tanh(bf2f(fb1 >> 16) + y1[3] + dv.w * bf2f(u1.y >> 16)));
                      *(u32x2*)(U + o1) = w; } }
                WAVE_SYNC();
            }
        }
#undef S5_HEAD
      }
    }
    for (int it = rg_it0 + rg_done * rg_stride; it < M * 128; it += rg_stride) {
        const int r = it >> 7, c = (it & 127) * 8, b = r / SEQL, s = r - b * SEQL;
        float a[8];
#pragma unroll
        for (int e = 0; e < 8; ++e) a[e] = rcb[c + e];
#pragma unroll
        for (int t = 0; t < 4; ++t) { const int sn = nb_even(s, t - 1);
            if (sn >= 0) { float x[8]; unpack8(*(const u32x4*)(XR + ((size_t)b * SEQL + sn) * 1024 + c), x);
#pragma unroll
                for (int e = 0; e < 8; ++e) a[e] += rcw[t * 1024 + c + e] * x[e]; } }
        *(u32x4*)(XC + (size_t)r * 1024 + c) = pack8(a);
    }
    __syncthreads();
}
__device__ __forceinline__ void ph_s5_post(const Ctx& F, int j, bf16* U, const bf16* YS0, const bf16* YS1) {
    const float* dd = F.in(I_S5D) + (size_t)j * 1024;
    const int stride = F.G * NTHR;
    for (int it = F.bid * NTHR + F.tid; it < M * 128; it += 2 * stride) {
        const int it2 = it + stride; const bool has2 = it2 < M * 128;
        const size_t o1 = (size_t)it * 8, o2 = (size_t)(has2 ? it2 : it) * 8; const int c1 = (it & 127) * 8, c2 = ((has2 ? it2 : it) & 127) * 8;
        const u32x4 u1 = *(const u32x4*)(U + o1), a1 = *(const u32x4*)(YS0 + o1), b1 = *(const u32x4*)(YS1 + o1);
        const u32x4 u2 = *(const u32x4*)(U + o2), a2 = *(const u32x4*)(YS0 + o2), b2 = *(const u32x4*)(YS1 + o2);
        { float u[8], a[8], b[8], o[8]; unpack8(u1, u); unpack8(a1, a); unpack8(b1, b);
#pragma unroll
          for (int e = 0; e < 8; ++e) o[e] = gelu_tanh(a[e] + b[e] + dd[c1 + e] * u[e]);
          *(u32x4*)(U + o1) = pack8(o); }
        if (has2) { float u[8], a[8], b[8], o[8]; unpack8(u2, u); unpack8(a2, a); unpack8(b2, b);
#pragma unroll
          for (int e = 0; e < 8; ++e) o[e] = gelu_tanh(a[e] + b[e] + dd[c2 + e] * u[e]);
          *(u32x4*)(U + o2) = pack8(o); }
    }
}
__device__ __forceinline__ void ph_rgscan_a(const Ctx& F, const bf16* OM0, const bf16* OM1, const bf16* BT0, const bf16* BT1, float* RGE, float* RGP, const bf16* OMC) {
    for (int it = F.wave * F.G + F.bid; it < NB * 2 * TPB * 4; it += F.NGW) {
        const int cg = it & 3, k = (it >> 2) % TPB, bd = (it >> 2) / TPB, b = bd >> 1, d = bd & 1, ch = cg * 256 + 4 * F.lane;
        const int r0 = pos2s_even(256 * k, d); const long rs = d ? -1024 : 1024;
        const bf16* OM = (d ? OM1 + ((size_t)b * SEQL + r0) * 1024 : (k == 0 ? OMC + ((size_t)b * 256 + r0) * 1024 : OM0 + ((size_t)b * SEQL + r0) * 1024)) + ch;
        const bf16* BT = (d ? BT1 : BT0) + ((size_t)b * SEQL + r0) * 1024 + ch;
        float h0 = 0.f, h1 = 0.f, h2 = 0.f, h3 = 0.f, p0 = 1.f, p1 = 1.f, p2 = 1.f, p3 = 1.f;
        u32x2 ow[16], bw[16], on[16], bn[16];
#pragma unroll
        for (int e = 0; e < 16; ++e) { ow[e] = *(const u32x2*)(OM + e * rs); bw[e] = *(const u32x2*)(BT + e * rs); }
#pragma unroll 1
        for (int t = 0; t < 256; t += 16) {
            const int tn = t + 16 < 256 ? t + 16 : t;
#pragma unroll
            for (int e = 0; e < 16; ++e) { on[e] = *(const u32x2*)(OM + (tn + e) * rs); bn[e] = *(const u32x2*)(BT + (tn + e) * rs); }
#pragma unroll
            for (int e = 0; e < 16; ++e) {
                const float a0 = 1.f - bf2f(ow[e].x & 0xffffu), a1 = 1.f - bf2f(ow[e].x >> 16), a2 = 1.f - bf2f(ow[e].y & 0xffffu), a3 = 1.f - bf2f(ow[e].y >> 16);
                h0 = a0 * h0 + bf2f(bw[e].x & 0xffffu); p0 *= a0; h1 = a1 * h1 + bf2f(bw[e].x >> 16); p1 *= a1;
                h2 = a2 * h2 + bf2f(bw[e].y & 0xffffu); p2 *= a2; h3 = a3 * h3 + bf2f(bw[e].y >> 16); p3 *= a3; }
#pragma unroll
            for (int e = 0; e < 16; ++e) { ow[e] = on[e]; bw[e] = bn[e]; }
        }
        const size_t o = ((size_t)bd * TPB + k) * 1024 + ch;
        *(f32x4*)(RGE + o) = (f32x4){h0, h1, h2, h3}; *(f32x4*)(RGP + o) = (f32x4){p0, p1, p2, p3};
    }
}
__device__ __forceinline__ void rg_carry(const float* RGE, const float* RGP, const size_t o, const int nk, float& h0, float& h1) {
    h0 = 0.f; h1 = 0.f;
#pragma unroll 1
    for (int k0 = 0; k0 < nk; k0 += 8) {
        float2 e[8], p[8];
#pragma unroll
        for (int i = 0; i < 8; ++i) { const int kk = k0 + i < nk ? k0 + i : nk - 1; e[i] = *(const float2*)(RGE + o + (size_t)kk * 1024); p[i] = *(const float2*)(RGP + o + (size_t)kk * 1024); }
#pragma unroll
        for (int i = 0; i < 8; ++i) if (k0 + i < nk) { h0 = p[i].x * h0 + e[i].x; h1 = p[i].y * h1 + e[i].y; }
    }
}
__device__ __forceinline__ void ph_rgscan_c(const Ctx& F, const bf16* OM0, const bf16* OM1, bf16* BT0, const bf16* BT1, const float* RGE, const float* RGP, bf16* Y, const bf16* OMC) {
    for (int it = F.wave * F.G + F.bid; it < NB * TPB * 8; it += F.NGW) {
        const int cg = it & 7, ti = (it >> 3) % TPB, b = (it >> 3) / TPB, ch = cg * 128 + 2 * F.lane;
        const size_t rb = (size_t)b * SEQL + 256 * ti;
        float h0, h1;
        rg_carry(RGE, RGP, ((size_t)(b * 2 + 0) * TPB) * 1024 + ch, ti, h0, h1);
        {
            const bf16* OM = (ti == 0 ? OMC + (size_t)b * 256 * 1024 : OM0 + rb * 1024) + ch; bf16* BT = BT0 + rb * 1024 + ch;
            unsigned ow[16], bw[16], on[16], bn[16];
#pragma unroll
            for (int e = 0; e < 16; ++e) { ow[e] = *(const unsigned*)(OM + (size_t)e * 1024); bw[e] = *(const unsigned*)(BT + (size_t)e * 1024); }
#pragma unroll 1
            for (int t = 0; t < 256; t += 16) {
                const int tn = t + 16 < 256 ? t + 16 : t;
#pragma unroll
                for (int e = 0; e < 16; ++e) { on[e] = *(const unsigned*)(OM + (size_t)(tn + e) * 1024); bn[e] = *(const unsigned*)(BT + (size_t)(tn + e) * 1024); }
#pragma unroll
                for (int e = 0; e < 16; ++e) {
                    h0 = (1.f - bf2f(ow[e] & 0xffffu)) * h0 + bf2f(bw[e] & 0xffffu); h1 = (1.f - bf2f(ow[e] >> 16)) * h1 + bf2f(bw[e] >> 16);
                    *(unsigned*)(BT + (size_t)(t + e) * 1024) = pk2(h0, h1); }
#pragma unroll
                for (int e = 0; e < 16; ++e) { ow[e] = on[e]; bw[e] = bn[e]; }
            }
        }
        const int kb = ti == 0 ? 0 : TPB - ti;
        rg_carry(RGE, RGP, ((size_t)(b * 2 + 1) * TPB) * 1024 + ch, kb, h0, h1);
        {
            const bf16* OM = OM1 + (rb + 255) * 1024 + ch; const bf16* BT = BT1 + (rb + 255) * 1024 + ch; const bf16* HF = BT0 + (rb + 255) * 1024 + ch; bf16* YR = Y + (rb + 255) * 2048 + 1024 + ch;
            unsigned ow[16], bw[16], hw[16], gw_[16], on[16], bn[16], hn[16], gn[16];
#define RGC_LD(t_, O, B, H, G) _Pragma("unroll") for (int e = 0; e < 16; ++e) { const long ro_ = -(long)((t_) + e); O[e] = *(const unsigned*)(OM + ro_ * 1024); B[e] = *(const unsigned*)(BT + ro_ * 1024); \
                H[e] = __hip_atomic_load((const unsigned*)(HF + ro_ * 1024), __ATOMIC_RELAXED, __HIP_MEMORY_SCOPE_AGENT); G[e] = *(const unsigned*)(YR + ro_ * 2048); }
            RGC_LD(0, ow, bw, hw, gw_)
#pragma unroll 1
            for (int t = 0; t < 256; t += 16) {
                const int tn = t + 16 < 256 ? t + 16 : t;
                RGC_LD(tn, on, bn, hn, gn)
#pragma unroll
                for (int e = 0; e < 16; ++e) {
                    h0 = (1.f - bf2f(ow[e] & 0xffffu)) * h0 + bf2f(bw[e] & 0xffffu); h1 = (1.f - bf2f(ow[e] >> 16)) * h1 + bf2f(bw[e] >> 16);
                    const float o0 = (bf2f(hw[e] & 0xffffu) + h0) * silu(bf2f(gw_[e] & 0xffffu)), o1 = (bf2f(hw[e] >> 16) + h1) * silu(bf2f(gw_[e] >> 16));
                    *(unsigned*)(YR - (long)(t + e) * 2048) = pk2(o0, o1); }
#pragma unroll
                for (int e = 0; e < 16; ++e) { ow[e] = on[e]; bw[e] = bn[e]; hw[e] = hn[e]; gw_[e] = gn[e]; }
            }
#undef RGC_LD
        }
    }
}

typedef __bf16 v2bf __attribute__((ext_vector_type(2)));
__device__ __forceinline__ float dot2bf(const unsigned a, const unsigned b, const float c) { return __builtin_amdgcn_fdot2_f32_bf16(__builtin_bit_cast(v2bf, a), __builtin_bit_cast(v2bf, b), c, false); }
__device__ __forceinline__ void ph_convq(const Ctx& F, int j, int hb, const bf16* XM, bf16* XCV, bf16* QP) {
    constexpr int NT = MH / 16, NTX = NT / 8;
    const bool xmap = (F.G & 7) == 0;
    const int xq = F.bid & 7, cu = F.bid >> 3, cpx = F.G >> 3;
    int ntile = xmap ? (NTX - cu + cpx - 1) / cpx : (NT - F.bid + F.G - 1) / F.G; ntile = ntile < 0 ? 0 : ntile;
#define CQ_TILE(slot_) (xmap ? 4 * (cu + cpx * (slot_) + NTX * (xq >> 2)) + (xq & 3) : F.bid + F.G * (slot_))
    const float* cw = F.in(I_MLCW) + (size_t)j * 4 * 2048; const float* cb = F.in(I_MLCB) + (size_t)j * 2048;
    const float* mg = (const float*)(F.ws + WS_MG);
    const float* bif = F.in(I_MLBIF) + (size_t)j * 16;
    float* gate = (float*)(F.ws + WS_GATE);
    const int nrows = 2 * ntile;
    {
        LAS f32x4* const WQ = (LAS f32x4*)F.lds;
        for (int i = F.tid; i < 4 * 18 * 64; i += NTHR) { const int ln = i & 63, q = (i >> 6) % 18, k = i / (18 * 64), c = 8 * ln + 512 * k;
            const float* src = q < 8 ? cw + (q >> 1) * 2048 + c + 4 * (q & 1) : (q < 10 ? cb + c + 4 * (q - 8) : mg + (size_t)((c >> 2) + ((q - 10) >> 2)) * 16 + 4 * ((q - 10) & 3));
            WQ[i] = *(const f32x4*)src; }
        __syncthreads();
        u32x4 cur[4][4]; float ma[4], mn[4]; int nrw[4];
#define CQ_NEXT(n_) do { const int nn_ = (n_); const int rl_ = CQ_TILE(nn_ >> 1) * 16 + 2 * F.wave + (nn_ & 1); const int r_ = hb * MH + rl_, b_ = r_ / SEQL, s2_ = r_ - b_ * SEQL; \
            _Pragma("unroll") for (int t = 0; t < 4; ++t) { const int sn = nb_odd(s2_, t - 1); const bool ok = sn >= 0; nrw[t] = ok ? (b_ * SEQL + sn - hb * MH) : rl_; mn[t] = ok ? 1.f : 0.f; } } while (0)
        if (nrows > 0) { CQ_NEXT(0);
#pragma unroll
            for (int k = 0; k < 4; ++k)
#pragma unroll
                for (int t = 0; t < 4; ++t) cur[k][t] = *(const u32x4*)(XM + (size_t)nrw[t] * 2048 + 8 * F.lane + 512 * k); }
#pragma unroll 1
        for (int n = 0; n < nrows; ++n) {
#pragma unroll
            for (int t = 0; t < 4; ++t) ma[t] = mn[t];
            const int rl = CQ_TILE(n >> 1) * 16 + 2 * F.wave + (n & 1);
            CQ_NEXT(n + 1 < nrows ? n + 1 : n);
#pragma unroll
            for (int k = 0; k < 4; ++k) {
                const int c = 8 * F.lane + 512 * k;
                const LAS f32x4* wl = WQ + (k * 18) * 64 + F.lane;
                float a[8];
                { const f32x4 b0 = wl[8 * 64], b1 = wl[9 * 64]; a[0] = b0.x; a[1] = b0.y; a[2] = b0.z; a[3] = b0.w; a[4] = b1.x; a[5] = b1.y; a[6] = b1.z; a[7] = b1.w; }
#pragma unroll
                for (int t = 0; t < 4; ++t) { float x[8]; unpack8(cur[k][t], x); const f32x4 w0 = wl[(2 * t) * 64], w1 = wl[(2 * t + 1) * 64];
                    a[0] += w0.x * (ma[t] * x[0]); a[1] += w0.y * (ma[t] * x[1]); a[2] += w0.z * (ma[t] * x[2]); a[3] += w0.w * (ma[t] * x[3]);
                    a[4] += w1.x * (ma[t] * x[4]); a[5] += w1.y * (ma[t] * x[5]); a[6] += w1.z * (ma[t] * x[6]); a[7] += w1.w * (ma[t] * x[7]); }
#pragma unroll
                for (int e = 0; e < 8; ++e) a[e] = silu(a[e]);
                *(u32x4*)(XCV + (size_t)rl * 2048 + c) = pack8(a);
                float qv[8];
#pragma unroll
                for (int blk = 0; blk < 2; ++blk) { const f32x4 m0 = wl[(10 + blk * 4 + 0) * 64], m1 = wl[(10 + blk * 4 + 1) * 64], m2 = wl[(10 + blk * 4 + 2) * 64], m3 = wl[(10 + blk * 4 + 3) * 64];
#pragma unroll
                    for (int jj = 0; jj < 4; ++jj) qv[blk * 4 + jj] = a[blk * 4 + 0] * m0[jj] + a[blk * 4 + 1] * m1[jj] + a[blk * 4 + 2] * m2[jj] + a[blk * 4 + 3] * m3[jj]; }
                { const int half = (c >> 3) & 1; bf16* qb = QP + (size_t)rl * 2048 + (c & ~15) + 4 * half;
                  u32x2 w0, w1; w0.x = pk2(qv[0], qv[1]); w0.y = pk2(qv[2], qv[3]); w1.x = pk2(qv[4], qv[5]); w1.y = pk2(qv[6], qv[7]);
                  *(u32x2*)qb = w0; *(u32x2*)(qb + 8) = w1; }
#pragma unroll
                for (int t = 0; t < 4; ++t) cur[k][t] = *(const u32x4*)(XM + (size_t)nrw[t] * 2048 + c);
                __builtin_amdgcn_sched_barrier(0);
            }
        }
#undef CQ_NEXT
    }
    __builtin_amdgcn_fence(__ATOMIC_RELEASE, "workgroup");
    asm volatile("s_waitcnt vmcnt(0)" ::: "memory");
    __syncthreads();
    __builtin_amdgcn_fence(__ATOMIC_ACQUIRE, "workgroup");
    {
        const int w = F.wave; const bf16* SRC = (w >> 2) ? XM : XCV;
        const u32x4* tb = (const u32x4*)(F.ws + WS_WGT) + (size_t)(w * 16) * 64 + F.lane;
        bf16x8 bfr[16];
#pragma unroll
        for (int st = 0; st < 16; ++st) bfr[st] = __builtin_bit_cast(bf16x8, tb[st * 64]);
        const bf16* cbase = SRC + (size_t)(F.lane & 15) * 2048 + (w & 3) * 512 + (F.lane >> 4) * 32;
        LAS f32x4* part = (LAS f32x4*)F.lds;
        bf16x8 cur[16], nxt[16];
#define CQ_LOADT(slot_, AV) do { const bf16* rp_ = cbase + (size_t)CQ_TILE(slot_) * 16 * 2048; \
            _Pragma("unroll") for (int st = 0; st < 16; ++st) AV[st] = *(const bf16x8*)(rp_ + (st >> 2) * 128 + (st & 3) * 8); } while (0)
        if (ntile > 0) CQ_LOADT(0, cur);
#pragma unroll 1
        for (int slot = 0; slot < ntile; ++slot) {
            { const int sn = slot + 1 < ntile ? slot + 1 : ntile - 1; CQ_LOADT(sn, nxt); }
            f32x4 acc = (f32x4){0.f, 0.f, 0.f, 0.f};
#pragma unroll
            for (int st = 0; st < 16; ++st) acc = __builtin_amdgcn_mfma_f32_16x16x32_bf16(cur[st], bfr[st], acc, 0, 0, 0);
            part[(slot * 8 + w) * 64 + F.lane] = acc;
#pragma unroll
            for (int st = 0; st < 16; ++st) cur[st] = nxt[st];
        }
#undef CQ_LOADT
        __syncthreads();
        for (int idx = F.tid; idx < ntile * 256; idx += NTHR) { const int slot = idx >> 8, o = idx & 255, ln = o & 63, i = o >> 6;
            float v = 0.f;
#pragma unroll
            for (int ww = 0; ww < 8; ++ww) v += ((const LAS float*)part)[((slot * 8 + ww) * 64 + ln) * 4 + i];
            const int n = ln & 15, m = 4 * (ln >> 4) + i, r = hb * MH + CQ_TILE(slot) * 16 + m, d = n >> 3, n8 = n & 7;
            v += bif[n];
            gate[((size_t)d * M + r) * 8 + n8] = n8 >= 4 ? logsigmoid(v) : v; }
    }
#undef CQ_TILE
    __syncthreads();
}

__device__ __forceinline__ void odd_chunk_rows(const int ck, const int d, int& rb, int& rs) {
    if (ck < LCTX / 64) { rb = d == 0 ? ck * 64 : LCTX - 1 - ck * 64; rs = d == 0 ? 1 : -1; }
    else { const int q0 = ck * 64 - LCTX, lo = q0 & 127, hi = q0 >> 7;
        if (d == 0) { rb = LCTX + lo * 64 + hi; rs = 64; } else { rb = LCTX + (127 - lo) * 64 + 63 - hi; rs = -64; } }
}
__device__ __forceinline__ void ph_mscan(const Ctx& F, int hb) {
    if (F.bid >= 16) return;
    const int sq = F.bid, b = hb * 2 + (sq >> 3), n = (sq >> 1) & 3, d = sq & 1;
    const float* gate = (const float*)(F.ws + WS_GATE) + (size_t)d * M * 8;
    LAS float* be = (LAS float*)F.lds; LAS float* um = be + 192; LAS float* ms = um + 192;
    const int ck = F.tid; const bool act = ck < NCH;
    float li[64], lf[64];
    if (act) {
        int rb, rs; odd_chunk_rows(ck, d, rb, rs);
        const float* gp = gate + ((size_t)b * SEQL + rb) * 8 + n; const long gs = (long)rs * 8;
#pragma unroll
        for (int e = 0; e < 64; ++e) { li[e] = gp[e * gs]; lf[e] = gp[e * gs + 4]; }
        float bs = 0.f, umax = -3.0e38f;
#pragma unroll
        for (int e = 0; e < 64; ++e) { bs += lf[e]; umax = fmaxf(umax, li[e] - bs); }
        be[ck] = bs; um[ck] = umax;
    }
    __syncthreads();
    if (F.tid == 0) { float m = 0.f;
#pragma unroll
        for (int c4 = 0; c4 < NCH; c4 += 4) { const f32x4 b4 = *(const LAS f32x4*)(be + c4), u4 = *(const LAS f32x4*)(um + c4); f32x4 m4;
            m4.x = m; m = b4.x + fmaxf(m, u4.x); m4.y = m; m = b4.y + fmaxf(m, u4.y); m4.z = m; m = b4.z + fmaxf(m, u4.z); m4.w = m; m = b4.w + fmaxf(m, u4.w);
            *(LAS f32x4*)(ms + c4) = m4; } }
    __syncthreads();
    if (act) {
        float* ps = (float*)(F.ws + WS_PS) + (size_t)sq * SEQL * 4; float* pc = (float*)(F.ws + WS_PC) + (size_t)sq * NCH * 4;
        const float m = ms[ck]; float bs = 0.f, cm = m, mt = 0.f;
#pragma unroll
        for (int e = 0; e < 64; ++e) { bs += lf[e]; const float u = li[e] - bs; cm = fmaxf(cm, u); mt = bs + cm;
            *(f32x4*)(ps + (size_t)(ck * 64 + e) * 4) = (f32x4){bs - mt, u, __expf(m - cm), mt}; }
        *(f32x4*)(pc + (size_t)ck * 4) = (f32x4){bs, mt, __expf(bs + m - mt), m};
    }
    __syncthreads();
}

__device__ __forceinline__ void ph_stilde(const Ctx& F, int hb, const bf16* QP, const bf16* XCV) {
    constexpr int LDR = 520;
    LAS bf16* ql = (LAS bf16*)F.lds; LAS bf16* kl = ql + 64 * LDR;
    LAS float* red = (LAS float*)(kl + 64 * LDR);
    LAS float* rsum = red + 4 * 16 * 64;
    LAS float* cwl = rsum + 128;
    bf16* DN = (bf16*)(F.ws + WS_DN);
    const float* PC = (const float*)(F.ws + WS_PC);
    bf16* ST = (bf16*)(F.ws + WS_ST); float* DS = (float*)(F.ws + WS_DS); const float* PS = (const float*)(F.ws + WS_PS);
    const int lane = F.lane, w = F.wave, r = lane & 31, h = lane >> 5;
    const int tile = w & 3, st = tile & 1, tt = tile >> 1, kh = w >> 2;
    u32x4 qg[8], kg[8]; float pc0n = 0.f, pc1n = 0.f, psn = 0.f;
#define ST_SQ(it_) ((((it_) >> 2) & 1) * 8 + ((it_) & 3) * 2 + (((it_) >> 3) & 1))
#define ST_CK(it_) (((((it_) >> 3) & 1) == 0) ? ((it_) >> 4) : (((it_) >> 4) < LCTX / 64 ? LCTX / 64 - 1 - ((it_) >> 4) : NCH + LCTX / 64 - 1 - ((it_) >> 4)))
#define ST_LOAD(it_) do { const int sq_ = ST_SQ(it_), ck_ = ST_CK(it_); int rb_, rs_; odd_chunk_rows(ck_, sq_ & 1, rb_, rs_); \
        const size_t o_ = (size_t)((sq_ >> 3) * SEQL + rb_ + w * rs_) * 2048 + ((sq_ >> 1) & 3) * 512 + 8 * lane; const long st_ = (long)rs_ * (8 * 2048); \
        _Pragma("unroll") for (int k_ = 0; k_ < 8; ++k_) { qg[k_] = *(const u32x4*)(QP + o_ + k_ * st_); kg[k_] = *(const u32x4*)(XCV + o_ + k_ * st_); } \
        if (w == 0) { const float* pcq_ = PC + ((size_t)sq_ * NCH + ck_) * 4; pc0n = pcq_[0]; pc1n = pcq_[1]; psn = PS[((size_t)sq_ * SEQL + ck_ * 64 + lane) * 4 + 1]; } } while (0)
    if (F.bid < 16 * NCH) ST_LOAD(F.bid);
    for (int it = F.bid; it < 16 * NCH; it += F.G) {
        const int sq = ST_SQ(it), ck = ST_CK(it);
        __syncthreads();
        { const int c8 = 8 * lane, hq = (c8 >> 3) & 1, g16 = c8 & ~15;
#pragma unroll
          for (int k_ = 0; k_ < 8; ++k_) { const int t = w + 8 * k_; u32x2 lo, hi; lo.x = qg[k_].x; lo.y = qg[k_].y; hi.x = qg[k_].z; hi.y = qg[k_].w;
              *(LAS u32x2*)(ql + t * LDR + g16 + 4 * hq) = lo; *(LAS u32x2*)(ql + t * LDR + g16 + 8 + 4 * hq) = hi;
              *(LAS u32x4*)(kl + t * LDR + c8) = kg[k_]; } }
        if (w == 0) cwl[lane] = __expf(pc0n + psn - pc1n);
        __syncthreads();
        const float* psq = PS + ((size_t)sq * SEQL + ck * 64) * 4;
        const int t = 32 * tt + r; const float am = psq[t * 4 + 0];
        float us[16];
#pragma unroll
        for (int j = 0; j < 16; ++j) us[j] = psq[(32 * st + 8 * (j >> 2) + 4 * h + (j & 3)) * 4 + 1];
        if (it + F.G < 16 * NCH) ST_LOAD(it + F.G);
        f32x16s acc;
#pragma unroll
        for (int j = 0; j < 16; ++j) acc[j] = 0.f;
        { const LAS bf16* ka = kl + (32 * st + r) * LDR + 256 * kh + 8 * h; const LAS bf16* qb = ql + (32 * tt + r) * LDR + 256 * kh + 8 * h;
#pragma unroll
          for (int ks = 0; ks < 16; ++ks) acc = __builtin_amdgcn_mfma_f32_32x32x16_bf16(*(const LAS bf16x8*)(ka + 16 * ks), *(const LAS bf16x8*)(qb + 16 * ks), acc, 0, 0, 0); }
        if (kh == 1) {
#pragma unroll
            for (int j = 0; j < 16; ++j) red[(tile * 16 + j) * 64 + lane] = acc[j]; }
        __syncthreads();
        if (kh == 0) {
            float rs = 0.f;
#pragma unroll
            for (int q4 = 0; q4 < 4; ++q4) { float o[4];
#pragma unroll
                for (int i = 0; i < 4; ++i) { const int j = 4 * q4 + i, s_ = 32 * st + 8 * q4 + 4 * h + i; const float v = acc[j] + red[(tile * 16 + j) * 64 + lane];
                    o[i] = s_ <= t ? v * __expf(am + us[j]) : 0.f; rs += o[i]; }
                u32x2 ow; ow.x = pk2(o[0], o[1]); ow.y = pk2(o[2], o[3]);
                *(u32x2*)(ST + ((size_t)(sq * NCH + ck) * 64 + t) * 64 + 32 * st + 8 * q4 + 4 * h) = ow; }
            rs += xhalf(rs, h);
            if (h == 0) rsum[st * 64 + t] = rs;
        } else {
            const int d2 = 2 * (F.tid - 256); float dn0 = 0.f, dn1 = 0.f;
#pragma unroll 4
            for (int s4 = 0; s4 < 64; s4 += 4) { const f32x4 c4 = *(const LAS f32x4*)(cwl + s4);
#pragma unroll
                for (int i = 0; i < 4; ++i) { const unsigned kk = *(const LAS unsigned*)(kl + (s4 + i) * LDR + d2); dn0 += c4[i] * bf2f(kk & 0xffffu); dn1 += c4[i] * bf2f(kk >> 16); } }
            *(unsigned*)(DN + ((size_t)sq * NCH + ck) * 512 + d2) = pk2(dn0, dn1); }
        __syncthreads();
        if (F.tid < 64) DS[(size_t)sq * SEQL + ck * 64 + F.tid] = rsum[F.tid] + rsum[64 + F.tid];
    }
#undef ST_LOAD
#undef ST_SQ
#undef ST_CK
    __syncthreads();
}

typedef float f32x16 __attribute__((ext_vector_type(16)));
__device__ __forceinline__ bf16x8 pack_bf16x8(const f32x16& c, const int o) {
    u32x4 w; w.x = pg8::cvt_pk_bf16(c[o], c[o + 1]); w.y = pg8::cvt_pk_bf16(c[o + 2], c[o + 3]); w.z = pg8::cvt_pk_bf16(c[o + 4], c[o + 5]); w.w = pg8::cvt_pk_bf16(c[o + 6], c[o + 7]);
    return __builtin_bit_cast(bf16x8, w);
}
__device__ __forceinline__ void ph_mlstm_r(const Ctx& F, int hb, const bf16* QP, const bf16* XCV, const bf16* XM, bf16* HM0, int ld0, bf16* HM1, int ld1) {
    constexpr int RV = 128, RS = 144;
    LAS unsigned char* const VT = F.lds;
    LAS unsigned char* const VW = VT + 32 * RV;
    LAS unsigned char* const SB = VW + 32 * RV;
    LAS float* const QNP = (LAS float*)(SB + 64 * RS);
    LAS float* const SCL = QNP + 64 * 16;
    LAS unsigned* const NSB = (LAS unsigned*)(SCL + 384);
    LAS unsigned char* const KR = (LAS unsigned char*)(NSB + 256);
    LAS float* const PART = (LAS float*)(KR + 8 * 8192);
    const bf16* ST = (const bf16*)(F.ws + WS_ST); const float* DS = (const float*)(F.ws + WS_DS); const float* PS = (const float*)(F.ws + WS_PS); const float* PC = (const float*)(F.ws + WS_PC);
    const bf16* DN = (const bf16*)(F.ws + WS_DN);
    const int tid = F.tid, lane = F.lane, w = F.wave, r = lane & 31, h = lane >> 5;
#define R_BAR() do { asm volatile("s_waitcnt lgkmcnt(0)" ::: "memory"); __builtin_amdgcn_s_barrier(); asm volatile("" ::: "memory"); } while (0)
    for (int it0 = F.bid; it0 < 256; it0 += F.G) {
        const int it = (F.G == 256) ? (((it0 & 7) * 2 + ((it0 >> 3) >> 4)) * 16 + ((it0 >> 3) & 15)) : it0;
        const int sq = it >> 4, eb = it & 15, bh = sq >> 3, n = (sq >> 1) & 3, d = sq & 1;
        bf16* HM = d ? HM1 : HM0; const int ldh = d ? ld1 : ld0;
        const int colv = n * 512 + eb * 32;
        f32x16 C0, C1;
#pragma unroll
        for (int j = 0; j < 16; ++j) { C0[j] = 0.f; C1[j] = 0.f; }
        float nreg = 0.f, dec_cur = 0.f;
        u32x4 kreg[8]; u32x2 vreg; u32x4 sreg; bf16x8 Qf[8]; f32x4 pvn, pcn; float dsn, dnv;
        int rbn, rsn, rowtn, rbk, rsk;
#define R_PREFETCH_K(ck_) do { const bf16* kb_ = XCV + (size_t)(bh * SEQL + rbk + (lane >> 3) * rsk) * 2048 + n * 512 + 64 * w + 8 * (lane & 7); const long ks_ = (long)rsk * (8 * 2048); \
            _Pragma("unroll") for (int k_ = 0; k_ < 8; ++k_) kreg[k_] = *(const u32x4*)(kb_ + k_ * ks_); } while (0)
#define R_KWRITE() do { LAS unsigned char* kp0_ = KR + w * 8192 + (lane >> 3) * 128 + (((lane & 7) ^ (((lane >> 4) & 1) << 2)) * 16); asm volatile("" : "+v"(kp0_)); \
            _Pragma("unroll") for (int k_ = 0; k_ < 8; ++k_) *(LAS u32x4*)(kp0_ + k_ * 1024) = kreg[k_]; } while (0)
#define R_PREFETCH_VS(ck_) do { const int p0_ = (ck_) * 64; rowtn = bh * SEQL + rbn + (tid >> 3) * rsn; \
            const size_t rv_ = (size_t)rowtn * 2048; vreg = *(const u32x2*)(XM + rv_ + colv + (tid & 7) * 4); \
            sreg = *(const u32x4*)(ST + ((size_t)(sq * NCH + (ck_))) * 4096 + (size_t)tid * 8); \
            pvn = *(const f32x4*)(PS + ((size_t)sq * SEQL + p0_ + (tid >> 3)) * 4); dsn = DS[(size_t)sq * SEQL + p0_ + (tid >> 3)]; dnv = bf2f(DN[((size_t)sq * NCH + (ck_)) * 512 + tid]); pcn = *(const f32x4*)(PC + ((size_t)sq * NCH + (ck_)) * 4); } while (0)
#define R_PREFETCH_Q(ck_) do { \
            _Pragma("unroll") for (int tt_ = 0; tt_ < 2; ++tt_) { const bf16* qr_ = QP + (size_t)(bh * SEQL + rbn + (32 * tt_ + r) * rsn) * 2048 + n * 512 + 64 * w + 8 * h; \
                _Pragma("unroll") for (int i_ = 0; i_ < 2; ++i_) _Pragma("unroll") for (int s_ = 0; s_ < 2; ++s_) Qf[(tt_ * 2 + i_) * 2 + s_] = *(const bf16x8*)(qr_ + 32 * i_ + 16 * s_); } } while (0)
#define R_STAGE(ck_) do { const f32x4 pc_ = pcn; asm volatile("" :: "v"(pc_.w), "v"(pvn.x));     \
            ((LAS bf16*)NSB)[tid] = (bf16)f2bf(nreg); nreg = pc_.z * nreg + dnv; dec_cur = pc_.z; \
            const int s_ = tid >> 3, e4_ = (tid & 7) * 4; const float cw_ = __expf(pc_.x + pvn.y - pc_.y); \
            if ((tid & 7) == 0) { LAS float* sc_ = SCL + ((ck_) & 1) * 192; sc_[s_] = pvn.z; sc_[64 + s_] = __expf(-pvn.w); sc_[128 + s_] = dsn; } \
            *(LAS u32x4*)(SB + s_ * RS + (tid & 7) * 16) = sreg; \
            const float v0_ = bf2f(vreg.x & 0xffffu), v1_ = bf2f(vreg.x >> 16), v2_ = bf2f(vreg.y & 0xffffu), v3_ = bf2f(vreg.y >> 16); (void)e4_; \
            *(LAS u32x2*)(VT + s_ * 64 + (tid & 7) * 8) = vreg; \
            { u32x2 wv_; wv_.x = pk2(cw_ * v0_, cw_ * v1_); wv_.y = pk2(cw_ * v2_, cw_ * v3_); *(LAS u32x2*)(VW + s_ * 64 + (tid & 7) * 8) = wv_; } } while (0)
        odd_chunk_rows(0, d, rbn, rsn); rbk = rbn; rsk = rsn;
        R_PREFETCH_K(0); R_PREFETCH_VS(0); R_PREFETCH_Q(0);
        __syncthreads();
        R_KWRITE(); odd_chunk_rows(1, d, rbk, rsk); R_PREFETCH_K(1);
        R_STAGE(0);
        for (int ck = 0; ck < NCH; ++ck) {
            const float decay = dec_cur;
            int vlo = (8 * h + ((lane & 15) >> 2)) * 64 + (16 * ((lane >> 4) & 1) + 4 * (lane & 3)) * 2; asm volatile("" : "+v"(vlo));
            const int rowt = rowtn;
            const LAS float* const scl = SCL + (ck & 1) * 192;
            if (ck + 1 < NCH) odd_chunk_rows(ck + 1, d, rbn, rsn);
            if (ck + 2 < NCH) odd_chunk_rows(ck + 2, d, rbk, rsk);
            R_BAR();
            s16x4 kf[16];
            {
                const int swz = (lane >> 3) & 1;
                const LAS unsigned char* krb = KR + w * 8192 + (8 * h + ((lane & 15) >> 2)) * 128 + (8 * swz + 4 * ((lane >> 4) & 1) + (lane & 3)) * 8;
                const LAS unsigned char* krc = krb + 64 - 128 * swz; asm volatile("" : "+v"(krb), "+v"(krc));
#pragma unroll
                for (int ks = 0; ks < 4; ++ks) {
                    kf[4 * ks + 0] = __builtin_amdgcn_ds_read_tr16_b64_v4i16((LAS s16x4*)(krb + (16 * ks) * 128)); kf[4 * ks + 1] = __builtin_amdgcn_ds_read_tr16_b64_v4i16((LAS s16x4*)(krb + (16 * ks + 4) * 128));
                    kf[4 * ks + 2] = __builtin_amdgcn_ds_read_tr16_b64_v4i16((LAS s16x4*)(krc + (16 * ks) * 128)); kf[4 * ks + 3] = __builtin_amdgcn_ds_read_tr16_b64_v4i16((LAS s16x4*)(krc + (16 * ks + 4) * 128)); }
            }
            __builtin_amdgcn_sched_barrier(0);
            if (ck + 1 < NCH) R_KWRITE();
            __builtin_amdgcn_sched_barrier(0);
            f32x16 P0, P1;
#pragma unroll
            for (int j = 0; j < 16; ++j) { P0[j] = 0.f; P1[j] = 0.f; }
            { const bf16x8 c00 = pack_bf16x8(C0, 0), c01 = pack_bf16x8(C0, 8), c10 = pack_bf16x8(C1, 0), c11 = pack_bf16x8(C1, 8);
              P0 = __builtin_amdgcn_mfma_f32_32x32x16_bf16(Qf[0], c00, P0, 0, 0, 0); P1 = __builtin_amdgcn_mfma_f32_32x32x16_bf16(Qf[4], c00, P1, 0, 0, 0);
              P0 = __builtin_amdgcn_mfma_f32_32x32x16_bf16(Qf[1], c01, P0, 0, 0, 0); P1 = __builtin_amdgcn_mfma_f32_32x32x16_bf16(Qf[5], c01, P1, 0, 0, 0);
              P0 = __builtin_amdgcn_mfma_f32_32x32x16_bf16(Qf[2], c10, P0, 0, 0, 0); P1 = __builtin_amdgcn_mfma_f32_32x32x16_bf16(Qf[6], c10, P1, 0, 0, 0);
              P0 = __builtin_amdgcn_mfma_f32_32x32x16_bf16(Qf[3], c11, P0, 0, 0, 0); P1 = __builtin_amdgcn_mfma_f32_32x32x16_bf16(Qf[7], c11, P1, 0, 0, 0); }
            __builtin_amdgcn_sched_barrier(0);
            {
                const LAS unsigned char* vwb = VT + vlo + 32 * RV;
#pragma unroll
                for (int j = 0; j < 16; ++j) { C0[j] *= decay; C1[j] *= decay; }
#pragma unroll
                for (int kh = 0; kh < 2; ++kh) {
                    bf16x8 vw2[2];
#pragma unroll
                    for (int k2 = 0; k2 < 2; ++k2) { const int ks = 2 * kh + k2;
                        const s16x4 f0 = __builtin_amdgcn_ds_read_tr16_b64_v4i16((LAS s16x4*)(vwb + (16 * ks) * 64)), f1 = __builtin_amdgcn_ds_read_tr16_b64_v4i16((LAS s16x4*)(vwb + (16 * ks + 4) * 64));
                        vw2[k2] = (bf16x8){f0.x, f0.y, f0.z, f0.w, f1.x, f1.y, f1.z, f1.w}; }
#pragma unroll
                    for (int k2 = 0; k2 < 2; ++k2) { const int ks = 2 * kh + k2;
                        const bf16x8 ka0 = (bf16x8){kf[4 * ks].x, kf[4 * ks].y, kf[4 * ks].z, kf[4 * ks].w, kf[4 * ks + 1].x, kf[4 * ks + 1].y, kf[4 * ks + 1].z, kf[4 * ks + 1].w};
                        const bf16x8 ka1 = (bf16x8){kf[4 * ks + 2].x, kf[4 * ks + 2].y, kf[4 * ks + 2].z, kf[4 * ks + 2].w, kf[4 * ks + 3].x, kf[4 * ks + 3].y, kf[4 * ks + 3].z, kf[4 * ks + 3].w};
                        C0 = __builtin_amdgcn_mfma_f32_32x32x16_bf16(ka0, vw2[k2], C0, 0, 0, 0); C1 = __builtin_amdgcn_mfma_f32_32x32x16_bf16(ka1, vw2[k2], C1, 0, 0, 0); }
                    __builtin_amdgcn_sched_barrier(0);
                }
            }
            __builtin_amdgcn_sched_barrier(0);
            u32x2 nsa[4], nsb[4];
#pragma unroll
            for (int i = 0; i < 2; ++i)
#pragma unroll
                for (int sx = 0; sx < 2; ++sx) { const int db = 64 * w + 32 * i + 16 * sx + 4 * h; nsa[i * 2 + sx] = *(const LAS u32x2*)(NSB + (db >> 1)); nsb[i * 2 + sx] = *(const LAS u32x2*)(NSB + ((db + 8) >> 1)); }
            if (ck + 2 < NCH) R_PREFETCH_K(ck + 2);
            if (ck + 1 < NCH) R_PREFETCH_VS(ck + 1);
            __builtin_amdgcn_sched_barrier(0);
            {
                float qn0 = 0.f, qn1 = 0.f;
#pragma unroll
                for (int i = 0; i < 2; ++i)
#pragma unroll
                    for (int sx = 0; sx < 2; ++sx) { const u32x2 na = nsa[i * 2 + sx], nb = nsb[i * 2 + sx];
                        const u32x4 qa = __builtin_bit_cast(u32x4, Qf[i * 2 + sx]), qb = __builtin_bit_cast(u32x4, Qf[4 + i * 2 + sx]);
                        qn0 = dot2bf(qa.x, na.x, qn0); qn0 = dot2bf(qa.y, na.y, qn0); qn0 = dot2bf(qa.z, nb.x, qn0); qn0 = dot2bf(qa.w, nb.y, qn0);
                        qn1 = dot2bf(qb.x, na.x, qn1); qn1 = dot2bf(qb.y, na.y, qn1); qn1 = dot2bf(qb.z, nb.x, qn1); qn1 = dot2bf(qb.w, nb.y, qn1); }
                qn0 += xhalf(qn0, h); qn1 += xhalf(qn1, h);
                if (h == 0) { QNP[w * 64 + r] = qn0; QNP[w * 64 + 32 + r] = qn1; }
                __builtin_amdgcn_sched_barrier(0);
                if (ck + 1 < NCH) R_PREFETCH_Q(ck + 1);
#pragma unroll
                for (int q4 = 0; q4 < 4; ++q4) { const f32x4 s0 = *(const LAS f32x4*)(scl + 8 * q4 + 4 * h), s1 = *(const LAS f32x4*)(scl + 32 + 8 * q4 + 4 * h);
                    P0[4 * q4] *= s0.x; P0[4 * q4 + 1] *= s0.y; P0[4 * q4 + 2] *= s0.z; P0[4 * q4 + 3] *= s0.w;
                    P1[4 * q4] *= s1.x; P1[4 * q4 + 1] *= s1.y; P1[4 * q4 + 2] *= s1.z; P1[4 * q4 + 3] *= s1.w; }
                if (w < 4) { const LAS unsigned char* vtb = VT + vlo + 16 * 64 * w;
                    const s16x4 f0 = __builtin_amdgcn_ds_read_tr16_b64_v4i16((LAS s16x4*)vtb), f1 = __builtin_amdgcn_ds_read_tr16_b64_v4i16((LAS s16x4*)(vtb + 4 * 64));
                    const bf16x8 vb = (bf16x8){f0.x, f0.y, f0.z, f0.w, f1.x, f1.y, f1.z, f1.w};
                    const bf16x8 sa0 = *(const LAS bf16x8*)(SB + r * RS + 32 * w + 16 * h), sa1 = *(const LAS bf16x8*)(SB + (32 + r) * RS + 32 * w + 16 * h);
                    P0 = __builtin_amdgcn_mfma_f32_32x32x16_bf16(sa0, vb, P0, 0, 0, 0); P1 = __builtin_amdgcn_mfma_f32_32x32x16_bf16(sa1, vb, P1, 0, 0, 0); }
                { LAS float* pb = PART + (w * 64 + 4 * h) * 32 + r; asm volatile("" : "+v"(pb));
#pragma unroll
                  for (int j = 0; j < 16; ++j) { pb[((j & 3) + 8 * (j >> 2)) * 32] = P0[j]; pb[(32 + (j & 3) + 8 * (j >> 2)) * 32] = P1[j]; } }
            }
            __builtin_amdgcn_sched_barrier(0);
            R_BAR();
            {
                const int t = tid >> 3, eg = tid & 7;
                const LAS float* pr = PART + t * 32 + eg * 4; asm volatile("" : "+v"(pr));
                f32x4 num = *(const LAS f32x4*)pr;
#pragma unroll
                for (int ww = 1; ww < 8; ++ww) num += *(const LAS f32x4*)(pr + ww * 64 * 32);
                const float qn = ((QNP[t] + QNP[64 + t]) + (QNP[128 + t] + QNP[192 + t])) + ((QNP[256 + t] + QNP[320 + t]) + (QNP[384 + t] + QNP[448 + t]));
                const float den = scl[128 + t] + scl[t] * qn, dn = fmaxf(fabsf(den), scl[64 + t]);
                const f32x4 hv = num * __builtin_amdgcn_rcpf(dn);
                u32x2 ow; ow.x = pk2(hv.x, hv.y); ow.y = pk2(hv.z, hv.w);
                *(u32x2*)(HM + (size_t)rowt * ldh + colv + eg * 4) = ow;
            }
            __builtin_amdgcn_sched_barrier(0);
            if (ck + 1 < NCH) R_STAGE(ck + 1);
        }
#undef R_PREFETCH_K
#undef R_KWRITE
#undef R_PREFETCH_VS
#undef R_PREFETCH_Q
#undef R_STAGE
    }
#undef R_BAR
    __syncthreads();
}

__device__ __forceinline__ void ph_mlpost(const Ctx& F, int j, int hb, bf16* PA, const bf16* HMB, const bf16* XCV, const bf16* ZG) {
    const float* wv = F.in(I_MLWV) + (size_t)j * 512 * 16; const float* ng = F.in(I_MLNG) + (size_t)j * 2048; const float* sk = F.in(I_MLSKIP) + (size_t)j * 2048;
    bf16* PH = PA + (size_t)hb * MH * 2048;
    LAS f32x4* const WL = (LAS f32x4*)F.lds;
    for (int i = F.tid; i < 4 * 12 * 64; i += NTHR) { const int ln = i & 63, q = (i >> 6) % 12, k = i / 768, c = 8 * ln + 512 * k;
        const float* src = q < 8 ? wv + (size_t)((c >> 2) + (q >> 2)) * 16 + 4 * (q & 3) : (q < 10 ? ng + c + 4 * (q - 8) : sk + c + 4 * (q - 10));
        WL[i] = *(const f32x4*)src; }
    __syncthreads();
    const int nrows = (MH - F.gw + F.NGW - 1) / F.NGW;
    u32x4 cur[4][4];
#define MP_ISSUE(n_, L) do { const size_t o_ = (size_t)(F.gw + (n_) * F.NGW) * 2048 + 8 * F.lane; \
        _Pragma("unroll") for (int k = 0; k < 4; ++k) { L[k][0] = *(const u32x4*)(PH + o_ + 512 * k); L[k][1] = *(const u32x4*)(HMB + o_ + 512 * k); L[k][2] = *(const u32x4*)(XCV + o_ + 512 * k); L[k][3] = *(const u32x4*)(ZG + o_ + 512 * k); } } while (0)
    if (nrows > 0) MP_ISSUE(0, cur);
#pragma unroll 1
    for (int n = 0; n < nrows; ++n) {
        const size_t on_ = (size_t)(F.gw + (n + 1 < nrows ? n + 1 : n) * F.NGW) * 2048 + 8 * F.lane;
        bf16* const prow = PH + (size_t)(F.gw + n * F.NGW) * 2048 + 8 * F.lane;
#pragma unroll
        for (int k = 0; k < 4; ++k) {
            const LAS f32x4* wl = WL + (k * 12) * 64 + F.lane;
            float a[8], b[8], h[8]; unpack8(cur[k][0], a); unpack8(cur[k][1], b);
#pragma unroll
            for (int e = 0; e < 8; ++e) a[e] += b[e];
#pragma unroll
            for (int blk = 0; blk < 2; ++blk) { const f32x4 w0 = wl[(blk * 4 + 0) * 64], w1 = wl[(blk * 4 + 1) * 64], w2 = wl[(blk * 4 + 2) * 64], w3 = wl[(blk * 4 + 3) * 64];
#pragma unroll
                for (int o = 0; o < 4; ++o) h[blk * 4 + o] = a[blk * 4 + 0] * w0[o] + a[blk * 4 + 1] * w1[o] + a[blk * 4 + 2] * w2[o] + a[blk * 4 + 3] * w3[o]; }
            float s1 = 0.f;
#pragma unroll
            for (int e = 0; e < 8; ++e) s1 += h[e];
            const float mu = wave_sum(s1) * (1.f / 512.f); float s2 = 0.f;
#pragma unroll
            for (int e = 0; e < 8; ++e) { h[e] -= mu; s2 += h[e] * h[e]; }
            const float rstd = rsqrtf(wave_sum(s2) * (1.f / 512.f) + EPS);
            const f32x4 g0 = wl[8 * 64], g1 = wl[9 * 64], k0 = wl[10 * 64], k1 = wl[11 * 64];
            const float ngv[8] = {g0.x, g0.y, g0.z, g0.w, g1.x, g1.y, g1.z, g1.w}, skv[8] = {k0.x, k0.y, k0.z, k0.w, k1.x, k1.y, k1.z, k1.w};
            float x[8], z[8], o[8]; unpack8(cur[k][2], x); unpack8(cur[k][3], z);
#pragma unroll
            for (int e = 0; e < 8; ++e) o[e] = (h[e] * rstd * ngv[e] + skv[e] * x[e]) * silu(z[e]);
            *(u32x4*)(prow + 512 * k) = pack8(o);
            cur[k][0] = *(const u32x4*)(PH + on_ + 512 * k); cur[k][1] = *(const u32x4*)(HMB + on_ + 512 * k); cur[k][2] = *(const u32x4*)(XCV + on_ + 512 * k); cur[k][3] = *(const u32x4*)(ZG + on_ + 512 * k);
            __builtin_amdgcn_sched_barrier(0);
        }
    }
#undef MP_ISSUE
    __syncthreads();
}

__device__ __forceinline__ void ph_ctx_reduce(const Ctx& F, const float* P, const float* src, float* dst, const float* gtc, int i0, int i1) {
    for (int i = i0 + F.bid * NTHR + F.tid; i < i1; i += F.G * NTHR) {
        const int c4 = (i & 255) * 4, row = i >> 8;
        f32x4 a = *(const f32x4*)(P + (size_t)row * 1024 + c4);
#pragma unroll
        for (int ks = 1; ks < 8; ++ks) a += *(const f32x4*)(P + ((size_t)ks * 1024 + row) * 1024 + c4);
        const f32x4 x = *(const f32x4*)(src + (size_t)row * 1024 + c4), g = *(const f32x4*)(gtc + c4);
        *(f32x4*)(dst + (size_t)row * 1024 + c4) = x + g * a;
    }
}
__device__ __forceinline__ void ph_final(const Ctx& F) {
    const float* fg = F.in(I_FINALG);
    for (int r = F.gw; r < NB * LLAT; r += F.NGW) {
        f32x4* xr = (f32x4*)(F.out + (size_t)r * D) + F.lane;
        f32x4 v[4]; float ss = 0.f;
#pragma unroll
        for (int jj = 0; jj < 4; ++jj) { v[jj] = xr[64 * jj]; ss += (v[jj].x * v[jj].x + v[jj].y * v[jj].y) + (v[jj].z * v[jj].z + v[jj].w * v[jj].w); }
        const float rstd = rsqrtf(wave_sum(ss) * (1.f / D) + EPS);
#pragma unroll
        for (int jj = 0; jj < 4; ++jj) { const f32x4 g = *(const f32x4*)(fg + 4 * F.lane + 256 * jj); xr[64 * jj] = v[jj] * rstd * g; }
    }
}

constexpr int NPH = 1 + 2 * 8 + 14 + 14 + 1;

__global__ void __launch_bounds__(NTHR, 2) fwd_kernel(Args args) {
    extern __shared__ __attribute__((aligned(16))) unsigned char lds_raw[];
    volatile LAS unsigned* MISC = (volatile LAS unsigned*)((LAS unsigned char*)lds_raw + MISC_OFF);
    if (threadIdx.x < 64) MISC[threadIdx.x] = 0u;
    __syncthreads();
    const int lo = args.ph_lo, hi = args.ph_hi;
    const int wv0 = __builtin_amdgcn_readfirstlane((int)threadIdx.x >> 6);
    XcdBarrier bar; bar.bar = (unsigned*)(args.ws + WS_CTL); bar.x = 0; bar.st = MISC;
    if (hi - lo > 1) bar = xcd_barrier_post((unsigned*)(args.ws + WS_CTL), MISC);
    int ph = 0;
#define PH_BEGIN if (ph >= lo && ph < hi) { Ctx F; { const CAS char* kp_ = (const CAS char*)__builtin_amdgcn_kernarg_segment_ptr(); asm volatile("" : "+s"(kp_)); F.kp = kp_; \
        F.lds = (LAS unsigned char*)lds_raw; { int w_ = wv0, b_ = blockIdx.x, g_ = gridDim.x, ln_; asm volatile("v_mbcnt_lo_u32_b32 %0, -1, 0\n\tv_mbcnt_hi_u32_b32 %0, -1, %0" : "=v"(ln_)); asm volatile("" : "+s"(w_), "+s"(b_), "+s"(g_)); F.tid = (w_ << 6) | ln_; F.wave = w_; F.bid = b_; F.G = g_; } \
        F.lane = F.tid & 63; \
        F.gw = F.bid * NWAVES + F.wave; F.NGW = F.G * NWAVES; F.out = *(float* const CAS*)(kp_ + 304); F.ws = *(unsigned char* const CAS*)(kp_ + 312); } \
        unsigned char* const ws = F.ws; bf16* const SL0 = (bf16*)(ws + WS_SLAB); bf16* const SL1 = (bf16*)(ws + WS_SLAB + SLAB); bf16* const SL2 = (bf16*)(ws + WS_SLAB + 2 * SLAB); bf16* const SL3 = (bf16*)(ws + WS_SLAB + 3 * SLAB); \
        bf16* const SL4 = (bf16*)(ws + WS_SLAB + 4 * SLAB); bf16* const SL5 = (bf16*)(ws + WS_SLAB + 5 * SLAB); bf16* const SL6 = (bf16*)(ws + WS_SLAB + 6 * SLAB); \
        bf16* const WIN = (bf16*)(ws + WS_W + W_IN); bf16* const WOUT = (bf16*)(ws + WS_W + W_OUT); bf16* const WGLU = (bf16*)(ws + WS_W + W_GLU); bf16* const WGATE = (bf16*)(ws + WS_W + W_GATE); \
        const float* const modv = (const float*)(ws + WS_MODV); float* const xctx = (float*)(ws + WS_XCTX); (void)SL0; (void)SL1; (void)SL2; (void)SL3; (void)SL4; (void)SL5; (void)SL6; (void)WIN; (void)WOUT; (void)WGLU; (void)WGATE; (void)modv; (void)xctx;
#define PH_END if (ph + 1 < hi) { int ln2_; asm volatile("v_mbcnt_lo_u32_b32 %0, -1, 0\n\tv_mbcnt_hi_u32_b32 %0, -1, %0" : "=v"(ln2_)); xcd_barrier(bar, (ln2_ == 0) & (wv0 == 0)); } } ++ph;

    PH_BEGIN ph_mod(F); PH_END

#pragma unroll 1
    for (int l = 0; l < DEPTH; ++l) {
        const int j = l >> 1;
        if ((l & 1) == 0) {
#define Y SL0
#define U SL2
#define XR SL3
#define HB SL4
#define XC SL4
#define YS0 SL5
#define YS1 SL6
            PH_BEGIN { int l_ = l; asm volatile("" : "+s"(l_)); ph_norm(F, l_, 0, M, HB, l_ > 0 ? (const float*)SL2 : (const float*)nullptr); } ph_wconv_even(F, j); PH_END
            PH_BEGIN { pg8::TileOrder S; S.init(NTILE, 16, F.G, F.bid, HB, (size_t)256 * 1024 * 2, WIN, (size_t)256 * 1024 * 2);
                       pg8::EpiSplit E{U, Y, (long)(XR - U), 1024, 1024, 2048, 10};
                       GEMM_CALL(1024, 1024, 1024, S, E); } PH_END
            PH_BEGIN ph_s5_mfma(F, j, U, YS0, XR, XC); PH_END
            PH_BEGIN { pg8::TileOrder S; S.init(NTILE - NB, 4, F.G, F.bid, U, (size_t)256 * 1024 * 2, WGLU, (size_t)256 * 1024 * 2); S.skipctx = 1;
                       pg8::EpiGlu E{U, Y, F.in(I_GLUB) + (size_t)j * 1024};
                       GEMM_CALL(1024, 1024, 1024, S, E); } PH_END
            PH_BEGIN {
                       { pg8::CtxOrder S3{F.G, F.bid, 64, 4, (const char*)U, (size_t)256 * 1024 * 2, (const char*)WGLU, (size_t)256 * 1024 * 2}; pg8::EpiGlu E3{U, Y, F.in(I_GLUB) + (size_t)j * 1024};
                         int tid3 = F.tid; asm volatile("" : "+v"(tid3)); pg8::gemm_phase(F.lds, tid3, 1024, 1024, 1024, S3, E3); }
                       __syncthreads();
                       pg8::TileOrder S; S.init(NTILE, 16, F.G, F.bid, XC, (size_t)256 * 1024 * 2, WGATE, (size_t)256 * 256 * 2, 2, (size_t)256 * 2);
                       pg8::EpiGate E{XC, SL2, F.in(I_RGBA) + (size_t)j * 2048, F.in(I_RGBX) + (size_t)j * 2048, (const float*)(ws + WS_SPT)};
                       GEMM_CALL(256, 1024, 256, S, E); } PH_END
            PH_BEGIN ph_rgscan_a(F, SL2, SL3, SL5, SL6, (float*)(ws + WS_PS), (float*)(ws + WS_GATE), (const bf16*)(ws + WS_ST)); PH_END
            PH_BEGIN ph_rgscan_c(F, SL2, SL3, SL5, SL6, (const float*)(ws + WS_PS), (const float*)(ws + WS_GATE), Y, (const bf16*)(ws + WS_ST)); PH_END
            PH_BEGIN { pg8::TileOrder S; S.init(NTILE - NB, 4, F.G, F.bid, Y, (size_t)256 * 2048 * 2, WOUT, (size_t)256 * 2048 * 2); S.skipctx = 1;
                       pg8::EpiOut E{l == 0 ? F.in(I_X) : (const float*)F.out, l == 0 ? F.in(I_CTX) : (const float*)xctx, F.out, xctx, modv + (size_t)l * 5 * 3072};
                       GEMM_CALL(2048, 2048, 2048, S, E);
                       __syncthreads();
                       { pg8::CtxKOrder S2{F.G, F.bid, (const char*)Y, (size_t)256 * 2048 * 2, (const char*)WOUT, (size_t)256 * 2048 * 2}; pg8::EpiPart E2{(float*)SL2};
                         { int tid2 = F.tid; asm volatile("" : "+v"(tid2)); pg8::gemm_phase(F.lds, tid2, 256, 2048, 2048, S2, E2); }     } } PH_END
        } else {
#undef Y
#undef U
#undef XR
#undef HB
#undef XC
#undef YS0
#undef YS1
#define PA SL0
#define HMB SL2
#define XM SL3
#define ZG SL4
#define XCV SL5
#define QP SL6
#define HB SL6
#pragma unroll 1
            for (int hb = 0; hb < 2; ++hb) {
                if (hb == 0) { PH_BEGIN { int l_ = l; asm volatile("" : "+s"(l_)); ph_norm(F, l_, 0, MH, HB, (const float*)SL2);
                                          ph_ctx_reduce(F, (const float*)SL2, l_ == 1 ? F.in(I_CTX) : (const float*)xctx, xctx, modv + (size_t)(l_ - 1) * 5 * 3072 + 4 * 3072 + 2048, (NB / 2) * LCTX * D / 4, NB * LCTX * D / 4); } ph_wconv_odd(F, j); PH_END }
                PH_BEGIN { pg8::TileOrder S; S.init(NTILE / 2, 16, F.G, F.bid, HB, (size_t)256 * 1024 * 2, WIN, (size_t)256 * 1024 * 2);
                           pg8::EpiSplit E{XM, ZG, 0, 0, 2048, 2048, 11};
                           GEMM_CALL(1024, 1024, 1024, S, E); } PH_END
                PH_BEGIN ph_convq(F, j, hb, XM, XCV, QP); PH_END
                PH_BEGIN ph_mscan(F, hb); PH_END
                PH_BEGIN ph_stilde(F, hb, QP, XCV); PH_END
                PH_BEGIN ph_mlstm_r(F, hb, QP, XCV, XM, PA + (size_t)hb * MH * 2048, 2048, HMB, 2048); PH_END
                PH_BEGIN ph_mlpost(F, j, hb, PA, HMB, XCV, ZG);
                         if (hb == 0) { int l_ = l; asm volatile("" : "+s"(l_)); ph_norm(F, l_, MH, 2 * MH, HB, (const float*)nullptr); }
                PH_END
            }
            PH_BEGIN { pg8::TileOrder S; S.init(NTILE - NB, 4, F.G, F.bid, PA, (size_t)256 * 2048 * 2, WOUT, (size_t)256 * 2048 * 2); S.skipctx = 1;
                       pg8::EpiOut E{l == 0 ? F.in(I_X) : (const float*)F.out, l == 0 ? F.in(I_CTX) : (const float*)xctx, F.out, xctx, modv + (size_t)l * 5 * 3072};
                       GEMM_CALL(2048, 2048, 2048, S, E);
                       if (l < DEPTH - 1) { __syncthreads();
                         pg8::CtxKOrder S2{F.G, F.bid, (const char*)PA, (size_t)256 * 2048 * 2, (const char*)WOUT, (size_t)256 * 2048 * 2}; pg8::EpiPart E2{(float*)SL2};
                         { int tid2 = F.tid; asm volatile("" : "+v"(tid2)); pg8::gemm_phase(F.lds, tid2, 256, 2048, 2048, S2, E2); }     } } PH_END
        }
    }
    PH_BEGIN ph_final(F); PH_END
#undef PH_BEGIN
#undef PH_END
#undef PA
#undef HMB
#undef XM
#undef ZG
#undef XCV
#undef QP
#undef HB
}

extern "C" void kernel_launch(void* const* d_in, const int* in_sizes, int n_in, void* d_out, int out_size, void* d_ws, size_t ws_size, hipStream_t stream) {
    static int grid = 0;
    if (grid == 0) {
        int dev = 0, cus = 0, per_cu = 0;
        if (hipGetDevice(&dev) != hipSuccess || hipDeviceGetAttribute(&cus, hipDeviceAttributeMultiprocessorCount, dev) != hipSuccess) { fprintf(stderr, "kernel_launch: device query failed\n"); grid = -1; return; }
        if (hipFuncSetAttribute((const void*)fwd_kernel, hipFuncAttributeMaxDynamicSharedMemorySize, LDS_BYTES) != hipSuccess) { fprintf(stderr, "kernel_launch: hipFuncSetAttribute failed\n"); grid = -1; return; }
        if (hipOccupancyMaxActiveBlocksPerMultiprocessor(&per_cu, (const void*)fwd_kernel, NTHR, LDS_BYTES) != hipSuccess || per_cu < 1) fprintf(stderr, "kernel_launch: occupancy query says %d\n", per_cu);
        (void)hipGetLastError();
        grid = cus;
        if (n_in != 38 || out_size != NB * LLAT * D || ws_size < WS_END) fprintf(stderr, "kernel_launch: unexpected shapes: n_in %d out %d ws %zu\n", n_in, out_size, ws_size);
    }
    if (grid < 0) return;
    (void)hipMemsetAsync((char*)d_ws + WS_CTL, 0, CTL_ZERO_BYTES, stream);
    Args a{};
    for (int i = 0; i < 38; ++i) a.in[i] = (const float*)d_in[i];
    a.out = (float*)d_out; a.ws = (unsigned char*)d_ws;
#if ONE_LAUNCH
    a.ph_lo = 0; a.ph_hi = NPH;
    hipLaunchKernelGGL(fwd_kernel, dim3(grid), dim3(NTHR), LDS_BYTES, stream, a);
#else
    for (int p = 0; p < NPH; ++p) { a.ph_lo = p; a.ph_hi = p + 1; hipLaunchKernelGGL(fwd_kernel, dim3(grid), dim3(NTHR), LDS_BYTES, stream, a); }
#endif
}
```

```cpp
#include <hip/hip_runtime.h>
#include <cstdio>
#include <cstdint>

#ifndef NAIVE_GEMM
#define NAIVE_GEMM 0
#endif
#if NAIVE_GEMM
#define GEMM_CALL(K_, la_, lb_, S_, E_) pg8::gemm_phase_naive(F.tid, K_, la_, lb_, S_, E_)
#else
#define GEMM_CALL(K_, la_, lb_, S_, E_) pg8::gemm_phase(F.lds, F.tid, K_, la_, lb_, S_, E_)
#endif
#ifndef ONE_LAUNCH
#define ONE_LAUNCH 1
#endif

#define LAS __attribute__((address_space(3)))
#define GAS __attribute__((address_space(1)))
typedef unsigned short bf16;
typedef short bf16x8 __attribute__((ext_vector_type(8)));
typedef float f32x4 __attribute__((ext_vector_type(4)));
typedef unsigned u32x4 __attribute__((ext_vector_type(4)));
typedef unsigned u32x2 __attribute__((ext_vector_type(2)));
typedef short s16x4 __attribute__((ext_vector_type(4)));

constexpr int NB = 4, LLAT = 8192, LCTX = 256, SEQL = LLAT + LCTX;
constexpr int M = NB * SEQL;
constexpr int D = 1024, DEPTH = 4;
constexpr int MH = M / 2;
constexpr int NTILE = M / 256, TPB = SEQL / 256;
constexpr float EPS = 1e-6f;
constexpr int NCH = SEQL / 64;

constexpr size_t MiB = 1u << 20;
constexpr size_t WS_CTL = 0, CTL_ZERO_BYTES = 64 * 1024;
constexpr size_t WS_MODV = 1 * MiB;
constexpr size_t WS_MG = WS_MODV + 256 * 1024;
constexpr size_t WS_WGT = WS_MG + 64 * 1024;
constexpr size_t WS_PC = WS_WGT + 128 * 1024;
constexpr size_t WS_SPT = WS_MODV + 512 * 1024;
constexpr size_t WS_DS = 2 * MiB;
constexpr size_t WS_PS = 3 * MiB;
constexpr size_t WS_GATE = 6 * MiB;
constexpr size_t WS_XCTX = 9 * MiB;
constexpr size_t WS_DN = 13 * MiB;
constexpr size_t WS_W = 16 * MiB;
constexpr size_t W_IN = 0, W_OUT = 8 * MiB, W_GLU = 12 * MiB, W_GATE = 14 * MiB;
constexpr size_t WS_ST = 32 * MiB;
constexpr size_t WS_SLAB = 50 * MiB;
constexpr size_t SLAB = (size_t)M * 1024 * 2;
static_assert(SLAB == 66 * MiB, "slab");
constexpr size_t WS_END = WS_SLAB + 7 * SLAB;
static_assert(WS_END == 512 * MiB, "ws map");

constexpr int LDS_BYTES = 163840;
constexpr int MISC_OFF = 163840 - 256;
constexpr int NWAVES = 8, NTHR = 512;

__device__ __forceinline__ float bf2f(unsigned b) { return __uint_as_float(b << 16); }
typedef __bf16 bf2v_t __attribute__((ext_vector_type(2)));
__device__ __forceinline__ unsigned f2bf(float f) { return (unsigned)__builtin_bit_cast(unsigned short, (__bf16)f); }
__device__ __forceinline__ unsigned pk2(float lo, float hi) { bf2v_t v; v.x = (__bf16)lo; v.y = (__bf16)hi; return __builtin_bit_cast(unsigned, v); }
__device__ __forceinline__ float sigm(float x) { return __builtin_amdgcn_rcpf(1.f + __expf(-x)); }
__device__ __forceinline__ float silu(float x) { return x * __builtin_amdgcn_rcpf(1.f + __expf(-x)); }
__device__ __forceinline__ float softplus(float x) { return x > 20.f ? x : __logf(1.f + __expf(x)); }
__device__ __forceinline__ float logsigmoid(float x) { return fminf(x, 0.f) - __logf(1.f + __expf(-fabsf(x))); }
__device__ __forceinline__ float gelu_tanh(float x) { return x * sigm(1.5957691216057308f * (x + 0.044715f * x * x * x)); }
__device__ __forceinline__ void unpack8(const u32x4 w, float (&v)[8]) {
    v[0] = bf2f(w.x & 0xffffu); v[1] = bf2f(w.x >> 16); v[2] = bf2f(w.y & 0xffffu); v[3] = bf2f(w.y >> 16);
    v[4] = bf2f(w.z & 0xffffu); v[5] = bf2f(w.z >> 16); v[6] = bf2f(w.w & 0xffffu); v[7] = bf2f(w.w >> 16);
}
__device__ __forceinline__ u32x4 pack8(const float (&v)[8]) { u32x4 w; w.x = pk2(v[0], v[1]); w.y = pk2(v[2], v[3]); w.z = pk2(v[4], v[5]); w.w = pk2(v[6], v[7]); return w; }
#define SWZX(v, m) __int_as_float(__builtin_amdgcn_ds_swizzle(__float_as_int(v), (((m) << 10) | 0x1f)))
__device__ __forceinline__ float wave_sum(float v) {
    v += SWZX(v, 1); v += SWZX(v, 2); v += SWZX(v, 4); v += SWZX(v, 8); v += SWZX(v, 16);
    return __int_as_float(__builtin_amdgcn_readlane(__float_as_int(v), 0)) + __int_as_float(__builtin_amdgcn_readlane(__float_as_int(v), 32));
}
__device__ __forceinline__ float sum8(float v) { v += SWZX(v, 1); v += SWZX(v, 2); v += SWZX(v, 4); return v; }
#define LDS_WAIT() asm volatile("s_waitcnt lgkmcnt(0)" ::: "memory")
#define VM_WAIT() asm volatile("s_waitcnt vmcnt(0)" ::: "memory")
#define WAVE_SYNC() do { asm volatile("s_waitcnt lgkmcnt(0)" ::: "memory"); __builtin_amdgcn_wave_barrier(); } while (0)

__device__ __forceinline__ int pos2s_even(int pos, int d) { return d == 0 ? pos : (pos < LCTX ? LCTX - 1 - pos : (SEQL + LCTX - 1) - pos); }
__device__ __forceinline__ int pos2s_odd(int pos, int d) {
    if (pos < LCTX) return d == 0 ? pos : LCTX - 1 - pos;
    const int p = d == 0 ? pos - LCTX : LLAT - 1 - (pos - LCTX);
    return LCTX + (p & 127) * 64 + (p >> 7);
}
__device__ __forceinline__ int nb_even(int s, int o) { const int t = s + o; return s < LCTX ? ((t >= 0 && t < LCTX) ? t : -1) : ((t >= LCTX && t < SEQL) ? t : -1); }
__device__ __forceinline__ int nb_odd(int s, int o) {
    if (s < LCTX) { const int t = s + o; return (t >= 0 && t < LCTX) ? t : -1; }
    const int i = s - LCTX, p = (i & 63) * 128 + (i >> 6) + o;
    if (p < 0 || p >= LLAT) return -1;
    return LCTX + (p & 127) * 64 + (p >> 7);
}

#define XB_TMO      128
#define XB_XCNT(j)  (256  + 64 * (j))
#define XB_XSUB(j)  (1280 + 64 * (j))
#define XB_XGEN(j)  (2304 + 64 * (j))
#define XB_TOP      3328
#define XB_TOPGEN   3392
#define XCD_BAR_WORDS 3456
#define XB_SPIN_CAP (1u << 22)
__device__ __forceinline__ unsigned xb_ld(unsigned* p)              { return __hip_atomic_load(p, __ATOMIC_RELAXED, __HIP_MEMORY_SCOPE_AGENT); }
__device__ __forceinline__ unsigned xb_add(unsigned* p, unsigned v) { return __hip_atomic_fetch_add(p, v, __ATOMIC_RELAXED, __HIP_MEMORY_SCOPE_AGENT); }
__device__ __forceinline__ unsigned xb_xcc_id() { return (unsigned)__builtin_amdgcn_s_getreg((3 << 11) | 20) & 0xFu; }
#define XB_SPIN(cond, bar) do { unsigned _sp = 0; while (cond) { __builtin_amdgcn_s_sleep(1); \
    if ((++_sp & 255u) == 0u) { if (xb_ld(&(bar)[XB_TMO])) break; if (_sp > XB_SPIN_CAP) { atomicAdd(&(bar)[XB_TMO], 1u); break; } } } } while (0)
struct XcdBarrier { unsigned* bar; unsigned x; volatile LAS unsigned* st; };
__device__ __forceinline__ XcdBarrier xcd_barrier_post(unsigned* bar, volatile LAS unsigned* st) {
    XcdBarrier b; b.bar = bar; b.x = xb_xcc_id(); b.st = st;
    if (threadIdx.x == 0) (void)xb_add(&bar[XB_XCNT(b.x)], 1u);
    return b;
}
__device__ __forceinline__ void xcd_barrier_complete(unsigned* bar, unsigned x, unsigned& nloc, unsigned& nx) {
    const unsigned G = gridDim.x * gridDim.y * gridDim.z;
    unsigned sum, cnt, mine, sp = 0u;
    for (;;) {
        sum = 0u; cnt = 0u; mine = 0u;
#pragma unroll
        for (unsigned j = 0; j < 16; ++j) { const unsigned c = xb_ld(&bar[XB_XCNT(j)]); sum += c; cnt += (c > 0u) ? 1u : 0u; mine = (j == x) ? c : mine; }
        if (sum == G) break;
        __builtin_amdgcn_s_sleep(1);
        if ((++sp & 255u) == 0u) { if (xb_ld(&bar[XB_TMO])) break; if (sp > XB_SPIN_CAP) { atomicAdd(&bar[XB_TMO], 1u); break; } }
    }
    nloc = mine > 0u ? mine : 1u; nx = cnt > 0u ? cnt : 1u;
}
__device__ __forceinline__ void xcd_barrier(const XcdBarrier& b, const bool leader) {
    asm volatile("s_waitcnt vmcnt(0)" ::: "memory");
    __syncthreads();
    if (leader) {
        unsigned* bar = b.bar;
        __builtin_amdgcn_s_waitcnt(0);
        unsigned nloc = b.st[0], nx = b.st[1];
        if (nloc == 0u) { xcd_barrier_complete(bar, b.x, nloc, nx); b.st[0] = nloc; b.st[1] = nx; }
        const unsigned old = xb_add(&bar[XB_XSUB(b.x)], 1u);
        const unsigned gen = old / nloc;
        if (old + 1u == (gen + 1u) * nloc) {
            __builtin_amdgcn_fence(__ATOMIC_RELEASE, "agent");
            asm volatile("s_waitcnt vmcnt(0)" ::: "memory");
            const unsigned og = xb_add(&bar[XB_TOP], 1u);
            const unsigned tg = og / nx;
            if (og + 1u == (tg + 1u) * nx) xb_add(&bar[XB_TOPGEN], 1u);
            else XB_SPIN(xb_ld(&bar[XB_TOPGEN]) == tg, bar);
            __builtin_amdgcn_fence(__ATOMIC_ACQUIRE, "agent");
            xb_add(&bar[XB_XGEN(b.x)], 1u);
            asm volatile("s_waitcnt vmcnt(0)" ::: "memory");
        } else {
            XB_SPIN(xb_ld(&bar[XB_XGEN(b.x)]) == gen, bar);
            __builtin_amdgcn_fence(__ATOMIC_ACQUIRE, "agent");
            asm volatile("s_waitcnt vmcnt(0)" ::: "memory");
        }
    }
    __syncthreads();
}

__device__ __forceinline__ void rg_coefs(const float la, float& om, float& mlt) {
    const float a = __expf(la);
    const float pom = -la * (1.f + la * (0.5f + la * (0.16666667f + la * 0.041666668f)));
    om = la > -0.125f ? pom : 1.f - a;
    mlt = __builtin_amdgcn_sqrtf(fmaxf(om * (2.f - om), 0.f));
}
namespace pg8 {
constexpr int BM = 256, BK = 64, HALF = 128, HTB = HALF * BK * 2, STAGE_BYTES = 8 * HTB, NXCD = 8, WGM = 8;
__host__ __device__ __forceinline__ int lds_byte(int r, int c) { const int st = (r >> 4) * 2 + (c >> 5), rr = r & 15, cc = c & 31, ob = rr * 64 + cc * 2; return st * 1024 + (ob ^ (((ob >> 9) & 1) << 5)); }
__host__ __device__ __forceinline__ void stage_rc(int b, int& R, int& C) { const int st = b / 1024, sb = b % 1024, swz = sb ^ (((sb >> 9) & 1) << 5); R = (st >> 1) * 16 + swz / 64; C = (st & 1) * 32 + (swz % 64) / 2; }
__host__ __device__ __forceinline__ int perm32(int rho) { const int n = rho >> 4, i = rho & 15; return 8 * (i >> 2) + 4 * n + (i & 3); }
struct Unit { int pm, pn; const char* a; const char* b; };
struct TileOrder {
    int nM, nN, nwg, G, c, skipctx;
    const char* A; size_t a_tile; int a_sh; size_t a_pn; const char* B; size_t b_tile;
    __device__ __forceinline__ void init(int nM_, int nN_, int G_, int c_, const void* A_, size_t a_tile_, const void* B_, size_t b_tile_, int a_sh_ = 0, size_t a_pn_ = 0) {
        nM = nM_; nN = nN_; nwg = nM * nN; G = G_; c = c_; skipctx = 0; A = (const char*)A_; a_tile = a_tile_; a_sh = a_sh_; a_pn = a_pn_; B = (const char*)B_; b_tile = b_tile_; }
    __device__ __forceinline__ bool next(int i, Unit& u) const {
        const long L = (long)i * G + c; if (L >= nwg) return false;
        int wgid = (int)L; { const int q = nwg / NXCD, r = nwg % NXCD, xcd = wgid % NXCD, off = wgid / NXCD; wgid = (xcd < r ? xcd * (q + 1) : r * (q + 1) + (xcd - r) * q) + off; }
        const int nig = WGM * nN, gid = wgid / nig, fm = gid * WGM, gsz = (nM - fm) < WGM ? (nM - fm) : WGM;
        u.pm = fm + ((wgid % nig) % gsz); u.pn = (wgid % nig) / gsz;
        if (skipctx) u.pm += u.pm / (TPB - 1) + 1;
        u.a = A + (size_t)u.pm * a_tile + (size_t)(u.pn >> a_sh) * a_pn; u.b = B + (size_t)u.pn * b_tile; return true;
    }
    __device__ __forceinline__ void a_ready(const Unit&) const {}
    __device__ __forceinline__ void done(const Unit&) const {}
};
__device__ __forceinline__ unsigned cvt_pk_bf16(float lo, float hi) { unsigned r; asm volatile("v_cvt_pk_bf16_f32 %0, %1, %2" : "=v"(r) : "v"(lo), "v"(hi)); return r; }

template <class Epi, class Sched>
__device__ __forceinline__ void gemm_phase(LAS unsigned char* lds, const int tid, const int K_, const int lda, const int ldb, const Sched& S, const Epi& E) {
    int K = K_; asm volatile("" : "+s"(K));
    const int wid = __builtin_amdgcn_readfirstlane(tid >> 6), lane = tid & 63, wr = wid >> 2, wc = wid & 3, fr = lane & 15, fq = lane >> 4;
    const int nt = K / BK;
    unsigned voffA[2], voffB[2];
#pragma unroll
    for (int i = 0; i < 2; ++i) { int R, C; stage_rc(tid * 16 + i * 8192, R, C); const int Rb = Epi::PERM ? ((R & ~31) + perm32(R & 31)) : R;
        voffA[i] = (unsigned)(R * lda + C) * 2u; voffB[i] = (unsigned)(Rb * ldb + C) * 2u; }
    const size_t kstep = (size_t)(BK * 2);
    const size_t hstepA = (size_t)HALF * lda * 2, hstepB = (size_t)HALF * ldb * 2;
    const unsigned ldsw = (unsigned)wid * 1024u;
    const int aoff = lds_byte(wr * 64 + fr, fq * 8), boff = lds_byte(wc * 32 + fr, fq * 8);
#define PG8_SA(b, h) (((b) * 2 + (h)) * HTB)
#define PG8_SB(b, h) ((4 + (b) * 2 + (h)) * HTB)
#define PG8_STAGE(bufoff, gbase, voff) do { _Pragma("unroll") for (int _i = 0; _i < 2; ++_i) \
        __builtin_amdgcn_global_load_lds((const unsigned*)((const char*)(gbase) + (voff)[_i]), (LAS unsigned*)(lds + (bufoff) + ldsw + _i * 8192), 16, 0, 0); } while (0)
#define PG8_LDA(dst, b, h) do { _Pragma("unroll") for (int m = 0; m < 4; ++m) _Pragma("unroll") for (int k = 0; k < 2; ++k) dst[m][k] = *(const LAS bf16x8*)(lds + PG8_SA(b, h) + aoff + m * 2048 + k * 1024); } while (0)
#define PG8_LDB(dst, b, h) do { _Pragma("unroll") for (int n = 0; n < 2; ++n) _Pragma("unroll") for (int k = 0; k < 2; ++k) dst[n][k] = *(const LAS bf16x8*)(lds + PG8_SB(b, h) + boff + n * 2048 + k * 1024); } while (0)
#define PG8_MMA(ai, bj, At, Bt) do { __builtin_amdgcn_s_setprio(1); _Pragma("unroll") for (int m = 0; m < 4; ++m) _Pragma("unroll") for (int n = 0; n < 2; ++n) _Pragma("unroll") for (int k = 0; k < 2; ++k) \
        acc[ai][bj][m][n] = __builtin_amdgcn_mfma_f32_16x16x32_bf16(Bt[n][k], At[m][k], acc[ai][bj][m][n], 0, 0, 0); __builtin_amdgcn_s_setprio(0); } while (0)
#define PG8_WAIT_V(n) asm volatile("s_waitcnt vmcnt(" #n ")" ::: "memory")
#define PG8_WAIT_L(n) asm volatile("s_waitcnt lgkmcnt(" #n ")" ::: "memory")
#define PG8_BAR __builtin_amdgcn_s_barrier()
#define PG8_SCHED __builtin_amdgcn_sched_barrier(0)
    Unit cur, nxt; int ui = 0;
    if (!S.next(0, cur)) return;
    f32x4 acc[2][2][4][2];
#pragma unroll
    for (int a = 0; a < 2; ++a)
#pragma unroll
        for (int b = 0; b < 2; ++b)
#pragma unroll
            for (int m = 0; m < 4; ++m)
#pragma unroll
                for (int n = 0; n < 2; ++n) acc[a][b][m][n] = (f32x4){0.f, 0.f, 0.f, 0.f};
    bf16x8 At[4][2], B0[2][2], B1[2][2];
    const char* cA = cur.a; const char* cB = cur.b;
    S.a_ready(cur);
    PG8_STAGE(PG8_SB(0, 0), cB, voffB); PG8_STAGE(PG8_SA(0, 0), cA, voffA); PG8_STAGE(PG8_SB(0, 1), cB + hstepB, voffB); PG8_STAGE(PG8_SA(0, 1), cA + hstepA, voffA);
    if (wr == 1) PG8_BAR;
    PG8_WAIT_V(4); PG8_BAR;
    PG8_STAGE(PG8_SB(1, 0), cB + kstep, voffB); PG8_STAGE(PG8_SA(1, 0), cA + kstep, voffA); PG8_STAGE(PG8_SB(1, 1), cB + hstepB + kstep, voffB);
    PG8_WAIT_V(6); PG8_BAR;
    for (;;) {
        const bool has_next = S.next(ui + 1, nxt);
        const char* nA = has_next ? nxt.a : cA; const char* nB = has_next ? nxt.b : cB;
        for (int t = 0; t < nt; t += 2) {
            const bool last = (t == nt - 2);
            const char* a1 = cA + (size_t)(t + 1) * kstep;
            const char* a2 = last ? nA : cA + (size_t)(t + 2) * kstep; const char* b2 = last ? nB : cB + (size_t)(t + 2) * kstep;
            const char* a3 = a2 + kstep; const char* b3 = b2 + kstep;
            if (last && has_next) S.a_ready(nxt);
            PG8_LDB(B0, 0, 0); PG8_SCHED; PG8_LDA(At, 0, 0); PG8_STAGE(PG8_SA(1, 1), a1 + hstepA, voffA);
            PG8_WAIT_L(8); PG8_BAR; PG8_WAIT_L(0); PG8_MMA(0, 0, At, B0); PG8_BAR; PG8_SCHED;
            PG8_LDB(B1, 0, 1); PG8_STAGE(PG8_SB(0, 0), b2, voffB);
            PG8_BAR; PG8_WAIT_L(0); PG8_MMA(0, 1, At, B1); PG8_BAR;
            PG8_LDA(At, 0, 1); PG8_STAGE(PG8_SA(0, 0), a2, voffA);
            PG8_BAR; PG8_WAIT_L(0); PG8_MMA(1, 0, At, B0); PG8_BAR; PG8_SCHED;
            PG8_STAGE(PG8_SB(0, 1), b2 + hstepB, voffB);
            PG8_WAIT_V(6); PG8_BAR; PG8_MMA(1, 1, At, B1); PG8_BAR;
            PG8_LDB(B0, 1, 0); PG8_SCHED; PG8_LDA(At, 1, 0); PG8_STAGE(PG8_SA(0, 1), a2 + hstepA, voffA);
            PG8_WAIT_L(8); PG8_BAR; PG8_WAIT_L(0); PG8_MMA(0, 0, At, B0); PG8_BAR; PG8_SCHED;
            PG8_LDB(B1, 1, 1); PG8_STAGE(PG8_SB(1, 0), b3, voffB);
            PG8_BAR; PG8_WAIT_L(0); PG8_MMA(0, 1, At, B1); PG8_BAR;
            PG8_LDA(At, 1, 1); PG8_STAGE(PG8_SA(1, 0), a3, voffA);
            PG8_BAR; PG8_WAIT_L(0); PG8_MMA(1, 0, At, B0); PG8_BAR; PG8_SCHED;
            PG8_STAGE(PG8_SB(1, 1), b3 + hstepB, voffB);
            PG8_WAIT_V(6); PG8_BAR; PG8_MMA(1, 1, At, B1); PG8_BAR;
        }
        E(acc, cur, wr, wc, fr, fq); S.done(cur);
        if (!has_next) break;
#pragma unroll
        for (int a = 0; a < 2; ++a)
#pragma unroll
            for (int b = 0; b < 2; ++b)
#pragma unroll
                for (int m = 0; m < 4; ++m)
#pragma unroll
                    for (int n = 0; n < 2; ++n) acc[a][b][m][n] = (f32x4){0.f, 0.f, 0.f, 0.f};
        cur = nxt; cA = nA; cB = nB; ++ui;
    }
    PG8_WAIT_V(0);
    if (wr == 0) PG8_BAR;
    PG8_BAR;
#undef PG8_SA
#undef PG8_SB
#undef PG8_STAGE
#undef PG8_LDA
#undef PG8_LDB
#undef PG8_MMA
#undef PG8_WAIT_V
#undef PG8_WAIT_L
#undef PG8_BAR
#undef PG8_SCHED
}

typedef const f32x4 (&AccRef)[2][2][4][2];
#ifndef NAIVE_GEMM
#define NAIVE_GEMM 0
#endif
template <class Epi, class Sched>
__device__ __forceinline__ void gemm_phase_naive(const int tid, const int K, const int lda, const int ldb, const Sched& S, const Epi& E) {
    const int wid = tid >> 6, lane = tid & 63, wr = wid >> 2, wc = wid & 3, fr = lane & 15, fq = lane >> 4;
    Unit cur;
    for (int ui = 0; S.next(ui, cur); ++ui) {
        f32x4 acc[2][2][4][2];
#pragma unroll
        for (int ai = 0; ai < 2; ++ai)
#pragma unroll
            for (int m = 0; m < 4; ++m) {
                const bf16* arow = (const bf16*)cur.a + (size_t)(128 * ai + 64 * wr + 16 * m + fr) * lda;
#pragma unroll
                for (int bj = 0; bj < 2; ++bj)
#pragma unroll
                    for (int n = 0; n < 2; ++n) {
                        const int c0 = 128 * bj + 32 * wc + (Epi::PERM ? 8 * fq + 4 * n : 16 * n + 4 * fq);
                        const bf16* b0 = (const bf16*)cur.b + (size_t)c0 * ldb;
                        float s0 = 0.f, s1 = 0.f, s2 = 0.f, s3 = 0.f;
                        for (int k = 0; k < K; k += 8) { float a[8], w[8]; unpack8(*(const u32x4*)(arow + k), a);
                            unpack8(*(const u32x4*)(b0 + k), w);
#pragma unroll
                            for (int x = 0; x < 8; ++x) s0 += a[x] * w[x];
                            unpack8(*(const u32x4*)(b0 + ldb + k), w);
#pragma unroll
                            for (int x = 0; x < 8; ++x) s1 += a[x] * w[x];
                            unpack8(*(const u32x4*)(b0 + 2 * ldb + k), w);
#pragma unroll
                            for (int x = 0; x < 8; ++x) s2 += a[x] * w[x];
                            unpack8(*(const u32x4*)(b0 + 3 * ldb + k), w);
#pragma unroll
                            for (int x = 0; x < 8; ++x) s3 += a[x] * w[x]; }
                        acc[ai][bj][m][n] = (f32x4){s0, s1, s2, s3}; } }
        E(acc, cur, wr, wc, fr, fq);
    }
}


struct EpiSplit {
    static constexpr bool PERM = true;
    bf16 *pe, *po; long se, so; int le, lo_; int wshift;
    __device__ __forceinline__ void operator()(AccRef acc, const Unit& u, int wr, int wc, int fr, int fq) const {
        const int rowb = u.pm * BM + wr * 64 + fr; const int colt = u.pn * BM; const int di = colt >> wshift, dh = di >> 1;
        bf16* base = (di & 1) ? po + (long)dh * so : pe + (long)dh * se; const int ldd = (di & 1) ? lo_ : le;
        const int col0 = (colt & ((1 << wshift) - 1)) + wc * 32 + 8 * fq;
#pragma unroll
        for (int ai = 0; ai < 2; ++ai)
#pragma unroll
            for (int m = 0; m < 4; ++m) { bf16* rowp = base + (size_t)(rowb + ai * HALF + m * 16) * ldd + col0;
#pragma unroll
                for (int bj = 0; bj < 2; ++bj) { const f32x4 v0 = acc[ai][bj][m][0], v1 = acc[ai][bj][m][1];
                    u32x4 w; w.x = cvt_pk_bf16(v0[0], v0[1]); w.y = cvt_pk_bf16(v0[2], v0[3]); w.z = cvt_pk_bf16(v1[0], v1[1]); w.w = cvt_pk_bf16(v1[2], v1[3]);
                    *(u32x4*)(rowp + bj * HALF) = w; } }
    }
};
struct EpiGlu {
    static constexpr bool PERM = true;
    const bf16* YG; bf16* Y; const float* gb;
    __device__ __forceinline__ void operator()(AccRef acc, const Unit& u, int wr, int wc, int fr, int fq) const {
        int rowb = u.pm * BM + wr * 64 + fr; const int col0 = u.pn * BM + wc * 32 + 8 * fq; asm volatile("" : "+v"(rowb));
        u32x4 ly[2][4], lg[2][4];
#define GLU_LD(g_, S) _Pragma("unroll") for (int q = 0; q < 4; ++q) { const size_t row = (size_t)(rowb + ((g_) >> 1) * HALF + (2 * ((g_) & 1) + (q >> 1)) * 16); const int col = col0 + (q & 1) * HALF; \
            ly[S][q] = *(const u32x4*)(YG + row * 1024 + col); lg[S][q] = *(const u32x4*)(Y + row * 2048 + col); }
        GLU_LD(0, 0)
#pragma unroll
        for (int g = 0; g < 4; ++g) {
            if (g + 1 < 4) { if ((g & 1) == 0) { GLU_LD(g + 1, 1) } else { GLU_LD(g + 1, 0) } }
#pragma unroll
            for (int q = 0; q < 4; ++q) { const int ai = g >> 1, m = 2 * (g & 1) + (q >> 1), bj = q & 1; const size_t row = (size_t)(rowb + ai * HALF + m * 16); const int col = col0 + bj * HALF;
                float y[8], gg[8], o[8]; unpack8(ly[g & 1][q], y); unpack8(lg[g & 1][q], gg);
                const f32x4 v0 = acc[ai][bj][m][0], v1 = acc[ai][bj][m][1];
                const float* gbp = gb + col; asm volatile("" : "+v"(gbp));
                const f32x4 b0 = *(const f32x4*)gbp, b1 = *(const f32x4*)(gbp + 4);
#pragma unroll
                for (int j = 0; j < 4; ++j) { o[j] = y[j] * sigm(v0[j] + b0[j]) * silu(gg[j]); o[4 + j] = y[4 + j] * sigm(v1[j] + b1[j]) * silu(gg[4 + j]); }
                *(u32x4*)(Y + row * 2048 + col) = pack8(o); }
        }
#undef GLU_LD
    }
};
struct EpiGate {
    static constexpr bool PERM = true;
    const bf16* XC; bf16* OM; const float *ba, *bx, *lam;
    __device__ __forceinline__ void operator()(AccRef acc, const Unit& u, int wr, int wc, int fr, int fq) const {
        const int rowb = u.pm * BM + wr * 64 + fr; const int h = u.pn >> 2, q = u.pn & 3, d = q >> 1, hf = q & 1;
        const int ch = h * 256 + hf * 128 + wc * 32 + 8 * fq;
        const int bq = u.pm / TPB; const bool cx = (u.pm - bq * TPB == 0) && d == 0;
        constexpr long dstep = (long)(SLAB / 2);
        bf16* const OMC = (bf16*)((char*)OM - (long)(WS_SLAB + 2 * SLAB - WS_ST)); bf16* const BT = OM + 3 * dstep;
        bf16* om = (cx ? OMC + ((long)bq * 256 - (long)u.pm * BM) * 1024 : OM + (long)d * dstep) + ch; bf16* bt = BT + (long)d * dstep + ch;
        float bav[8], bxv[8], sp[8];
#pragma unroll
        for (int j = 0; j < 8; ++j) { bav[j] = ba[d * 1024 + ch + j]; bxv[j] = bx[d * 1024 + ch + j]; sp[j] = lam[d * 1024 + ch + j]; }
        u32x4 xl[2][4];
#pragma unroll
        for (int ai = 0; ai < 2; ++ai)
#pragma unroll
            for (int m = 0; m < 4; ++m) xl[ai][m] = *(const u32x4*)(XC + (size_t)(rowb + ai * HALF + m * 16) * 1024 + ch);
#pragma unroll
        for (int ai = 0; ai < 2; ++ai)
#pragma unroll
            for (int m = 0; m < 4; ++m) { const size_t row = (size_t)(rowb + ai * HALF + m * 16);
                const f32x4 r0 = acc[ai][0][m][0], r1 = acc[ai][0][m][1], i0 = acc[ai][1][m][0], i1 = acc[ai][1][m][1];
                float x[8], o1[8], o2[8]; unpack8(xl[ai][m], x);
#pragma unroll
                for (int j = 0; j < 8; ++j) { const float vr = j < 4 ? r0[j & 3] : r1[j & 3], vi = j < 4 ? i0[j & 3] : i1[j & 3];
                    const float la = sp[j] * sigm(vr + bav[j]); float omj, mj; rg_coefs(la, omj, mj);
                    o1[j] = omj; o2[j] = mj * sigm(vi + bxv[j]) * x[j]; }
                *(u32x4*)(om + row * 1024) = pack8(o1); *(u32x4*)(bt + row * 1024) = pack8(o2); }
    }
};
struct EpiOut {
    static constexpr bool PERM = false;
    const float *srcLat, *srcCtx; float *dstLat, *dstCtx; const float* modl;
    __device__ __forceinline__ void operator()(AccRef acc, const Unit& u, int wr, int wc, int fr, int fq) const {
        const int b = u.pm / TPB, ti = u.pm - b * TPB;
        const float* src; float* dst; const float* gt;
        if (ti == 0) { src = srcCtx + (size_t)b * LCTX * D; dst = dstCtx + (size_t)b * LCTX * D; gt = modl + 4 * 3072 + 2048; }
        else { const size_t o = ((size_t)b * LLAT + (size_t)(ti - 1) * 256) * D; src = srcLat + o; dst = dstLat + o; gt = modl + b * 3072 + 2048; }
        const int rowb = wr * 64 + fr, col0 = u.pn * BM + wc * 32 + 4 * fq;
        f32x4 gv[2][2];
#pragma unroll
        for (int bj = 0; bj < 2; ++bj)
#pragma unroll
            for (int n = 0; n < 2; ++n) gv[bj][n] = *(const f32x4*)(gt + col0 + bj * HALF + n * 16);
        f32x4 xl[2][8];
#define OUT_LD(g_, S) { const float* sp_ = src + (size_t)(rowb + ((g_) >> 1) * HALF + 2 * ((g_) & 1) * 16) * D + col0; asm volatile("" : "+v"(sp_));     \
            _Pragma("unroll") for (int q = 0; q < 8; ++q) xl[S][q] = *(const f32x4*)(sp_ + (q >> 2) * 16 * D + ((q >> 1) & 1) * HALF + (q & 1) * 16); }
        OUT_LD(0, 0)
#pragma unroll
        for (int g = 0; g < 4; ++g) {
            if (g + 1 < 4) { if ((g & 1) == 0) { OUT_LD(g + 1, 1) } else { OUT_LD(g + 1, 0) } }
            float* dp_ = dst + (size_t)(rowb + (g >> 1) * HALF + 2 * (g & 1) * 16) * D + col0; asm volatile("" : "+v"(dp_));
#pragma unroll
            for (int q = 0; q < 8; ++q) { const int ai = g >> 1, m = 2 * (g & 1) + (q >> 2), bj = (q >> 1) & 1, n = q & 1;
                *(f32x4*)(dp_ + (q >> 2) * 16 * D + bj * HALF + n * 16) = xl[g & 1][q] + gv[bj][n] * acc[ai][bj][m][n]; }
        }
#undef OUT_LD
    }
};
struct CtxKOrder {
    int G, c; const char* A; size_t a_tile; const char* B; size_t b_tile;
    __device__ __forceinline__ bool next(int i, Unit& u) const {
        const int L = i * G + c; if (L >= 128) return false;
        const int ks = L & 7, pn = (L >> 3) & 3, b = L >> 5;
        u.pm = b * TPB; u.pn = pn | (ks << 8);
        u.a = A + (size_t)u.pm * a_tile + (size_t)ks * 256 * 2; u.b = B + (size_t)pn * b_tile + (size_t)ks * 256 * 2; return true;
    }
    __device__ __forceinline__ void a_ready(const Unit&) const {}
    __device__ __forceinline__ void done(const Unit&) const {}
};
struct CtxOrder {
    int G, c, c0, nN; const char* A; size_t a_tile; const char* B; size_t b_tile;
    __device__ __forceinline__ bool next(int i, Unit& u) const {
        const int L = i * G + c - c0; if (c < c0 || L >= NB * nN) return false;
        const int b = L / nN, pn = L - b * nN;
        u.pm = b * TPB; u.pn = pn; u.a = A + (size_t)u.pm * a_tile; u.b = B + (size_t)pn * b_tile; return true;
    }
    __device__ __forceinline__ void a_ready(const Unit&) const {}
    __device__ __forceinline__ void done(const Unit&) const {}
};
struct EpiPart {
    static constexpr bool PERM = false;
    float* P;
    __device__ __forceinline__ void operator()(AccRef acc, const Unit& u, int wr, int wc, int fr, int fq) const {
        const int ks = u.pn >> 8, pn = u.pn & 255, b = u.pm / TPB;
        float* dst = P + ((size_t)(ks * 4 + b) * 256 + wr * 64 + fr) * 1024 + pn * BM + wc * 32 + 4 * fq;
#pragma unroll
        for (int ai = 0; ai < 2; ++ai)
#pragma unroll
            for (int m = 0; m < 4; ++m)
#pragma unroll
                for (int bj = 0; bj < 2; ++bj)
#pragma unroll
                    for (int n = 0; n < 2; ++n) *(f32x4*)(dst + (size_t)(ai * HALF + m * 16) * 1024 + bj * HALF + n * 16) = acc[ai][bj][m][n];
    }
};
}

struct Args { const float* in[38]; float* out; unsigned char* ws; int ph_lo, ph_hi; };
#define CAS __attribute__((address_space(4)))
struct Ctx {
    LAS unsigned char* lds; int tid, lane, wave, bid, G, gw, NGW;
    const CAS char* kp; float* out; unsigned char* ws;
    __device__ __forceinline__ const float* in(int k) const { return *(const float* const CAS*)(kp + 8 * k); }
};
enum { I_X = 0, I_C, I_CTX, I_CCTX, I_NORMG, I_MODW, I_MODB, I_FINALG, I_EWIN, I_EWOUT, I_S5ARE, I_S5AIM, I_S5LOGDT, I_S5BRE, I_S5BIM, I_S5CRE, I_S5CIM, I_S5D, I_GLUW, I_GLUB,
       I_RGCW, I_RGCB, I_RGWA, I_RGBA, I_RGWX, I_RGBX, I_RGLAM, I_OWIN, I_OWOUT, I_MLCW, I_MLCB, I_MLWQ, I_MLWK, I_MLWV, I_MLWIF, I_MLBIF, I_MLNG, I_MLSKIP };

__device__ __forceinline__ const float* xrow_src(const Ctx& F, int l, int r, int lc) {
    const int b = r / SEQL, s = r - b * SEQL;
    if (s < LCTX) return (lc == 0 ? F.in(I_CTX) : (const float*)(F.ws + WS_XCTX)) + ((size_t)b * LCTX + s) * D;
    return (l == 0 ? F.in(I_X) : (const float*)F.out) + ((size_t)b * LLAT + (s - LCTX)) * D;
}

__device__ __forceinline__ void ph_mod(const Ctx& F) {
    LAS float* sl = (LAS float*)F.lds;
    LAS float* red = sl + 5 * 1024;
    for (int i = F.tid; i < 5 * 1024; i += NTHR) { const int bb = i >> 10, k = i & 1023; const float v = bb < 4 ? F.in(I_C)[bb * 1024 + k] : F.in(I_CCTX)[k]; sl[i] = silu(v); }
    __syncthreads();
    float* modv = (float*)(F.ws + WS_MODV);
    for (int it = F.bid; it < DEPTH * 48; it += F.G) {
        const int l = it / 48, j = (it - l * 48) * 64 + (F.tid & 63), kp = F.tid >> 6;
        const float* w = F.in(I_MODW) + (size_t)l * 1024 * 3072 + (size_t)(kp * 128) * 3072 + j;
        float a0 = 0.f, a1 = 0.f, a2 = 0.f, a3 = 0.f, a4 = 0.f;
#pragma unroll 16
        for (int k = 0; k < 128; ++k) { const float wv = w[(size_t)k * 3072]; const int kk = kp * 128 + k; a0 += sl[kk] * wv; a1 += sl[1024 + kk] * wv; a2 += sl[2048 + kk] * wv; a3 += sl[3072 + kk] * wv; a4 += sl[4096 + kk] * wv; }
        __syncthreads();
        red[(kp * 5 + 0) * 64 + (F.tid & 63)] = a0; red[(kp * 5 + 1) * 64 + (F.tid & 63)] = a1; red[(kp * 5 + 2) * 64 + (F.tid & 63)] = a2; red[(kp * 5 + 3) * 64 + (F.tid & 63)] = a3; red[(kp * 5 + 4) * 64 + (F.tid & 63)] = a4;
        __syncthreads();
        if (F.tid < 320) { const int bb = F.tid >> 6, jj = F.tid & 63; float t = 0.f;
#pragma unroll
            for (int q = 0; q < 8; ++q) t += red[(q * 5 + bb) * 64 + jj];
            const int jo = (it - l * 48) * 64 + jj;
            modv[((size_t)l * 5 + bb) * 3072 + jo] = t + F.in(I_MODB)[l * 3072 + jo]; }
    }
    __syncthreads();
}

__device__ __forceinline__ void transpose_item(const float* W, int N, bf16* WT, int ldw, int row_off, LAS float* scr, int item, int lane) {
    const int nblk = N / 32, kb = item / nblk, nbk = item % nblk, k0 = 64 * kb, n0 = 32 * nbk;
#pragma unroll 8
    for (int i = 0; i < 32; ++i) { const int kk = 2 * i + (lane >> 5); scr[kk * 33 + (lane & 31)] = W[(size_t)(k0 + kk) * N + n0 + (lane & 31)]; }
    WAVE_SYNC();
    const int c = lane & 7;
#pragma unroll
    for (int j = 0; j < 4; ++j) { const int n = (lane >> 3) + 8 * j; const LAS float* s = scr + (8 * c) * 33 + n;
        u32x4 o; o.x = pk2(s[0 * 33], s[1 * 33]); o.y = pk2(s[2 * 33], s[3 * 33]); o.z = pk2(s[4 * 33], s[5 * 33]); o.w = pk2(s[6 * 33], s[7 * 33]);
        *(u32x4*)(WT + (size_t)(row_off + n0 + n) * ldw + k0 + 8 * c) = o; }
    WAVE_SYNC();
}
__device__ __forceinline__ void ph_wconv_even(const Ctx& F, int j) {
    { const float* lam = F.in(I_RGLAM) + (size_t)j * 2048; float* spt = (float*)(F.ws + WS_SPT);
      for (int i = F.bid * NTHR + F.tid; i < 2048; i += F.G * NTHR) spt[i] = -8.f * softplus(-lam[i]); }
    LAS float* scr = (LAS float*)(F.lds + F.wave * 16384);
    bf16* win = (bf16*)(F.ws + WS_W + W_IN); bf16* wout = (bf16*)(F.ws + WS_W + W_OUT); bf16* wglu = (bf16*)(F.ws + WS_W + W_GLU); bf16* wgate = (bf16*)(F.ws + WS_W + W_GATE);
    constexpr int I_1 = 16 * 128, I_2 = 16 * 32, I_3 = 32 * 32, I_4 = 16 * 32;
    for (int it = F.gw; it < I_1 + I_2 + I_3 + I_4; it += F.NGW) {
        int r = it;
        if (r < I_1) { transpose_item(F.in(I_EWIN) + (size_t)j * 1024 * 4096, 4096, win, 1024, 0, scr, r, F.lane); continue; } r -= I_1;
        if (r < I_2) { transpose_item(F.in(I_GLUW) + (size_t)j * 1024 * 1024, 1024, wglu, 1024, 0, scr, r, F.lane); continue; } r -= I_2;
        if (r < I_3) { transpose_item(F.in(I_EWOUT) + (size_t)j * 2048 * 1024, 1024, wout, 2048, 0, scr, r, F.lane); continue; } r -= I_3;
        { const int mat = r >> 5, sub = r & 31, h = mat >> 2, q = mat & 3, d = q >> 1, isx = q & 1;
          const float* W = (isx ? F.in(I_RGWX) : F.in(I_RGWA)) + ((size_t)((j * 2 + d) * 4 + h)) * 256 * 256;
          const int n0 = 32 * (sub & 7);
          transpose_item(W, 256, wgate, 256, (4 * h + 2 * d + (n0 >> 7)) * 256 + isx * 128 + (n0 & 127) - n0, scr, sub, F.lane); }
    }
}
__device__ __forceinline__ void ph_wconv_odd(const Ctx& F, int j) {
    LAS float* scr = (LAS float*)(F.lds + F.wave * 16384);
    bf16* win = (bf16*)(F.ws + WS_W + W_IN); bf16* wout = (bf16*)(F.ws + WS_W + W_OUT);
    constexpr int I_1 = 16 * 128, I_3 = 32 * 32;
    for (int it = F.gw; it < I_1 + I_3; it += F.NGW) {
        int r = it;
        if (r < I_1) { transpose_item(F.in(I_OWIN) + (size_t)j * 1024 * 4096, 4096, win, 1024, 0, scr, r, F.lane); continue; } r -= I_1;
        transpose_item(F.in(I_OWOUT) + (size_t)j * 2048 * 1024, 1024, wout, 2048, 0, scr, r, F.lane);
    }
    const float* wq = F.in(I_MLWQ) + (size_t)j * 512 * 16; const float* wk = F.in(I_MLWK) + (size_t)j * 512 * 16; const float* wv = F.in(I_MLWV) + (size_t)j * 512 * 16;
    float* mg = (float*)(F.ws + WS_MG);
    for (int idx = F.bid * NTHR + F.tid; idx < 512 * 16; idx += F.G * NTHR) { const int g = idx >> 4, i = (idx >> 2) & 3, jj = idx & 3; float a = 0.f;
#pragma unroll
        for (int o = 0; o < 4; ++o) a += wq[g * 16 + i * 4 + o] * wk[g * 16 + jj * 4 + o];
        mg[idx] = a * 0.04419417382415922f; }
    unsigned* wgt = (unsigned*)(F.ws + WS_WGT);
    const float* wif = F.in(I_MLWIF) + (size_t)j * 2 * 3 * 2048 * 8;
    for (int idx = F.bid * NTHR + F.tid; idx < 1024 * 32; idx += F.G * NTHR) {
        const int cp = idx >> 5, src = (idx >> 4) & 1, o = idx & 15, d = o >> 3, n8 = o & 7; float wv2[2];
#pragma unroll
        for (int half = 0; half < 2; ++half) { const int c = 2 * cp + half, g = c >> 2, i = c & 3; float a = 0.f;
#pragma unroll
            for (int oo = 0; oo < 4; ++oo) {
                if (src) a += wv[g * 16 + i * 4 + oo] * wif[((size_t)(d * 3 + 2) * 2048 + 4 * g + oo) * 8 + n8];
                else a += wq[g * 16 + i * 4 + oo] * wif[((size_t)(d * 3 + 0) * 2048 + 4 * g + oo) * 8 + n8] + wk[g * 16 + i * 4 + oo] * wif[((size_t)(d * 3 + 1) * 2048 + 4 * g + oo) * 8 + n8]; }
            wv2[half] = a; }
        const int c0 = 2 * cp, cq = c0 >> 9, rem = c0 & 511, kk = rem >> 7, g4 = (rem >> 5) & 3, i4 = (rem >> 3) & 3, e2 = (rem & 7) >> 1;
        wgt[((size_t)(((src * 4 + cq) * 16 + kk * 4 + i4) * 64 + g4 * 16 + o)) * 4 + e2] = pk2(wv2[0], wv2[1]);
    }
}

__device__ __forceinline__ void fold_ctx(const Ctx& F, const float* P, const float* gtc, int r, f32x4 (&v)[4]) {
    const int b = r / SEQL, s = r - b * SEQL;
    if (s >= LCTX) return;
    const int row = b * LCTX + s;
    const f32x4* p = (const f32x4*)(P + (size_t)row * 1024) + F.lane;
    f32x4 a[4];
#pragma unroll
    for (int jj = 0; jj < 4; ++jj) a[jj] = p[64 * jj];
#pragma unroll
    for (int ks = 1; ks < 8; ++ks)
#pragma unroll
        for (int jj = 0; jj < 4; ++jj) a[jj] += p[(size_t)ks * (1024 * 256) + 64 * jj];
    f32x4* xo = (f32x4*)((float*)(F.ws + WS_XCTX) + (size_t)row * 1024) + F.lane;
#pragma unroll
    for (int jj = 0; jj < 4; ++jj) { const f32x4 g = *(const f32x4*)(gtc + 4 * F.lane + 256 * jj); v[jj] = v[jj] + g * a[jj]; xo[64 * jj] = v[jj]; }
}
__device__ __forceinline__ void ph_norm(const Ctx& F, int l, int r0, int r1, bf16* HB, const float* P) {
    const float* modl = (const float*)(F.ws + WS_MODV) + (size_t)l * 5 * 3072;
    const float* ng = F.in(I_NORMG) + l * 1024;
    const float* gtc = modl - 5 * 3072 + 4 * 3072 + 2048;
    const int lc = P ? l - 1 : l;
    for (int ra = r0 + F.gw; ra < r1; ra += 2 * F.NGW) {
        const int rb = ra + F.NGW; const bool hasb = rb < r1; const int rbb = hasb ? rb : ra;
        const f32x4* xa = (const f32x4*)xrow_src(F, l, ra, lc) + F.lane; const f32x4* xb = (const f32x4*)xrow_src(F, l, rbb, lc) + F.lane;
        f32x4 va[4], vb[4]; float sa = 0.f, sb = 0.f;
#pragma unroll
        for (int jj = 0; jj < 4; ++jj) { va[jj] = xa[64 * jj]; vb[jj] = xb[64 * jj]; }
        if (P) { fold_ctx(F, P, gtc, ra, va); if (hasb) fold_ctx(F, P, gtc, rb, vb); }
#pragma unroll
        for (int jj = 0; jj < 4; ++jj) { sa += (va[jj].x * va[jj].x + va[jj].y * va[jj].y) + (va[jj].z * va[jj].z + va[jj].w * va[jj].w); sb += (vb[jj].x * vb[jj].x + vb[jj].y * vb[jj].y) + (vb[jj].z * vb[jj].z + vb[jj].w * vb[jj].w); }
        const float rsa = rsqrtf(wave_sum(sa) * (1.f / D) + EPS), rsb = rsqrtf(wave_sum(sb) * (1.f / D) + EPS);
#pragma unroll
        for (int w2 = 0; w2 < 2; ++w2) { if (w2 == 1 && !hasb) break;
            const int r = w2 ? rb : ra; const float rstd = w2 ? rsb : rsa;
            const int b = r / SEQL, s = r - b * SEQL, bb = s < LCTX ? 4 : b;
            const float* sh = modl + bb * 3072; const float* sc = sh + 1024;
            unsigned long long* o8 = (unsigned long long*)(HB + (size_t)(r - r0) * D) + F.lane;
#pragma unroll
            for (int jj = 0; jj < 4; ++jj) { const int c = 4 * F.lane + 256 * jj; const f32x4 v = w2 ? vb[jj] : va[jj];
                const f32x4 g = *(const f32x4*)(ng + c), a = *(const f32x4*)(sc + c), h = *(const f32x4*)(sh + c);
                const float y0 = v.x * rstd * g.x * (1.f + a.x) + h.x, y1 = v.y * rstd * g.y * (1.f + a.y) + h.y, y2 = v.z * rstd * g.z * (1.f + a.z) + h.z, y3 = v.w * rstd * g.w * (1.f + a.w) + h.w;
                o8[64 * jj] = (unsigned long long)pk2(y0, y1) | ((unsigned long long)pk2(y2, y3) << 32); } }
    }
}

__device__ __forceinline__ void ph_rgconv(const Ctx& F, int j, const bf16* XR, bf16* XC) {
    const float* cw = F.in(I_RGCW) + (size_t)j * 4 * 1024; const float* cb = F.in(I_RGCB) + (size_t)j * 1024;
    for (int it = F.bid * NTHR + F.tid; it < M * 128; it += F.G * NTHR) {
        const int r = it >> 7, c = (it & 127) * 8, b = r / SEQL, s = r - b * SEQL;
        float a[8];
#pragma unroll
        for (int e = 0; e < 8; ++e) a[e] = cb[c + e];
#pragma unroll
        for (int t = 0; t < 4; ++t) { const int sn = nb_even(s, t - 1);
            if (sn >= 0) { float x[8]; unpack8(*(const u32x4*)(XR + ((size_t)b * SEQL + sn) * 1024 + c), x);
#pragma unroll
                for (int e = 0; e < 8; ++e) a[e] += cw[t * 1024 + c + e] * x[e]; } }
        *(u32x4*)(XC + (size_t)r * 1024 + c) = pack8(a);
    }
}

__device__ __forceinline__ void ph_s5_naive(const Ctx& F, int j, const bf16* U, bf16* YS0, bf16* YS1) {
    if ((F.wave & 3) != 0) return;
    const int slot = F.wave >> 2;
    LAS float* xre = (LAS float*)(F.lds + slot * 65536);
    LAS float* xim = xre + 64 * 65;
    LAS float* cre = xim + 64 * 65;
    LAS float* cim = cre + 1024;
    LAS float* ub = cim + 1024;
    const int p = F.lane;
    for (int q = F.bid * 2 + slot; q < NB * 2 * 64; q += F.G * 2) {
        const int b = q >> 7, d = (q >> 6) & 1, g = q & 63;
        const size_t pg = (size_t)((j * 2 + d) * 64 + g);
        const float are = F.in(I_S5ARE)[pg * 64 + p], aim = F.in(I_S5AIM)[pg * 64 + p], dt = expf(F.in(I_S5LOGDT)[pg]);
        const float dar = dt * are, dai = dt * aim, mag = expf(dar);
        const float abr = mag * cosf(dai), abi = mag * sinf(dai);
        const float den = are * are + aim * aim, nr = abr - 1.f, ni = abi;
        const float cor = (nr * are + ni * aim) / den, coi = (ni * are - nr * aim) / den;
        float bbr[16], bbi[16];
#pragma unroll
        for (int h = 0; h < 16; ++h) { const float br = F.in(I_S5BRE)[(pg * 64 + p) * 16 + h], bi = F.in(I_S5BIM)[(pg * 64 + p) * 16 + h]; bbr[h] = cor * br - coi * bi; bbi[h] = cor * bi + coi * br; }
#pragma unroll
        for (int h = 0; h < 16; ++h) { cre[h * 64 + p] = F.in(I_S5CRE)[(pg * 16 + h) * 64 + p]; cim[h * 64 + p] = F.in(I_S5CIM)[(pg * 16 + h) * 64 + p]; }
        bf16* YS = d ? YS1 : YS0;
        float sr = 0.f, si = 0.f;
        for (int ck = 0; ck < SEQL / 64; ++ck) {
            const size_t myrow = (size_t)b * SEQL + pos2s_even(ck * 64 + F.lane, d);
            { float x[8]; unpack8(*(const u32x4*)(U + myrow * 1024 + 16 * g), x);
#pragma unroll
              for (int e = 0; e < 8; ++e) ub[F.lane * 16 + e] = x[e];
              unpack8(*(const u32x4*)(U + myrow * 1024 + 16 * g + 8), x);
#pragma unroll
              for (int e = 0; e < 8; ++e) ub[F.lane * 16 + 8 + e] = x[e]; }
            WAVE_SYNC();
            for (int t = 0; t < 64; ++t) {
                float bur = 0.f, bui = 0.f;
#pragma unroll
                for (int h4 = 0; h4 < 4; ++h4) { const f32x4 uv = *(const LAS f32x4*)(ub + t * 16 + h4 * 4);
                    bur += bbr[h4 * 4] * uv.x + bbr[h4 * 4 + 1] * uv.y + bbr[h4 * 4 + 2] * uv.z + bbr[h4 * 4 + 3] * uv.w;
                    bui += bbi[h4 * 4] * uv.x + bbi[h4 * 4 + 1] * uv.y + bbi[h4 * 4 + 2] * uv.z + bbi[h4 * 4 + 3] * uv.w; }
                const float nsr = abr * sr - abi * si + bur, nsi = abr * si + abi * sr + bui;
                sr = nsr; si = nsi;
                xre[p * 65 + t] = sr; xim[p * 65 + t] = si;
            }
            WAVE_SYNC();
            float y[16];
#pragma unroll
            for (int h = 0; h < 16; ++h) y[h] = 0.f;
            for (int pp = 0; pp < 64; ++pp) { const float vr = xre[pp * 65 + F.lane], vi = xim[pp * 65 + F.lane];
#pragma unroll
                for (int h = 0; h < 16; ++h) y[h] += vr * cre[h * 64 + pp] - vi * cim[h * 64 + pp]; }
            { float o[8];
#pragma unroll
              for (int e = 0; e < 8; ++e) o[e] = y[e];
              *(u32x4*)(YS + myrow * 1024 + 16 * g) = pack8(o);
#pragma unroll
              for (int e = 0; e < 8; ++e) o[e] = y[8 + e];
              *(u32x4*)(YS + myrow * 1024 + 16 * g + 8) = pack8(o); }
            WAVE_SYNC();
        }
    }
}
typedef float f32x16s __attribute__((ext_vector_type(16)));
__device__ __forceinline__ float xhalf(const float v, const int hh) { const auto r = __builtin_amdgcn_permlane32_swap(__float_as_uint(v), __float_as_uint(v), false, false); return __uint_as_float(hh ? r[0] : r[1]); }
__device__ __forceinline__ void ph_s5_mfma(const Ctx& F, int j, bf16* U, bf16* YS0) {
    const int qd = F.wave;
    constexpr int XS = 272;
    constexpr int NCQ = SEQL / 32 / 8;
    LAS unsigned char* const X = F.lds + F.wave * 8704;
    LAS bf16x8* const FRL = (LAS bf16x8*)(F.lds + 8 * 8704);
    LAS f32x4* const PWT = (LAS f32x4*)(F.lds + 8 * 8704 + 8192);
    LAS f32x4* const ES = (LAS f32x4*)(F.lds + 8 * 8704 + 24576);
    const float* dd = F.in(I_S5D) + (size_t)j * 1024;
    const int lane = F.lane, c = lane & 31, hh = lane >> 5;
    const int qb = (F.G == 256) ? ((F.bid & 7) * 32 + (F.bid >> 3)) : F.bid;
    for (int q = qb; q < NB * 64; q += F.G) {
        const int b = q >> 6, g = q & 63;
#pragma unroll 1
      for (int d = 0; d < 2; ++d) {
        const size_t pg = (size_t)((j * 2 + d) * 64 + g);
        const float dt = expf(F.in(I_S5LOGDT)[pg]);
        float abr[2], abi[2], cor[2], coi[2], a16r[2], a16i[2], aqr[2], aqi[2];
#pragma unroll
        for (int st = 0; st < 2; ++st) { const int pp = st * 32 + c; const float are = F.in(I_S5ARE)[pg * 64 + pp], aim = F.in(I_S5AIM)[pg * 64 + pp];
            const float dar = dt * are, dai = dt * aim, mag = expf(dar); abr[st] = mag * cosf(dai); abi[st] = mag * sinf(dai);
            const float den = are * are + aim * aim, nr = abr[st] - 1.f, ni = abi[st]; cor[st] = (nr * are + ni * aim) / den; coi[st] = (ni * are - nr * aim) / den;
            const float m16 = expf(16.f * dar); a16r[st] = m16 * cosf(16.f * dai); a16i[st] = m16 * sinf(16.f * dai);
            const float mq = expf((float)(NCQ * 32) * dar); aqr[st] = mq * cosf((float)(NCQ * 32) * dai); aqi[st] = mq * sinf((float)(NCQ * 32) * dai); }
        __syncthreads();
        if (qd == 0) {
            { float pr = abr[0], pi = abi[0], qr = abr[1], qi = abi[1];
#pragma unroll 1
              for (int i = 0; i < 16; ++i) { PWT[i * 64 + lane] = (f32x4){pr, pi, qr, qi};
                  const float npr = pr * abr[0] - pi * abi[0], npi = pr * abi[0] + pi * abr[0]; pr = npr; pi = npi;
                  const float nqr = qr * abr[1] - qi * abi[1], nqi = qr * abi[1] + qi * abr[1]; qr = nqr; qi = nqi; } }
#pragma unroll
            for (int st = 0; st < 2; ++st) { const int pp = st * 32 + c;
                const f32x4 br0 = *(const f32x4*)(F.in(I_S5BRE) + (pg * 64 + pp) * 16 + 8 * hh), br1 = *(const f32x4*)(F.in(I_S5BRE) + (pg * 64 + pp) * 16 + 8 * hh + 4);
                const f32x4 bi0 = *(const f32x4*)(F.in(I_S5BIM) + (pg * 64 + pp) * 16 + 8 * hh), bi1 = *(const f32x4*)(F.in(I_S5BIM) + (pg * 64 + pp) * 16 + 8 * hh + 4);
                const float brv[8] = {br0.x, br0.y, br0.z, br0.w, br1.x, br1.y, br1.z, br1.w}, biv[8] = {bi0.x, bi0.y, bi0.z, bi0.w, bi1.x, bi1.y, bi1.z, bi1.w};
                float vr[8], vi[8];
#pragma unroll
                for (int i = 0; i < 8; ++i) { vr[i] = cor[st] * brv[i] - coi[st] * biv[i]; vi[i] = cor[st] * biv[i] + coi[st] * brv[i]; }
                FRL[st * 64 + lane] = __builtin_bit_cast(bf16x8, pack8(vr)); FRL[(2 + st) * 64 + lane] = __builtin_bit_cast(bf16x8, pack8(vi)); }
#pragma unroll
            for (int ks = 0; ks < 4; ++ks) { const int c2a = 8 * ks + 2 * (lane >> 4); const size_t ro = (pg * 16 + (lane & 15)) * 64;
                const float2 r0 = *(const float2*)(F.in(I_S5CRE) + ro + c2a), r1 = *(const float2*)(F.in(I_S5CRE) + ro + 32 + c2a);
                const float2 m0 = *(const float2*)(F.in(I_S5CIM) + ro + c2a), m1 = *(const float2*)(F.in(I_S5CIM) + ro + 32 + c2a);
                const float v[8] = {r0.x, r1.x, -m0.x, -m1.x, r0.y, r1.y, -m0.y, -m1.y};
                FRL[(4 + ks) * 64 + lane] = __builtin_bit_cast(bf16x8, pack8(v)); }
        }
        __syncthreads();
        const int tau = 16 * ((c >> 2) & 1) + 4 * (c >> 3) + (c & 3);
        float cin[4] = {0.f, 0.f, 0.f, 0.f};
        const int ck0 = qd * NCQ;
#define S5_HEAD() \
                const bf16x8 ucur = unext; \
                if (ck + 1 < ck0 + NCQ) unext = *(const bf16x8*)(U + ((size_t)b * SEQL + pos2s_even(32 * (ck + 1) + tau, d)) * 1024 + 16 * g + 8 * hh); \
                f32x16s t0, t1, t2, t3; \
                _Pragma("unroll") for (int i = 0; i < 16; ++i) { t0[i] = 0.f; t1[i] = 0.f; t2[i] = 0.f; t3[i] = 0.f; } \
                t0 = __builtin_amdgcn_mfma_f32_32x32x16_bf16(ucur, FRL[lane], t0, 0, 0, 0); t1 = __builtin_amdgcn_mfma_f32_32x32x16_bf16(ucur, FRL[64 + lane], t1, 0, 0, 0); \
                t2 = __builtin_amdgcn_mfma_f32_32x32x16_bf16(ucur, FRL[128 + lane], t2, 0, 0, 0); t3 = __builtin_amdgcn_mfma_f32_32x32x16_bf16(ucur, FRL[192 + lane], t3, 0, 0, 0); \
                  \
                { float xr = 0.f, xi = 0.f, yr = 0.f, yi = 0.f; \
                  _Pragma("unroll") for (int i = 0; i < 16; ++i) { const float nr = abr[0] * xr - abi[0] * xi + t0[i], ni = abr[0] * xi + abi[0] * xr + t2[i]; t0[i] = nr; t2[i] = ni; xr = nr; xi = ni; \
                      const float mr = abr[1] * yr - abi[1] * yi + t1[i], mi = abr[1] * yi + abi[1] * yr + t3[i]; t1[i] = mr; t3[i] = mi; yr = mr; yi = mi; } } \
                __builtin_amdgcn_sched_barrier(0); \
                  \
                float ce[4]; \
                { const float l0 = xhalf(t0[15], hh), l2 = xhalf(t2[15], hh), l1 = xhalf(t1[15], hh), l3 = xhalf(t3[15], hh); \
                  const float e0 = l0 + (a16r[0] * cin[0] - a16i[0] * cin[1]), e1 = l2 + (a16r[0] * cin[1] + a16i[0] * cin[0]); \
                  const float e2 = l1 + (a16r[1] * cin[2] - a16i[1] * cin[3]), e3 = l3 + (a16r[1] * cin[3] + a16i[1] * cin[2]); \
                  ce[0] = hh ? e0 : cin[0]; ce[1] = hh ? e1 : cin[1]; ce[2] = hh ? e2 : cin[2]; ce[3] = hh ? e3 : cin[3]; }
        {
            bf16x8 unext = *(const bf16x8*)(U + ((size_t)b * SEQL + pos2s_even(32 * ck0 + tau, d)) * 1024 + 16 * g + 8 * hh);
#pragma unroll 1
            for (int ck = ck0; ck < ck0 + NCQ; ++ck) {
                S5_HEAD()
                const float n0 = t0[15] + (a16r[0] * ce[0] - a16i[0] * ce[1]), n1 = t2[15] + (a16r[0] * ce[1] + a16i[0] * ce[0]);
                const float n2 = t1[15] + (a16r[1] * ce[2] - a16i[1] * ce[3]), n3 = t3[15] + (a16r[1] * ce[3] + a16i[1] * ce[2]);
                const float o0 = xhalf(n0, hh), o1 = xhalf(n1, hh), o2 = xhalf(n2, hh), o3 = xhalf(n3, hh);
                cin[0] = hh ? n0 : o0; cin[1] = hh ? n1 : o1; cin[2] = hh ? n2 : o2; cin[3] = hh ? n3 : o3;
            }
            ES[qd * 64 + lane] = (f32x4){cin[0], cin[1], cin[2], cin[3]};
            __syncthreads();
            float c0 = 0.f, c1 = 0.f, c2 = 0.f, c3 = 0.f;
            for (int k = 0; k < qd; ++k) { const f32x4 e = ES[k * 64 + lane];
                const float n0 = aqr[0] * c0 - aqi[0] * c1 + e.x, n1 = aqr[0] * c1 + aqi[0] * c0 + e.y, n2 = aqr[1] * c2 - aqi[1] * c3 + e.z, n3 = aqr[1] * c3 + aqi[1] * c2 + e.w;
                c0 = n0; c1 = n1; c2 = n2; c3 = n3; }
            cin[0] = c0; cin[1] = c1; cin[2] = c2; cin[3] = c3;
        }
        {
            bf16x8 unext = *(const bf16x8*)(U + ((size_t)b * SEQL + pos2s_even(32 * ck0 + tau, d)) * 1024 + 16 * g + 8 * hh);
#pragma unroll 1
            for (int ck = ck0; ck < ck0 + NCQ; ++ck) {
                S5_HEAD()
#pragma unroll
                for (int i = 0; i < 16; ++i) { const f32x4 pw = PWT[i * 64 + lane];
                    t0[i] += pw.x * ce[0] - pw.y * ce[1]; t2[i] += pw.x * ce[1] + pw.y * ce[0]; t1[i] += pw.z * ce[2] - pw.w * ce[3]; t3[i] += pw.z * ce[3] + pw.w * ce[2]; }
                { const float o0 = xhalf(t0[15], hh), o1 = xhalf(t2[15], hh), o2 = xhalf(t1[15], hh), o3 = xhalf(t3[15], hh);
                  cin[0] = hh ? t0[15] : o0; cin[1] = hh ? t2[15] : o1; cin[2] = hh ? t1[15] : o2; cin[3] = hh ? t3[15] : o3; }
                __builtin_amdgcn_sched_barrier(0);
#pragma unroll
                for (int i = 0; i < 16; ++i) { u32x2 w; w.x = pk2(t0[i], t1[i]); w.y = pk2(t2[i], t3[i]); *(LAS u32x2*)(X + (16 * hh + i) * XS + 8 * c) = w; }
                WAVE_SYNC();
                __builtin_amdgcn_sched_barrier(0);
                f32x4 y0 = (f32x4){0.f, 0.f, 0.f, 0.f}, y1 = (f32x4){0.f, 0.f, 0.f, 0.f};
#pragma unroll
                for (int ks = 0; ks < 4; ++ks) { const bf16x8 x0 = *(const LAS bf16x8*)(X + (lane & 15) * XS + 64 * ks + 16 * (lane >> 4)), x1 = *(const LAS bf16x8*)(X + (16 + (lane & 15)) * XS + 64 * ks + 16 * (lane >> 4));
                    const bf16x8 cf = FRL[(4 + ks) * 64 + lane]; y0 = __builtin_amdgcn_mfma_f32_16x16x32_bf16(cf, x0, y0, 0, 0, 0); y1 = __builtin_amdgcn_mfma_f32_16x16x32_bf16(cf, x1, y1, 0, 0, 0); }
                { const size_t o0 = ((size_t)b * SEQL + pos2s_even(32 * ck + (lane & 15), d)) * 1024 + 16 * g + 4 * (lane >> 4), o1 = ((size_t)b * SEQL + pos2s_even(32 * ck + 16 + (lane & 15), d)) * 1024 + 16 * g + 4 * (lane >> 4);
                  if (d == 0) { u32x2 w; w.x = pk2(y0[0], y0[1]); w.y = pk2(y0[2], y0[3]); *(u32x2*)(YS0 + o0) = w;
                      w.x = pk2(y1[0], y1[1]); w.y = pk2(y1[2], y1[3]); *(u32x2*)(YS0 + o1) = w; }
                  else {
                      const unsigned long long f0 = __hip_atomic_load((const unsigned long long*)(YS0 + o0), __ATOMIC_RELAXED, __HIP_MEMORY_SCOPE_AGENT), f1 = __hip_atomic_load((const unsigned long long*)(YS0 + o1), __ATOMIC_RELAXED, __HIP_MEMORY_SCOPE_AGENT);
                      const u32x2 u0 = *(const u32x2*)(U + o0), u1 = *(const u32x2*)(U + o1);
                      const f32x4 dv = *(const f32x4*)(dd + 16 * g + 4 * (lane >> 4));
                      const unsigned fa0 = (unsigned)f0, fb0 = (unsigned)(f0 >> 32), fa1 = (unsigned)f1, fb1 = (unsigned)(f1 >> 32);
                      u32x2 w;
                      w.x = pk2(gelu_tanh(bf2f(fa0 & 0xffffu) + y0[0] + dv.x * bf2f(u0.x & 0xffffu)), gelu_tanh(bf2f(fa0 >> 16) + y0[1] + dv.y * bf2f(u0.x >> 16)));
                      w.y = pk2(gelu_tanh(bf2f(fb0 & 0xffffu) + y0[2] + dv.z * bf2f(u0.y & 0xffffu)), gelu_tanh(bf2f(fb0 >> 16) + y0[3] + dv.w * bf2f(u0.y >> 16)));
                      *(u32x2*)(U + o0) = w;
                      w.x = pk2(gelu_tanh(bf2f(fa1 & 0xffffu) + y1[0] + dv.x * bf2f(u1.x & 0xffffu)), gelu_tanh(bf2f(fa1 >> 16) + y1[1] + dv.y * bf2f(u1.x >> 16)));
                      w.y = pk2(gelu_tanh(bf2f(fb1 & 0xffffu) + y1[2] + dv.z * bf2f(u1.y & 0xffffu)), gelu_tanh(bf2f(fb1 >> 16) + y1[3] + dv.w * bf2f(u1.y >> 16)));
                      *(u32x2*)(U + o1) = w; } }
                WAVE_SYNC();
            }
        }
#undef S5_HEAD
      }
    }
    __syncthreads();
}
__device__ __forceinline__ void ph_s5_post(const Ctx& F, int j, bf16* U, const bf16* YS0, const bf16* YS1) {
    const float* dd = F.in(I_S5D) + (size_t)j * 1024;
    const int stride = F.G * NTHR;
    for (int it = F.bid * NTHR + F.tid; it < M * 128; it += 2 * stride) {
        const int it2 = it + stride; const bool has2 = it2 < M * 128;
        const size_t o1 = (size_t)it * 8, o2 = (size_t)(has2 ? it2 : it) * 8; const int c1 = (it & 127) * 8, c2 = ((has2 ? it2 : it) & 127) * 8;
        const u32x4 u1 = *(const u32x4*)(U + o1), a1 = *(const u32x4*)(YS0 + o1), b1 = *(const u32x4*)(YS1 + o1);
        const u32x4 u2 = *(const u32x4*)(U + o2), a2 = *(const u32x4*)(YS0 + o2), b2 = *(const u32x4*)(YS1 + o2);
        { float u[8], a[8], b[8], o[8]; unpack8(u1, u); unpack8(a1, a); unpack8(b1, b);
#pragma unroll
          for (int e = 0; e < 8; ++e) o[e] = gelu_tanh(a[e] + b[e] + dd[c1 + e] * u[e]);
          *(u32x4*)(U + o1) = pack8(o); }
        if (has2) { float u[8], a[8], b[8], o[8]; unpack8(u2, u); unpack8(a2, a); unpack8(b2, b);
#pragma unroll
          for (int e = 0; e < 8; ++e) o[e] = gelu_tanh(a[e] + b[e] + dd[c2 + e] * u[e]);
          *(u32x4*)(U + o2) = pack8(o); }
    }
}
__device__ __forceinline__ void ph_rgscan_a(const Ctx& F, const bf16* OM0, const bf16* OM1, const bf16* BT0, const bf16* BT1, float* RGE, float* RGP, const bf16* OMC) {
    for (int it = F.wave * F.G + F.bid; it < NB * 2 * TPB * 4; it += F.NGW) {
        const int cg = it & 3, k = (it >> 2) % TPB, bd = (it >> 2) / TPB, b = bd >> 1, d = bd & 1, ch = cg * 256 + 4 * F.lane;
        const int r0 = pos2s_even(256 * k, d); const long rs = d ? -1024 : 1024;
        const bf16* OM = (d ? OM1 + ((size_t)b * SEQL + r0) * 1024 : (k == 0 ? OMC + ((size_t)b * 256 + r0) * 1024 : OM0 + ((size_t)b * SEQL + r0) * 1024)) + ch;
        const bf16* BT = (d ? BT1 : BT0) + ((size_t)b * SEQL + r0) * 1024 + ch;
        float h0 = 0.f, h1 = 0.f, h2 = 0.f, h3 = 0.f, p0 = 1.f, p1 = 1.f, p2 = 1.f, p3 = 1.f;
        u32x2 ow[16], bw[16], on[16], bn[16];
#pragma unroll
        for (int e = 0; e < 16; ++e) { ow[e] = *(const u32x2*)(OM + e * rs); bw[e] = *(const u32x2*)(BT + e * rs); }
#pragma unroll 1
        for (int t = 0; t < 256; t += 16) {
            const int tn = t + 16 < 256 ? t + 16 : t;
#pragma unroll
            for (int e = 0; e < 16; ++e) { on[e] = *(const u32x2*)(OM + (tn + e) * rs); bn[e] = *(const u32x2*)(BT + (tn + e) * rs); }
#pragma unroll
            for (int e = 0; e < 16; ++e) {
                const float a0 = 1.f - bf2f(ow[e].x & 0xffffu), a1 = 1.f - bf2f(ow[e].x >> 16), a2 = 1.f - bf2f(ow[e].y & 0xffffu), a3 = 1.f - bf2f(ow[e].y >> 16);
                h0 = a0 * h0 + bf2f(bw[e].x & 0xffffu); p0 *= a0; h1 = a1 * h1 + bf2f(bw[e].x >> 16); p1 *= a1;
                h2 = a2 * h2 + bf2f(bw[e].y & 0xffffu); p2 *= a2; h3 = a3 * h3 + bf2f(bw[e].y >> 16); p3 *= a3; }
#pragma unroll
            for (int e = 0; e < 16; ++e) { ow[e] = on[e]; bw[e] = bn[e]; }
        }
        const size_t o = ((size_t)bd * TPB + k) * 1024 + ch;
        *(f32x4*)(RGE + o) = (f32x4){h0, h1, h2, h3}; *(f32x4*)(RGP + o) = (f32x4){p0, p1, p2, p3};
    }
}
__device__ __forceinline__ void rg_carry(const float* RGE, const float* RGP, const size_t o, const int nk, float& h0, float& h1) {
    h0 = 0.f; h1 = 0.f;
#pragma unroll 1
    for (int k0 = 0; k0 < nk; k0 += 8) {
        float2 e[8], p[8];
#pragma unroll
        for (int i = 0; i < 8; ++i) { const int kk = k0 + i < nk ? k0 + i : nk - 1; e[i] = *(const float2*)(RGE + o + (size_t)kk * 1024); p[i] = *(const float2*)(RGP + o + (size_t)kk * 1024); }
#pragma unroll
        for (int i = 0; i < 8; ++i) if (k0 + i < nk) { h0 = p[i].x * h0 + e[i].x; h1 = p[i].y * h1 + e[i].y; }
    }
}
__device__ __forceinline__ void ph_rgscan_c(const Ctx& F, const bf16* OM0, const bf16* OM1, bf16* BT0, const bf16* BT1, const float* RGE, const float* RGP, bf16* Y, const bf16* OMC) {
    for (int it = F.wave * F.G + F.bid; it < NB * TPB * 8; it += F.NGW) {
        const int cg = it & 7, ti = (it >> 3) % TPB, b = (it >> 3) / TPB, ch = cg * 128 + 2 * F.lane;
        const size_t rb = (size_t)b * SEQL + 256 * ti;
        float h0, h1;
        {
            const bf16* OM = (ti == 0 ? OMC + (size_t)b * 256 * 1024 : OM0 + rb * 1024) + ch; bf16* BT = BT0 + rb * 1024 + ch;
            unsigned ow[16], bw[16], on[16], bn[16];
#pragma unroll
            for (int e = 0; e < 16; ++e) { ow[e] = *(const unsigned*)(OM + (size_t)e * 1024); bw[e] = *(const unsigned*)(BT + (size_t)e * 1024); }
            rg_carry(RGE, RGP, ((size_t)(b * 2 + 0) * TPB) * 1024 + ch, ti, h0, h1);
#pragma unroll 1
            for (int t = 0; t < 256; t += 16) {
                const int tn = t + 16 < 256 ? t + 16 : t;
#pragma unroll
                for (int e = 0; e < 16; ++e) { on[e] = *(const unsigned*)(OM + (size_t)(tn + e) * 1024); bn[e] = *(const unsigned*)(BT + (size_t)(tn + e) * 1024); }
#pragma unroll
                for (int e = 0; e < 16; ++e) {
                    h0 = (1.f - bf2f(ow[e] & 0xffffu)) * h0 + bf2f(bw[e] & 0xffffu); h1 = (1.f - bf2f(ow[e] >> 16)) * h1 + bf2f(bw[e] >> 16);
                    *(unsigned*)(BT + (size_t)(t + e) * 1024) = pk2(h0, h1); }
#pragma unroll
                for (int e = 0; e < 16; ++e) { ow[e] = on[e]; bw[e] = bn[e]; }
            }
        }
        const int kb = ti == 0 ? 0 : TPB - ti;
        {
            const bf16* OM = OM1 + (rb + 255) * 1024 + ch; const bf16* BT = BT1 + (rb + 255) * 1024 + ch; const bf16* HF = BT0 + (rb + 255) * 1024 + ch; bf16* YR = Y + (rb + 255) * 2048 + 1024 + ch;
            unsigned ow[16], bw[16], hw[16], gw_[16], on[16], bn[16], hn[16], gn[16];
#define RGC_LD(t_, O, B, H, G) _Pragma("unroll") for (int e = 0; e < 16; ++e) { const long ro_ = -(long)((t_) + e); O[e] = *(const unsigned*)(OM + ro_ * 1024); B[e] = *(const unsigned*)(BT + ro_ * 1024); \
                H[e] = __hip_atomic_load((const unsigned*)(HF + ro_ * 1024), __ATOMIC_RELAXED, __HIP_MEMORY_SCOPE_AGENT); G[e] = *(const unsigned*)(YR + ro_ * 2048); }
            RGC_LD(0, ow, bw, hw, gw_)
            rg_carry(RGE, RGP, ((size_t)(b * 2 + 1) * TPB) * 1024 + ch, kb, h0, h1);
#pragma unroll 1
            for (int t = 0; t < 256; t += 16) {
                const int tn = t + 16 < 256 ? t + 16 : t;
                RGC_LD(tn, on, bn, hn, gn)
#pragma unroll
                for (int e = 0; e < 16; ++e) {
                    h0 = (1.f - bf2f(ow[e] & 0xffffu)) * h0 + bf2f(bw[e] & 0xffffu); h1 = (1.f - bf2f(ow[e] >> 16)) * h1 + bf2f(bw[e] >> 16);
                    const float o0 = (bf2f(hw[e] & 0xffffu) + h0) * silu(bf2f(gw_[e] & 0xffffu)), o1 = (bf2f(hw[e] >> 16) + h1) * silu(bf2f(gw_[e] >> 16));
                    *(unsigned*)(YR - (long)(t + e) * 2048) = pk2(o0, o1); }
#pragma unroll
                for (int e = 0; e < 16; ++e) { ow[e] = on[e]; bw[e] = bn[e]; hw[e] = hn[e]; gw_[e] = gn[e]; }
            }
#undef RGC_LD
        }
    }
}

typedef __bf16 v2bf __attribute__((ext_vector_type(2)));
__device__ __forceinline__ float dot2bf(const unsigned a, const unsigned b, const float c) { return __builtin_amdgcn_fdot2_f32_bf16(__builtin_bit_cast(v2bf, a), __builtin_bit_cast(v2bf, b), c, false); }
__device__ __forceinline__ void ph_convq(const Ctx& F, int j, int hb, const bf16* XM, bf16* XCV, bf16* QP) {
    constexpr int NT = MH / 16, NTX = NT / 8;
    const bool xmap = (F.G & 7) == 0;
    const int xq = F.bid & 7, cu = F.bid >> 3, cpx = F.G >> 3;
    int ntile = xmap ? (NTX - cu + cpx - 1) / cpx : (NT - F.bid + F.G - 1) / F.G; ntile = ntile < 0 ? 0 : ntile;
#define CQ_TILE(slot_) (xmap ? 4 * (cu + cpx * (slot_) + NTX * (xq >> 2)) + (xq & 3) : F.bid + F.G * (slot_))
    const float* cw = F.in(I_MLCW) + (size_t)j * 4 * 2048; const float* cb = F.in(I_MLCB) + (size_t)j * 2048;
    const float* mg = (const float*)(F.ws + WS_MG);
    const float* bif = F.in(I_MLBIF) + (size_t)j * 16;
    float* gate = (float*)(F.ws + WS_GATE);
    const int nrows = 2 * ntile;
    {
        LAS f32x4* const WQ = (LAS f32x4*)F.lds;
        for (int i = F.tid; i < 4 * 18 * 64; i += NTHR) { const int ln = i & 63, q = (i >> 6) % 18, k = i / (18 * 64), c = 8 * ln + 512 * k;
            const float* src = q < 8 ? cw + (q >> 1) * 2048 + c + 4 * (q & 1) : (q < 10 ? cb + c + 4 * (q - 8) : mg + (size_t)((c >> 2) + ((q - 10) >> 2)) * 16 + 4 * ((q - 10) & 3));
            WQ[i] = *(const f32x4*)src; }
        __syncthreads();
        u32x4 cur[4][4]; float ma[4], mn[4]; int nrw[4];
#define CQ_NEXT(n_) do { const int nn_ = (n_); const int rl_ = CQ_TILE(nn_ >> 1) * 16 + 2 * F.wave + (nn_ & 1); const int r_ = hb * MH + rl_, b_ = r_ / SEQL, s2_ = r_ - b_ * SEQL; \
            _Pragma("unroll") for (int t = 0; t < 4; ++t) { const int sn = nb_odd(s2_, t - 1); const bool ok = sn >= 0; nrw[t] = ok ? (b_ * SEQL + sn - hb * MH) : rl_; mn[t] = ok ? 1.f : 0.f; } } while (0)
        if (nrows > 0) { CQ_NEXT(0);
#pragma unroll
            for (int k = 0; k < 4; ++k)
#pragma unroll
                for (int t = 0; t < 4; ++t) cur[k][t] = *(const u32x4*)(XM + (size_t)nrw[t] * 2048 + 8 * F.lane + 512 * k); }
#pragma unroll 1
        for (int n = 0; n < nrows; ++n) {
#pragma unroll
            for (int t = 0; t < 4; ++t) ma[t] = mn[t];
            const int rl = CQ_TILE(n >> 1) * 16 + 2 * F.wave + (n & 1);
            CQ_NEXT(n + 1 < nrows ? n + 1 : n);
#pragma unroll
            for (int k = 0; k < 4; ++k) {
                const int c = 8 * F.lane + 512 * k;
                const LAS f32x4* wl = WQ + (k * 18) * 64 + F.lane;
                float a[8];
                { const f32x4 b0 = wl[8 * 64], b1 = wl[9 * 64]; a[0] = b0.x; a[1] = b0.y; a[2] = b0.z; a[3] = b0.w; a[4] = b1.x; a[5] = b1.y; a[6] = b1.z; a[7] = b1.w; }
#pragma unroll
                for (int t = 0; t < 4; ++t) { float x[8]; unpack8(cur[k][t], x); const f32x4 w0 = wl[(2 * t) * 64], w1 = wl[(2 * t + 1) * 64];
                    a[0] += w0.x * (ma[t] * x[0]); a[1] += w0.y * (ma[t] * x[1]); a[2] += w0.z * (ma[t] * x[2]); a[3] += w0.w * (ma[t] * x[3]);
                    a[4] += w1.x * (ma[t] * x[4]); a[5] += w1.y * (ma[t] * x[5]); a[6] += w1.z * (ma[t] * x[6]); a[7] += w1.w * (ma[t] * x[7]); }
#pragma unroll
                for (int e = 0; e < 8; ++e) a[e] = silu(a[e]);
                *(u32x4*)(XCV + (size_t)rl * 2048 + c) = pack8(a);
                float qv[8];
#pragma unroll
                for (int blk = 0; blk < 2; ++blk) { const f32x4 m0 = wl[(10 + blk * 4 + 0) * 64], m1 = wl[(10 + blk * 4 + 1) * 64], m2 = wl[(10 + blk * 4 + 2) * 64], m3 = wl[(10 + blk * 4 + 3) * 64];
#pragma unroll
                    for (int jj = 0; jj < 4; ++jj) qv[blk * 4 + jj] = a[blk * 4 + 0] * m0[jj] + a[blk * 4 + 1] * m1[jj] + a[blk * 4 + 2] * m2[jj] + a[blk * 4 + 3] * m3[jj]; }
                { const int half = (c >> 3) & 1; bf16* qb = QP + (size_t)rl * 2048 + (c & ~15) + 4 * half;
                  u32x2 w0, w1; w0.x = pk2(qv[0], qv[1]); w0.y = pk2(qv[2], qv[3]); w1.x = pk2(qv[4], qv[5]); w1.y = pk2(qv[6], qv[7]);
                  *(u32x2*)qb = w0; *(u32x2*)(qb + 8) = w1; }
#pragma unroll
                for (int t = 0; t < 4; ++t) cur[k][t] = *(const u32x4*)(XM + (size_t)nrw[t] * 2048 + c);
                __builtin_amdgcn_sched_barrier(0);
            }
        }
#undef CQ_NEXT
    }
    __builtin_amdgcn_fence(__ATOMIC_RELEASE, "workgroup");
    asm volatile("s_waitcnt vmcnt(0)" ::: "memory");
    __syncthreads();
    __builtin_amdgcn_fence(__ATOMIC_ACQUIRE, "workgroup");
    {
        const int w = F.wave; const bf16* SRC = (w >> 2) ? XM : XCV;
        const u32x4* tb = (const u32x4*)(F.ws + WS_WGT) + (size_t)(w * 16) * 64 + F.lane;
        bf16x8 bfr[16];
#pragma unroll
        for (int st = 0; st < 16; ++st) bfr[st] = __builtin_bit_cast(bf16x8, tb[st * 64]);
        const bf16* cbase = SRC + (size_t)(F.lane & 15) * 2048 + (w & 3) * 512 + (F.lane >> 4) * 32;
        LAS f32x4* part = (LAS f32x4*)F.lds;
        bf16x8 cur[16], nxt[16];
#define CQ_LOADT(slot_, AV) do { const bf16* rp_ = cbase + (size_t)CQ_TILE(slot_) * 16 * 2048; \
            _Pragma("unroll") for (int st = 0; st < 16; ++st) AV[st] = *(const bf16x8*)(rp_ + (st >> 2) * 128 + (st & 3) * 8); } while (0)
        if (ntile > 0) CQ_LOADT(0, cur);
#pragma unroll 1
        for (int slot = 0; slot < ntile; ++slot) {
            { const int sn = slot + 1 < ntile ? slot + 1 : ntile - 1; CQ_LOADT(sn, nxt); }
            f32x4 acc = (f32x4){0.f, 0.f, 0.f, 0.f};
#pragma unroll
            for (int st = 0; st < 16; ++st) acc = __builtin_amdgcn_mfma_f32_16x16x32_bf16(cur[st], bfr[st], acc, 0, 0, 0);
            part[(slot * 8 + w) * 64 + F.lane] = acc;
#pragma unroll
            for (int st = 0; st < 16; ++st) cur[st] = nxt[st];
        }
#undef CQ_LOADT
        __syncthreads();
        for (int idx = F.tid; idx < ntile * 256; idx += NTHR) { const int slot = idx >> 8, o = idx & 255, ln = o & 63, i = o >> 6;
            float v = 0.f;
#pragma unroll
            for (int ww = 0; ww < 8; ++ww) v += ((const LAS float*)part)[((slot * 8 + ww) * 64 + ln) * 4 + i];
            const int n = ln & 15, m = 4 * (ln >> 4) + i, r = hb * MH + CQ_TILE(slot) * 16 + m, d = n >> 3, n8 = n & 7;
            v += bif[n];
            gate[((size_t)d * M + r) * 8 + n8] = n8 >= 4 ? logsigmoid(v) : v; }
    }
#undef CQ_TILE
    __syncthreads();
}

__device__ __forceinline__ void odd_chunk_rows(const int ck, const int d, int& rb, int& rs) {
    if (ck < LCTX / 64) { rb = d == 0 ? ck * 64 : LCTX - 1 - ck * 64; rs = d == 0 ? 1 : -1; }
    else { const int q0 = ck * 64 - LCTX, lo = q0 & 127, hi = q0 >> 7;
        if (d == 0) { rb = LCTX + lo * 64 + hi; rs = 64; } else { rb = LCTX + (127 - lo) * 64 + 63 - hi; rs = -64; } }
}
__device__ __forceinline__ void ph_mscan(const Ctx& F, int hb) {
    if (F.bid >= 16) return;
    const int sq = F.bid, b = hb * 2 + (sq >> 3), n = (sq >> 1) & 3, d = sq & 1;
    const float* gate = (const float*)(F.ws + WS_GATE) + (size_t)d * M * 8;
    LAS float* be = (LAS float*)F.lds; LAS float* um = be + 192; LAS float* ms = um + 192;
    const int ck = F.tid; const bool act = ck < NCH;
    float li[64], lf[64];
    if (act) {
        int rb, rs; odd_chunk_rows(ck, d, rb, rs);
        const float* gp = gate + ((size_t)b * SEQL + rb) * 8 + n; const long gs = (long)rs * 8;
#pragma unroll
        for (int e = 0; e < 64; ++e) { li[e] = gp[e * gs]; lf[e] = gp[e * gs + 4]; }
        float bs = 0.f, umax = -3.0e38f;
#pragma unroll
        for (int e = 0; e < 64; ++e) { bs += lf[e]; umax = fmaxf(umax, li[e] - bs); }
        be[ck] = bs; um[ck] = umax;
    }
    __syncthreads();
    if (F.tid == 0) { float m = 0.f;
#pragma unroll
        for (int c4 = 0; c4 < NCH; c4 += 4) { const f32x4 b4 = *(const LAS f32x4*)(be + c4), u4 = *(const LAS f32x4*)(um + c4); f32x4 m4;
            m4.x = m; m = b4.x + fmaxf(m, u4.x); m4.y = m; m = b4.y + fmaxf(m, u4.y); m4.z = m; m = b4.z + fmaxf(m, u4.z); m4.w = m; m = b4.w + fmaxf(m, u4.w);
            *(LAS f32x4*)(ms + c4) = m4; } }
    __syncthreads();
    if (act) {
        float* ps = (float*)(F.ws + WS_PS) + (size_t)sq * SEQL * 4; float* pc = (float*)(F.ws + WS_PC) + (size_t)sq * NCH * 4;
        const float m = ms[ck]; float bs = 0.f, cm = m, mt = 0.f;
#pragma unroll
        for (int e = 0; e < 64; ++e) { bs += lf[e]; const float u = li[e] - bs; cm = fmaxf(cm, u); mt = bs + cm;
            *(f32x4*)(ps + (size_t)(ck * 64 + e) * 4) = (f32x4){bs - mt, u, __expf(m - cm), mt}; }
        *(f32x4*)(pc + (size_t)ck * 4) = (f32x4){bs, mt, __expf(bs + m - mt), m};
    }
    __syncthreads();
}

__device__ __forceinline__ void ph_stilde(const Ctx& F, int hb, const bf16* QP, const bf16* XCV) {
    constexpr int LDR = 520;
    LAS bf16* ql = (LAS bf16*)F.lds; LAS bf16* kl = ql + 64 * LDR;
    LAS float* red = (LAS float*)(kl + 64 * LDR);
    LAS float* rsum = red + 4 * 16 * 64;
    LAS float* cwl = rsum + 128;
    bf16* DN = (bf16*)(F.ws + WS_DN);
    const float* PC = (const float*)(F.ws + WS_PC);
    bf16* ST = (bf16*)(F.ws + WS_ST); float* DS = (float*)(F.ws + WS_DS); const float* PS = (const float*)(F.ws + WS_PS);
    const int lane = F.lane, w = F.wave, r = lane & 31, h = lane >> 5;
    const int tile = w & 3, st = tile & 1, tt = tile >> 1, kh = w >> 2;
    u32x4 qg[8], kg[8]; float pc0n = 0.f, pc1n = 0.f, psn = 0.f;
#define ST_SQ(it_) ((((it_) >> 2) & 1) * 8 + ((it_) & 3) * 2 + (((it_) >> 3) & 1))
#define ST_CK(it_) (((((it_) >> 3) & 1) == 0) ? ((it_) >> 4) : (((it_) >> 4) < LCTX / 64 ? LCTX / 64 - 1 - ((it_) >> 4) : NCH + LCTX / 64 - 1 - ((it_) >> 4)))
#define ST_LOAD(it_) do { const int sq_ = ST_SQ(it_), ck_ = ST_CK(it_); int rb_, rs_; odd_chunk_rows(ck_, sq_ & 1, rb_, rs_); \
        const size_t o_ = (size_t)((sq_ >> 3) * SEQL + rb_ + w * rs_) * 2048 + ((sq_ >> 1) & 3) * 512 + 8 * lane; const long st_ = (long)rs_ * (8 * 2048); \
        _Pragma("unroll") for (int k_ = 0; k_ < 8; ++k_) { qg[k_] = *(const u32x4*)(QP + o_ + k_ * st_); kg[k_] = *(const u32x4*)(XCV + o_ + k_ * st_); } \
        if (w == 0) { const float* pcq_ = PC + ((size_t)sq_ * NCH + ck_) * 4; pc0n = pcq_[0]; pc1n = pcq_[1]; psn = PS[((size_t)sq_ * SEQL + ck_ * 64 + lane) * 4 + 1]; } } while (0)
    if (F.bid < 16 * NCH) ST_LOAD(F.bid);
    __syncthreads();
    for (int it = F.bid; it < 16 * NCH; it += F.G) {
        const int sq = ST_SQ(it), ck = ST_CK(it);
        { const int c8 = 8 * lane, hq = (c8 >> 3) & 1, g16 = c8 & ~15;
#pragma unroll
          for (int k_ = 0; k_ < 8; ++k_) { const int t = w + 8 * k_; u32x2 lo, hi; lo.x = qg[k_].x; lo.y = qg[k_].y; hi.x = qg[k_].z; hi.y = qg[k_].w;
              *(LAS u32x2*)(ql + t * LDR + g16 + 4 * hq) = lo; *(LAS u32x2*)(ql + t * LDR + g16 + 8 + 4 * hq) = hi;
              *(LAS u32x4*)(kl + t * LDR + c8) = kg[k_]; } }
        if (w == 0) cwl[lane] = __expf(pc0n + psn - pc1n);
        __syncthreads();
        const float* psq = PS + ((size_t)sq * SEQL + ck * 64) * 4;
        const int t = 32 * tt + r; const float am = psq[t * 4 + 0];
        float us[16];
#pragma unroll
        for (int j = 0; j < 16; ++j) us[j] = psq[(32 * st + 8 * (j >> 2) + 4 * h + (j & 3)) * 4 + 1];
        if (it + F.G < 16 * NCH) ST_LOAD(it + F.G);
        f32x16s acc;
#pragma unroll
        for (int j = 0; j < 16; ++j) acc[j] = 0.f;
        { const LAS bf16* ka = kl + (32 * st + r) * LDR + 256 * kh + 8 * h; const LAS bf16* qb = ql + (32 * tt + r) * LDR + 256 * kh + 8 * h;
#pragma unroll
          for (int ks = 0; ks < 16; ++ks) acc = __builtin_amdgcn_mfma_f32_32x32x16_bf16(*(const LAS bf16x8*)(ka + 16 * ks), *(const LAS bf16x8*)(qb + 16 * ks), acc, 0, 0, 0); }
        if (kh == 1) {
#pragma unroll
            for (int j = 0; j < 16; ++j) red[(tile * 16 + j) * 64 + lane] = acc[j]; }
        __syncthreads();
        if (kh == 0) {
            float rs = 0.f;
#pragma unroll
            for (int q4 = 0; q4 < 4; ++q4) { float o[4];
#pragma unroll
                for (int i = 0; i < 4; ++i) { const int j = 4 * q4 + i, s_ = 32 * st + 8 * q4 + 4 * h + i; const float v = acc[j] + red[(tile * 16 + j) * 64 + lane];
                    o[i] = s_ <= t ? v * __expf(am + us[j]) : 0.f; rs += o[i]; }
                u32x2 ow; ow.x = pk2(o[0], o[1]); ow.y = pk2(o[2], o[3]);
                *(u32x2*)(ST + ((size_t)(sq * NCH + ck) * 64 + t) * 64 + 32 * st + 8 * q4 + 4 * h) = ow; }
            rs += xhalf(rs, h);
            if (h == 0) rsum[st * 64 + t] = rs;
        } else {
            const int d2 = 2 * (F.tid - 256); float dn0 = 0.f, dn1 = 0.f;
#pragma unroll 4
            for (int s4 = 0; s4 < 64; s4 += 4) { const f32x4 c4 = *(const LAS f32x4*)(cwl + s4);
#pragma unroll
                for (int i = 0; i < 4; ++i) { const unsigned kk = *(const LAS unsigned*)(kl + (s4 + i) * LDR + d2); dn0 += c4[i] * bf2f(kk & 0xffffu); dn1 += c4[i] * bf2f(kk >> 16); } }
            *(unsigned*)(DN + ((size_t)sq * NCH + ck) * 512 + d2) = pk2(dn0, dn1); }
        __syncthreads();
        if (F.tid < 64) DS[(size_t)sq * SEQL + ck * 64 + F.tid] = rsum[F.tid] + rsum[64 + F.tid];
    }
#undef ST_LOAD
#undef ST_SQ
#undef ST_CK
    __syncthreads();
}

typedef float f32x16 __attribute__((ext_vector_type(16)));
__device__ __forceinline__ bf16x8 pack_bf16x8(const f32x16& c, const int o) {
    u32x4 w; w.x = pg8::cvt_pk_bf16(c[o], c[o + 1]); w.y = pg8::cvt_pk_bf16(c[o + 2], c[o + 3]); w.z = pg8::cvt_pk_bf16(c[o + 4], c[o + 5]); w.w = pg8::cvt_pk_bf16(c[o + 6], c[o + 7]);
    return __builtin_bit_cast(bf16x8, w);
}
__device__ __forceinline__ void ph_mlstm_r(const Ctx& F, int hb, const bf16* QP, const bf16* XCV, const bf16* XM, bf16* HM0, int ld0, bf16* HM1, int ld1) {
    constexpr int RV = 128, RS = 144;
    LAS unsigned char* const VT = F.lds;
    LAS unsigned char* const VW = VT + 32 * RV;
    LAS unsigned char* const SB = VW + 32 * RV;
    LAS float* const QNP = (LAS float*)(SB + 64 * RS);
    LAS float* const SCL = QNP + 64 * 16;
    LAS unsigned* const NSB = (LAS unsigned*)(SCL + 384);
    LAS unsigned char* const KR = (LAS unsigned char*)(NSB + 256);
    LAS float* const PART = (LAS float*)(KR + 8 * 8192);
    const bf16* ST = (const bf16*)(F.ws + WS_ST); const float* DS = (const float*)(F.ws + WS_DS); const float* PS = (const float*)(F.ws + WS_PS); const float* PC = (const float*)(F.ws + WS_PC);
    const bf16* DN = (const bf16*)(F.ws + WS_DN);
    const int tid = F.tid, lane = F.lane, w = F.wave, r = lane & 31, h = lane >> 5;
#define R_BAR() do { asm volatile("s_waitcnt lgkmcnt(0)" ::: "memory"); __builtin_amdgcn_s_barrier(); asm volatile("" ::: "memory"); } while (0)
    for (int it0 = F.bid; it0 < 256; it0 += F.G) {
        const int it = (F.G == 256) ? (((it0 & 7) * 2 + ((it0 >> 3) >> 4)) * 16 + ((it0 >> 3) & 15)) : it0;
        const int sq = it >> 4, eb = it & 15, bh = sq >> 3, n = (sq >> 1) & 3, d = sq & 1;
        bf16* HM = d ? HM1 : HM0; const int ldh = d ? ld1 : ld0;
        const int colv = n * 512 + eb * 32;
        f32x16 C0, C1;
#pragma unroll
        for (int j = 0; j < 16; ++j) { C0[j] = 0.f; C1[j] = 0.f; }
        float nreg = 0.f, dec_cur = 0.f;
        u32x4 kreg[8]; u32x2 vreg; u32x4 sreg; bf16x8 Qf[8]; f32x4 pvn, pcn; float dsn, dnv;
        int rbn, rsn, rowtn, rbk, rsk;
#define R_PREFETCH_K(ck_) do { const bf16* kb_ = XCV + (size_t)(bh * SEQL + rbk + (lane >> 3) * rsk) * 2048 + n * 512 + 64 * w + 8 * (lane & 7); const long ks_ = (long)rsk * (8 * 2048); \
            _Pragma("unroll") for (int k_ = 0; k_ < 8; ++k_) kreg[k_] = *(const u32x4*)(kb_ + k_ * ks_); } while (0)
#define R_KWRITE() do { LAS unsigned char* kp0_ = KR + w * 8192 + (lane >> 3) * 128 + (((lane & 7) ^ (((lane >> 4) & 1) << 2)) * 16); asm volatile("" : "+v"(kp0_)); \
            _Pragma("unroll") for (int k_ = 0; k_ < 8; ++k_) *(LAS u32x4*)(kp0_ + k_ * 1024) = kreg[k_]; } while (0)
#define R_PREFETCH_VS(ck_) do { const int p0_ = (ck_) * 64; rowtn = bh * SEQL + rbn + (tid >> 3) * rsn; \
            const size_t rv_ = (size_t)rowtn * 2048; vreg = *(const u32x2*)(XM + rv_ + colv + (tid & 7) * 4); \
            sreg = *(const u32x4*)(ST + ((size_t)(sq * NCH + (ck_))) * 4096 + (size_t)tid * 8); \
            pvn = *(const f32x4*)(PS + ((size_t)sq * SEQL + p0_ + (tid >> 3)) * 4); dsn = DS[(size_t)sq * SEQL + p0_ + (tid >> 3)]; dnv = bf2f(DN[((size_t)sq * NCH + (ck_)) * 512 + tid]); pcn = *(const f32x4*)(PC + ((size_t)sq * NCH + (ck_)) * 4); } while (0)
#define R_PREFETCH_Q(ck_) do { \
            _Pragma("unroll") for (int tt_ = 0; tt_ < 2; ++tt_) { const bf16* qr_ = QP + (size_t)(bh * SEQL + rbn + (32 * tt_ + r) * rsn) * 2048 + n * 512 + 64 * w + 8 * h; \
                _Pragma("unroll") for (int i_ = 0; i_ < 2; ++i_) _Pragma("unroll") for (int s_ = 0; s_ < 2; ++s_) Qf[(tt_ * 2 + i_) * 2 + s_] = *(const bf16x8*)(qr_ + 32 * i_ + 16 * s_); } } while (0)
#define R_STAGE(ck_) do { const f32x4 pc_ = pcn; asm volatile("" :: "v"(pc_.w), "v"(pvn.x));     \
            ((LAS bf16*)NSB)[tid] = (bf16)f2bf(nreg); nreg = pc_.z * nreg + dnv; dec_cur = pc_.z; \
            const int s_ = tid >> 3, e4_ = (tid & 7) * 4; const float cw_ = __expf(pc_.x + pvn.y - pc_.y); \
            if ((tid & 7) == 0) { LAS float* sc_ = SCL + ((ck_) & 1) * 192; sc_[s_] = pvn.z; sc_[64 + s_] = __expf(-pvn.w); sc_[128 + s_] = dsn; } \
            *(LAS u32x4*)(SB + s_ * RS + (tid & 7) * 16) = sreg; \
            const float v0_ = bf2f(vreg.x & 0xffffu), v1_ = bf2f(vreg.x >> 16), v2_ = bf2f(vreg.y & 0xffffu), v3_ = bf2f(vreg.y >> 16); (void)e4_; \
            *(LAS u32x2*)(VT + s_ * 64 + (tid & 7) * 8) = vreg; \
            { u32x2 wv_; wv_.x = pk2(cw_ * v0_, cw_ * v1_); wv_.y = pk2(cw_ * v2_, cw_ * v3_); *(LAS u32x2*)(VW + s_ * 64 + (tid & 7) * 8) = wv_; } } while (0)
        odd_chunk_rows(0, d, rbn, rsn); rbk = rbn; rsk = rsn;
        R_PREFETCH_K(0); R_PREFETCH_VS(0); R_PREFETCH_Q(0);
        __syncthreads();
        R_KWRITE(); odd_chunk_rows(1, d, rbk, rsk); R_PREFETCH_K(1);
        R_STAGE(0);
        for (int ck = 0; ck < NCH; ++ck) {
            const float decay = dec_cur;
            int vlo = (8 * h + ((lane & 15) >> 2)) * 64 + (16 * ((lane >> 4) & 1) + 4 * (lane & 3)) * 2; asm volatile("" : "+v"(vlo));
            const int rowt = rowtn;
            const LAS float* const scl = SCL + (ck & 1) * 192;
            if (ck + 1 < NCH) odd_chunk_rows(ck + 1, d, rbn, rsn);
            if (ck + 2 < NCH) odd_chunk_rows(ck + 2, d, rbk, rsk);
            R_BAR();
            s16x4 kf[16];
            {
                const int swz = (lane >> 3) & 1;
                const LAS unsigned char* krb = KR + w * 8192 + (8 * h + ((lane & 15) >> 2)) * 128 + (8 * swz + 4 * ((lane >> 4) & 1) + (lane & 3)) * 8;
                const LAS unsigned char* krc = krb + 64 - 128 * swz; asm volatile("" : "+v"(krb), "+v"(krc));
#pragma unroll
                for (int ks = 0; ks < 4; ++ks) {
                    kf[4 * ks + 0] = __builtin_amdgcn_ds_read_tr16_b64_v4i16((LAS s16x4*)(krb + (16 * ks) * 128)); kf[4 * ks + 1] = __builtin_amdgcn_ds_read_tr16_b64_v4i16((LAS s16x4*)(krb + (16 * ks + 4) * 128));
                    kf[4 * ks + 2] = __builtin_amdgcn_ds_read_tr16_b64_v4i16((LAS s16x4*)(krc + (16 * ks) * 128)); kf[4 * ks + 3] = __builtin_amdgcn_ds_read_tr16_b64_v4i16((LAS s16x4*)(krc + (16 * ks + 4) * 128)); }
            }
            __builtin_amdgcn_sched_barrier(0);
            if (ck + 1 < NCH) R_KWRITE();
            __builtin_amdgcn_sched_barrier(0);
            f32x16 P0, P1;
#pragma unroll
            for (int j = 0; j < 16; ++j) { P0[j] = 0.f; P1[j] = 0.f; }
            { const bf16x8 c00 = pack_bf16x8(C0, 0), c01 = pack_bf16x8(C0, 8), c10 = pack_bf16x8(C1, 0), c11 = pack_bf16x8(C1, 8);
              P0 = __builtin_amdgcn_mfma_f32_32x32x16_bf16(Qf[0], c00, P0, 0, 0, 0); P1 = __builtin_amdgcn_mfma_f32_32x32x16_bf16(Qf[4], c00, P1, 0, 0, 0);
              P0 = __builtin_amdgcn_mfma_f32_32x32x16_bf16(Qf[1], c01, P0, 0, 0, 0); P1 = __builtin_amdgcn_mfma_f32_32x32x16_bf16(Qf[5], c01, P1, 0, 0, 0);
              P0 = __builtin_amdgcn_mfma_f32_32x32x16_bf16(Qf[2], c10, P0, 0, 0, 0); P1 = __builtin_amdgcn_mfma_f32_32x32x16_bf16(Qf[6], c10, P1, 0, 0, 0);
              P0 = __builtin_amdgcn_mfma_f32_32x32x16_bf16(Qf[3], c11, P0, 0, 0, 0); P1 = __builtin_amdgcn_mfma_f32_32x32x16_bf16(Qf[7], c11, P1, 0, 0, 0); }
            __builtin_amdgcn_sched_barrier(0);
            {
                const LAS unsigned char* vwb = VT + vlo + 32 * RV;
#pragma unroll
                for (int j = 0; j < 16; ++j) { C0[j] *= decay; C1[j] *= decay; }
#pragma unroll
                for (int kh = 0; kh < 2; ++kh) {
                    bf16x8 vw2[2];
#pragma unroll
                    for (int k2 = 0; k2 < 2; ++k2) { const int ks = 2 * kh + k2;
                        const s16x4 f0 = __builtin_amdgcn_ds_read_tr16_b64_v4i16((LAS s16x4*)(vwb + (16 * ks) * 64)), f1 = __builtin_amdgcn_ds_read_tr16_b64_v4i16((LAS s16x4*)(vwb + (16 * ks + 4) * 64));
                        vw2[k2] = (bf16x8){f0.x, f0.y, f0.z, f0.w, f1.x, f1.y, f1.z, f1.w}; }
#pragma unroll
                    for (int k2 = 0; k2 < 2; ++k2) { const int ks = 2 * kh + k2;
                        const bf16x8 ka0 = (bf16x8){kf[4 * ks].x, kf[4 * ks].y, kf[4 * ks].z, kf[4 * ks].w, kf[4 * ks + 1].x, kf[4 * ks + 1].y, kf[4 * ks + 1].z, kf[4 * ks + 1].w};
                        const bf16x8 ka1 = (bf16x8){kf[4 * ks + 2].x, kf[4 * ks + 2].y, kf[4 * ks + 2].z, kf[4 * ks + 2].w, kf[4 * ks + 3].x, kf[4 * ks + 3].y, kf[4 * ks + 3].z, kf[4 * ks + 3].w};
                        C0 = __builtin_amdgcn_mfma_f32_32x32x16_bf16(ka0, vw2[k2], C0, 0, 0, 0); C1 = __builtin_amdgcn_mfma_f32_32x32x16_bf16(ka1, vw2[k2], C1, 0, 0, 0); }
                    __builtin_amdgcn_sched_barrier(0);
                }
            }
            __builtin_amdgcn_sched_barrier(0);
            u32x2 nsa[4], nsb[4];
#pragma unroll
            for (int i = 0; i < 2; ++i)
#pragma unroll
                for (int sx = 0; sx < 2; ++sx) { const int db = 64 * w + 32 * i + 16 * sx + 4 * h; nsa[i * 2 + sx] = *(const LAS u32x2*)(NSB + (db >> 1)); nsb[i * 2 + sx] = *(const LAS u32x2*)(NSB + ((db + 8) >> 1)); }
            if (ck + 2 < NCH) R_PREFETCH_K(ck + 2);
            if (ck + 1 < NCH) R_PREFETCH_VS(ck + 1);
            __builtin_amdgcn_sched_barrier(0);
            {
                float qn0 = 0.f, qn1 = 0.f;
#pragma unroll
                for (int i = 0; i < 2; ++i)
#pragma unroll
                    for (int sx = 0; sx < 2; ++sx) { const u32x2 na = nsa[i * 2 + sx], nb = nsb[i * 2 + sx];
                        const u32x4 qa = __builtin_bit_cast(u32x4, Qf[i * 2 + sx]), qb = __builtin_bit_cast(u32x4, Qf[4 + i * 2 + sx]);
                        qn0 = dot2bf(qa.x, na.x, qn0); qn0 = dot2bf(qa.y, na.y, qn0); qn0 = dot2bf(qa.z, nb.x, qn0); qn0 = dot2bf(qa.w, nb.y, qn0);
                        qn1 = dot2bf(qb.x, na.x, qn1); qn1 = dot2bf(qb.y, na.y, qn1); qn1 = dot2bf(qb.z, nb.x, qn1); qn1 = dot2bf(qb.w, nb.y, qn1); }
                qn0 += xhalf(qn0, h); qn1 += xhalf(qn1, h);
                if (h == 0) { QNP[w * 64 + r] = qn0; QNP[w * 64 + 32 + r] = qn1; }
                __builtin_amdgcn_sched_barrier(0);
                if (ck + 1 < NCH) R_PREFETCH_Q(ck + 1);
#pragma unroll
                for (int q4 = 0; q4 < 4; ++q4) { const f32x4 s0 = *(const LAS f32x4*)(scl + 8 * q4 + 4 * h), s1 = *(const LAS f32x4*)(scl + 32 + 8 * q4 + 4 * h);
                    P0[4 * q4] *= s0.x; P0[4 * q4 + 1] *= s0.y; P0[4 * q4 + 2] *= s0.z; P0[4 * q4 + 3] *= s0.w;
                    P1[4 * q4] *= s1.x; P1[4 * q4 + 1] *= s1.y; P1[4 * q4 + 2] *= s1.z; P1[4 * q4 + 3] *= s1.w; }
                if (w < 4) { const LAS unsigned char* vtb = VT + vlo + 16 * 64 * w;
                    const s16x4 f0 = __builtin_amdgcn_ds_read_tr16_b64_v4i16((LAS s16x4*)vtb), f1 = __builtin_amdgcn_ds_read_tr16_b64_v4i16((LAS s16x4*)(vtb + 4 * 64));
                    const bf16x8 vb = (bf16x8){f0.x, f0.y, f0.z, f0.w, f1.x, f1.y, f1.z, f1.w};
                    const bf16x8 sa0 = *(const LAS bf16x8*)(SB + r * RS + 32 * w + 16 * h), sa1 = *(const LAS bf16x8*)(SB + (32 + r) * RS + 32 * w + 16 * h);
                    P0 = __builtin_amdgcn_mfma_f32_32x32x16_bf16(sa0, vb, P0, 0, 0, 0); P1 = __builtin_amdgcn_mfma_f32_32x32x16_bf16(sa1, vb, P1, 0, 0, 0); }
                { LAS float* pb = PART + (w * 64 + 4 * h) * 32 + r; asm volatile("" : "+v"(pb));
#pragma unroll
                  for (int j = 0; j < 16; ++j) { pb[((j & 3) + 8 * (j >> 2)) * 32] = P0[j]; pb[(32 + (j & 3) + 8 * (j >> 2)) * 32] = P1[j]; } }
            }
            __builtin_amdgcn_sched_barrier(0);
            R_BAR();
            {
                const int t = tid >> 3, eg = tid & 7;
                const LAS float* pr = PART + t * 32 + eg * 4; asm volatile("" : "+v"(pr));
                f32x4 num = *(const LAS f32x4*)pr;
#pragma unroll
                for (int ww = 1; ww < 8; ++ww) num += *(const LAS f32x4*)(pr + ww * 64 * 32);
                const float qn = ((QNP[t] + QNP[64 + t]) + (QNP[128 + t] + QNP[192 + t])) + ((QNP[256 + t] + QNP[320 + t]) + (QNP[384 + t] + QNP[448 + t]));
                const float den = scl[128 + t] + scl[t] * qn, dn = fmaxf(fabsf(den), scl[64 + t]);
                const f32x4 hv = num * __builtin_amdgcn_rcpf(dn);
                u32x2 ow; ow.x = pk2(hv.x, hv.y); ow.y = pk2(hv.z, hv.w);
                *(u32x2*)(HM + (size_t)rowt * ldh + colv + eg * 4) = ow;
            }
            __builtin_amdgcn_sched_barrier(0);
            if (ck + 1 < NCH) R_STAGE(ck + 1);
        }
#undef R_PREFETCH_K
#undef R_KWRITE
#undef R_PREFETCH_VS
#undef R_PREFETCH_Q
#undef R_STAGE
    }
#undef R_BAR
    __syncthreads();
}

__device__ __forceinline__ void ph_mlpost(const Ctx& F, int j, int hb, bf16* PA, const bf16* HMB, const bf16* XCV, const bf16* ZG) {
    const float* wv = F.in(I_MLWV) + (size_t)j * 512 * 16; const float* ng = F.in(I_MLNG) + (size_t)j * 2048; const float* sk = F.in(I_MLSKIP) + (size_t)j * 2048;
    bf16* PH = PA + (size_t)hb * MH * 2048;
    LAS f32x4* const WL = (LAS f32x4*)F.lds;
    for (int i = F.tid; i < 4 * 12 * 64; i += NTHR) { const int ln = i & 63, q = (i >> 6) % 12, k = i / 768, c = 8 * ln + 512 * k;
        const float* src = q < 8 ? wv + (size_t)((c >> 2) + (q >> 2)) * 16 + 4 * (q & 3) : (q < 10 ? ng + c + 4 * (q - 8) : sk + c + 4 * (q - 10));
        WL[i] = *(const f32x4*)src; }
    __syncthreads();
    const int nrows = (MH - F.gw + F.NGW - 1) / F.NGW;
    u32x4 cur[4][4];
#define MP_ISSUE(n_, L) do { const size_t o_ = (size_t)(F.gw + (n_) * F.NGW) * 2048 + 8 * F.lane; \
        _Pragma("unroll") for (int k = 0; k < 4; ++k) { L[k][0] = *(const u32x4*)(PH + o_ + 512 * k); L[k][1] = *(const u32x4*)(HMB + o_ + 512 * k); L[k][2] = *(const u32x4*)(XCV + o_ + 512 * k); L[k][3] = *(const u32x4*)(ZG + o_ + 512 * k); } } while (0)
    if (nrows > 0) MP_ISSUE(0, cur);
#pragma unroll 1
    for (int n = 0; n < nrows; ++n) {
        const size_t on_ = (size_t)(F.gw + (n + 1 < nrows ? n + 1 : n) * F.NGW) * 2048 + 8 * F.lane;
        bf16* const prow = PH + (size_t)(F.gw + n * F.NGW) * 2048 + 8 * F.lane;
#pragma unroll
        for (int k = 0; k < 4; ++k) {
            const LAS f32x4* wl = WL + (k * 12) * 64 + F.lane;
            float a[8], b[8], h[8]; unpack8(cur[k][0], a); unpack8(cur[k][1], b);
#pragma unroll
            for (int e = 0; e < 8; ++e) a[e] += b[e];
#pragma unroll
            for (int blk = 0; blk < 2; ++blk) { const f32x4 w0 = wl[(blk * 4 + 0) * 64], w1 = wl[(blk * 4 + 1) * 64], w2 = wl[(blk * 4 + 2) * 64], w3 = wl[(blk * 4 + 3) * 64];
#pragma unroll
                for (int o = 0; o < 4; ++o) h[blk * 4 + o] = a[blk * 4 + 0] * w0[o] + a[blk * 4 + 1] * w1[o] + a[blk * 4 + 2] * w2[o] + a[blk * 4 + 3] * w3[o]; }
            float s1 = 0.f;
#pragma unroll
            for (int e = 0; e < 8; ++e) s1 += h[e];
            const float mu = wave_sum(s1) * (1.f / 512.f); float s2 = 0.f;
#pragma unroll
            for (int e = 0; e < 8; ++e) { h[e] -= mu; s2 += h[e] * h[e]; }
            const float rstd = rsqrtf(wave_sum(s2) * (1.f / 512.f) + EPS);
            const f32x4 g0 = wl[8 * 64], g1 = wl[9 * 64], k0 = wl[10 * 64], k1 = wl[11 * 64];
            const float ngv[8] = {g0.x, g0.y, g0.z, g0.w, g1.x, g1.y, g1.z, g1.w}, skv[8] = {k0.x, k0.y, k0.z, k0.w, k1.x, k1.y, k1.z, k1.w};
            float x[8], z[8], o[8]; unpack8(cur[k][2], x); unpack8(cur[k][3], z);
#pragma unroll
            for (int e = 0; e < 8; ++e) o[e] = (h[e] * rstd * ngv[e] + skv[e] * x[e]) * silu(z[e]);
            *(u32x4*)(prow + 512 * k) = pack8(o);
            cur[k][0] = *(const u32x4*)(PH + on_ + 512 * k); cur[k][1] = *(const u32x4*)(HMB + on_ + 512 * k); cur[k][2] = *(const u32x4*)(XCV + on_ + 512 * k); cur[k][3] = *(const u32x4*)(ZG + on_ + 512 * k);
            __builtin_amdgcn_sched_barrier(0);
        }
    }
#undef MP_ISSUE
    __syncthreads();
}

__device__ __forceinline__ void ph_ctx_reduce(const Ctx& F, const float* P, const float* src, float* dst, const float* gtc, int i0, int i1) {
    for (int i = i0 + F.bid * NTHR + F.tid; i < i1; i += F.G * NTHR) {
        const int c4 = (i & 255) * 4, row = i >> 8;
        f32x4 a = *(const f32x4*)(P + (size_t)row * 1024 + c4);
#pragma unroll
        for (int ks = 1; ks < 8; ++ks) a += *(const f32x4*)(P + ((size_t)ks * 1024 + row) * 1024 + c4);
        const f32x4 x = *(const f32x4*)(src + (size_t)row * 1024 + c4), g = *(const f32x4*)(gtc + c4);
        *(f32x4*)(dst + (size_t)row * 1024 + c4) = x + g * a;
    }
}
__device__ __forceinline__ void ph_final(const Ctx& F) {
    const float* fg = F.in(I_FINALG);
    for (int r = F.gw; r < NB * LLAT; r += F.NGW) {
        f32x4* xr = (f32x4*)(F.out + (size_t)r * D) + F.lane;
        f32x4 v[4]; float ss = 0.f;
#pragma unroll
        for (int jj = 0; jj < 4; ++jj) { v[jj] = xr[64 * jj]; ss += (v[jj].x * v[jj].x + v[jj].y * v[jj].y) + (v[jj].z * v[jj].z + v[jj].w * v[jj].w); }
        const float rstd = rsqrtf(wave_sum(ss) * (1.f / D) + EPS);
#pragma unroll
        for (int jj = 0; jj < 4; ++jj) { const f32x4 g = *(const f32x4*)(fg + 4 * F.lane + 256 * jj); xr[64 * jj] = v[jj] * rstd * g; }
    }
}

constexpr int NPH = 1 + 2 * 8 + 14 + 14 + 1;

__global__ void __launch_bounds__(NTHR, 2) fwd_kernel(Args args) {
    extern __shared__ __attribute__((aligned(16))) unsigned char lds_raw[];
    volatile LAS unsigned* MISC = (volatile LAS unsigned*)((LAS unsigned char*)lds_raw + MISC_OFF);
    if (threadIdx.x < 64) MISC[threadIdx.x] = 0u;
    __syncthreads();
    const int lo = args.ph_lo, hi = args.ph_hi;
    const int wv0 = __builtin_amdgcn_readfirstlane((int)threadIdx.x >> 6);
    XcdBarrier bar; bar.bar = (unsigned*)(args.ws + WS_CTL); bar.x = 0; bar.st = MISC;
    if (hi - lo > 1) bar = xcd_barrier_post((unsigned*)(args.ws + WS_CTL), MISC);
    int ph = 0;
#define PH_BEGIN if (ph >= lo && ph < hi) { Ctx F; { const CAS char* kp_ = (const CAS char*)__builtin_amdgcn_kernarg_segment_ptr(); asm volatile("" : "+s"(kp_)); F.kp = kp_; \
        F.lds = (LAS unsigned char*)lds_raw; { int w_ = wv0, b_ = blockIdx.x, g_ = gridDim.x, ln_; asm volatile("v_mbcnt_lo_u32_b32 %0, -1, 0\n\tv_mbcnt_hi_u32_b32 %0, -1, %0" : "=v"(ln_)); asm volatile("" : "+s"(w_), "+s"(b_), "+s"(g_)); F.tid = (w_ << 6) | ln_; F.wave = w_; F.bid = b_; F.G = g_; } \
        F.lane = F.tid & 63; \
        F.gw = F.bid * NWAVES + F.wave; F.NGW = F.G * NWAVES; F.out = *(float* const CAS*)(kp_ + 304); F.ws = *(unsigned char* const CAS*)(kp_ + 312); } \
        unsigned char* const ws = F.ws; bf16* const SL0 = (bf16*)(ws + WS_SLAB); bf16* const SL1 = (bf16*)(ws + WS_SLAB + SLAB); bf16* const SL2 = (bf16*)(ws + WS_SLAB + 2 * SLAB); bf16* const SL3 = (bf16*)(ws + WS_SLAB + 3 * SLAB); \
        bf16* const SL4 = (bf16*)(ws + WS_SLAB + 4 * SLAB); bf16* const SL5 = (bf16*)(ws + WS_SLAB + 5 * SLAB); bf16* const SL6 = (bf16*)(ws + WS_SLAB + 6 * SLAB); \
        bf16* const WIN = (bf16*)(ws + WS_W + W_IN); bf16* const WOUT = (bf16*)(ws + WS_W + W_OUT); bf16* const WGLU = (bf16*)(ws + WS_W + W_GLU); bf16* const WGATE = (bf16*)(ws + WS_W + W_GATE); \
        const float* const modv = (const float*)(ws + WS_MODV); float* const xctx = (float*)(ws + WS_XCTX); (void)SL0; (void)SL1; (void)SL2; (void)SL3; (void)SL4; (void)SL5; (void)SL6; (void)WIN; (void)WOUT; (void)WGLU; (void)WGATE; (void)modv; (void)xctx;
#define PH_END if (ph + 1 < hi) { int ln2_; asm volatile("v_mbcnt_lo_u32_b32 %0, -1, 0\n\tv_mbcnt_hi_u32_b32 %0, -1, %0" : "=v"(ln2_)); xcd_barrier(bar, (ln2_ == 0) & (wv0 == 0)); } } ++ph;

    PH_BEGIN ph_mod(F); PH_END

#pragma unroll 1
    for (int l = 0; l < DEPTH; ++l) {
        const int j = l >> 1;
        if ((l & 1) == 0) {
#define Y SL0
#define U SL2
#define XR SL3
#define HB SL4
#define XC SL4
#define YS0 SL5
#define YS1 SL6
            PH_BEGIN { int l_ = l; asm volatile("" : "+s"(l_)); ph_norm(F, l_, 0, M, HB, l_ > 0 ? (const float*)SL2 : (const float*)nullptr); } ph_wconv_even(F, j); PH_END
            PH_BEGIN { pg8::TileOrder S; S.init(NTILE, 16, F.G, F.bid, HB, (size_t)256 * 1024 * 2, WIN, (size_t)256 * 1024 * 2);
                       pg8::EpiSplit E{U, Y, (long)(XR - U), 1024, 1024, 2048, 10};
                       GEMM_CALL(1024, 1024, 1024, S, E); } PH_END
            PH_BEGIN ph_rgconv(F, j, XR, XC); __syncthreads(); ph_s5_mfma(F, j, U, YS0); PH_END
            PH_BEGIN { pg8::TileOrder S; S.init(NTILE - NB, 4, F.G, F.bid, U, (size_t)256 * 1024 * 2, WGLU, (size_t)256 * 1024 * 2); S.skipctx = 1;
                       pg8::EpiGlu E{U, Y, F.in(I_GLUB) + (size_t)j * 1024};
                       GEMM_CALL(1024, 1024, 1024, S, E); } PH_END
            PH_BEGIN {
                       { pg8::CtxOrder S3{F.G, F.bid, 64, 4, (const char*)U, (size_t)256 * 1024 * 2, (const char*)WGLU, (size_t)256 * 1024 * 2}; pg8::EpiGlu E3{U, Y, F.in(I_GLUB) + (size_t)j * 1024};
                         int tid3 = F.tid; asm volatile("" : "+v"(tid3)); pg8::gemm_phase(F.lds, tid3, 1024, 1024, 1024, S3, E3); }
                       __syncthreads();
                       pg8::TileOrder S; S.init(NTILE, 16, F.G, F.bid, XC, (size_t)256 * 1024 * 2, WGATE, (size_t)256 * 256 * 2, 2, (size_t)256 * 2);
                       pg8::EpiGate E{XC, SL2, F.in(I_RGBA) + (size_t)j * 2048, F.in(I_RGBX) + (size_t)j * 2048, (const float*)(ws + WS_SPT)};
                       GEMM_CALL(256, 1024, 256, S, E); } PH_END
            PH_BEGIN ph_rgscan_a(F, SL2, SL3, SL5, SL6, (float*)(ws + WS_PS), (float*)(ws + WS_GATE), (const bf16*)(ws + WS_ST)); PH_END
            PH_BEGIN ph_rgscan_c(F, SL2, SL3, SL5, SL6, (const float*)(ws + WS_PS), (const float*)(ws + WS_GATE), Y, (const bf16*)(ws + WS_ST)); PH_END
            PH_BEGIN { pg8::TileOrder S; S.init(NTILE - NB, 4, F.G, F.bid, Y, (size_t)256 * 2048 * 2, WOUT, (size_t)256 * 2048 * 2); S.skipctx = 1;
                       pg8::EpiOut E{l == 0 ? F.in(I_X) : (const float*)F.out, l == 0 ? F.in(I_CTX) : (const float*)xctx, F.out, xctx, modv + (size_t)l * 5 * 3072};
                       GEMM_CALL(2048, 2048, 2048, S, E);
                       __syncthreads();
                       { pg8::CtxKOrder S2{F.G, F.bid, (const char*)Y, (size_t)256 * 2048 * 2, (const char*)WOUT, (size_t)256 * 2048 * 2}; pg8::EpiPart E2{(float*)SL2};
                         { int tid2 = F.tid; asm volatile("" : "+v"(tid2)); pg8::gemm_phase(F.lds, tid2, 256, 2048, 2048, S2, E2); }     } } PH_END
        } else {
#undef Y
#undef U
#undef XR
#undef HB
#undef XC
#undef YS0
#undef YS1
#define PA SL0
#define HMB SL2
#define XM SL3
#define ZG SL4
#define XCV SL5
#define QP SL6
#define HB SL6
#pragma unroll 1
            for (int hb = 0; hb < 2; ++hb) {
                if (hb == 0) { PH_BEGIN { int l_ = l; asm volatile("" : "+s"(l_)); ph_norm(F, l_, 0, MH, HB, (const float*)SL2);
                                          ph_ctx_reduce(F, (const float*)SL2, l_ == 1 ? F.in(I_CTX) : (const float*)xctx, xctx, modv + (size_t)(l_ - 1) * 5 * 3072 + 4 * 3072 + 2048, (NB / 2) * LCTX * D / 4, NB * LCTX * D / 4); } ph_wconv_odd(F, j); PH_END }
                PH_BEGIN { pg8::TileOrder S; S.init(NTILE / 2, 16, F.G, F.bid, HB, (size_t)256 * 1024 * 2, WIN, (size_t)256 * 1024 * 2);
                           pg8::EpiSplit E{XM, ZG, 0, 0, 2048, 2048, 11};
                           GEMM_CALL(1024, 1024, 1024, S, E); } PH_END
                PH_BEGIN ph_convq(F, j, hb, XM, XCV, QP); PH_END
                PH_BEGIN ph_mscan(F, hb); PH_END
                PH_BEGIN ph_stilde(F, hb, QP, XCV); PH_END
                PH_BEGIN ph_mlstm_r(F, hb, QP, XCV, XM, PA + (size_t)hb * MH * 2048, 2048, HMB, 2048); PH_END
                PH_BEGIN ph_mlpost(F, j, hb, PA, HMB, XCV, ZG);
                         if (hb == 0) { int l_ = l; asm volatile("" : "+s"(l_)); ph_norm(F, l_, MH, 2 * MH, HB, (const float*)nullptr); }
                PH_END
            }
            PH_BEGIN { pg8::TileOrder S; S.init(NTILE - NB, 4, F.G, F.bid, PA, (size_t)256 * 2048 * 2, WOUT, (size_t)256 * 2048 * 2); S.skipctx = 1;
                       pg8::EpiOut E{l == 0 ? F.in(I_X) : (const float*)F.out, l == 0 ? F.in(I_CTX) : (const float*)xctx, F.out, xctx, modv + (size_t)l * 5 * 3072};
                       GEMM_CALL(2048, 2048, 2048, S, E);
                       if (l < DEPTH - 1) { __syncthreads();
                         pg8::CtxKOrder S2{F.G, F.bid, (const char*)PA, (size_t)256 * 2048 * 2, (const char*)WOUT, (size_t)256 * 2048 * 2}; pg8::EpiPart E2{(float*)SL2};
                         { int tid2 = F.tid; asm volatile("" : "+v"(tid2)); pg8::gemm_phase(F.lds, tid2, 256, 2048, 2048, S2, E2); }     } } PH_END
        }
    }
    PH_BEGIN ph_final(F); PH_END
#undef PH_BEGIN
#undef PH_END
#undef PA
#undef HMB
#undef XM
#undef ZG
#undef XCV
#undef QP
#undef HB
}

extern "C" void kernel_launch(void* const* d_in, const int* in_sizes, int n_in, void* d_out, int out_size, void* d_ws, size_t ws_size, hipStream_t stream) {
    static int grid = 0;
    if (grid == 0) {
        int dev = 0, cus = 0, per_cu = 0;
        if (hipGetDevice(&dev) != hipSuccess || hipDeviceGetAttribute(&cus, hipDeviceAttributeMultiprocessorCount, dev) != hipSuccess) { fprintf(stderr, "kernel_launch: device query failed\n"); grid = -1; return; }
        if (hipFuncSetAttribute((const void*)fwd_kernel, hipFuncAttributeMaxDynamicSharedMemorySize, LDS_BYTES) != hipSuccess) { fprintf(stderr, "kernel_launch: hipFuncSetAttribute failed\n"); grid = -1; return; }
        if (hipOccupancyMaxActiveBlocksPerMultiprocessor(&per_cu, (const void*)fwd_kernel, NTHR, LDS_BYTES) != hipSuccess || per_cu < 1) fprintf(stderr, "kernel_launch: occupancy query says %d\n", per_cu);
        (void)hipGetLastError();
        grid = cus;
        if (n_in != 38 || out_size != NB * LLAT * D || ws_size < WS_END) fprintf(stderr, "kernel_launch: unexpected shapes: n_in %d out %d ws %zu\n", n_in, out_size, ws_size);
    }
    if (grid < 0) return;
    (void)hipMemsetAsync((char*)d_ws + WS_CTL, 0, CTL_ZERO_BYTES, stream);
    Args a{};
    for (int i = 0; i < 38; ++i) a.in[i] = (const float*)d_in[i];
    a.out = (float*)d_out; a.ws = (unsigned char*)d_ws;
#if ONE_LAUNCH
    a.ph_lo = 0; a.ph_hi = NPH;
    hipLaunchKernelGGL(fwd_kernel, dim3(grid), dim3(NTHR), LDS_BYTES, stream, a);
#else
    for (int p = 0; p < NPH; ++p) { a.ph_lo = p; a.ph_hi = p + 1; hipLaunchKernelGGL(fwd_kernel, dim3(grid), dim3(NTHR), LDS_BYTES, stream, a); }
#endif
}
```

```cpp
#include <hip/hip_runtime.h>
#include <cstdio>
#include <cstdint>

#ifndef NAIVE_GEMM
#define NAIVE_GEMM 0
#endif
#if NAIVE_GEMM
#define GEMM_CALL(K_, la_, lb_, S_, E_) pg8::gemm_phase_naive(F.tid, K_, la_, lb_, S_, E_)
#else
#define GEMM_CALL(K_, la_, lb_, S_, E_) pg8::gemm_phase(F.lds, F.tid, K_, la_, lb_, S_, E_)
#endif
#ifndef ONE_LAUNCH
#define ONE_LAUNCH 1
#endif

#define LAS __attribute__((address_space(3)))
#define GAS __attribute__((address_space(1)))
typedef unsigned short bf16;
typedef short bf16x8 __attribute__((ext_vector_type(8)));
typedef float f32x4 __attribute__((ext_vector_type(4)));
typedef unsigned u32x4 __attribute__((ext_vector_type(4)));
typedef unsigned u32x2 __attribute__((ext_vector_type(2)));
typedef short s16x4 __attribute__((ext_vector_type(4)));

constexpr int NB = 4, LLAT = 8192, LCTX = 256, SEQL = LLAT + LCTX;
constexpr int M = NB * SEQL;
constexpr int D = 1024, DEPTH = 4;
constexpr int MH = M / 2;
constexpr int NTILE = M / 256, TPB = SEQL / 256;
constexpr float EPS = 1e-6f;
constexpr int NCH = SEQL / 64;

constexpr size_t MiB = 1u << 20;
constexpr size_t WS_CTL = 0, CTL_ZERO_BYTES = 64 * 1024;
constexpr size_t WS_MODV = 1 * MiB;
constexpr size_t WS_MG = WS_MODV + 256 * 1024;
constexpr size_t WS_WGT = WS_MG + 64 * 1024;
constexpr size_t WS_PC = WS_WGT + 128 * 1024;
constexpr size_t WS_SPT = WS_MODV + 512 * 1024;
constexpr size_t WS_DS = 2 * MiB;
constexpr size_t WS_PS = 3 * MiB;
constexpr size_t WS_GATE = 6 * MiB;
constexpr size_t WS_XCTX = 9 * MiB;
constexpr size_t WS_DN = 13 * MiB;
constexpr size_t WS_W = 16 * MiB;
constexpr size_t W_IN = 0, W_OUT = 8 * MiB, W_GLU = 12 * MiB, W_GATE = 14 * MiB;
constexpr size_t WS_ST = 32 * MiB;
constexpr size_t WS_SLAB = 50 * MiB;
constexpr size_t SLAB = (size_t)M * 1024 * 2;
static_assert(SLAB == 66 * MiB, "slab");
constexpr size_t WS_END = WS_SLAB + 7 * SLAB;
static_assert(WS_END == 512 * MiB, "ws map");

constexpr int LDS_BYTES = 163840;
constexpr int MISC_OFF = 163840 - 256;
constexpr int NWAVES = 8, NTHR = 512;

__device__ __forceinline__ float bf2f(unsigned b) { return __uint_as_float(b << 16); }
typedef __bf16 bf2v_t __attribute__((ext_vector_type(2)));
__device__ __forceinline__ unsigned f2bf(float f) { return (unsigned)__builtin_bit_cast(unsigned short, (__bf16)f); }
__device__ __forceinline__ unsigned pk2(float lo, float hi) { bf2v_t v; v.x = (__bf16)lo; v.y = (__bf16)hi; return __builtin_bit_cast(unsigned, v); }
__device__ __forceinline__ float sigm(float x) { return __builtin_amdgcn_rcpf(1.f + __expf(-x)); }
__device__ __forceinline__ float silu(float x) { return x * __builtin_amdgcn_rcpf(1.f + __expf(-x)); }
__device__ __forceinline__ float softplus(float x) { return x > 20.f ? x : __logf(1.f + __expf(x)); }
__device__ __forceinline__ float logsigmoid(float x) { return fminf(x, 0.f) - __logf(1.f + __expf(-fabsf(x))); }
__device__ __forceinline__ float gelu_tanh(float x) { return x * sigm(1.5957691216057308f * (x + 0.044715f * x * x * x)); }
__device__ __forceinline__ void unpack8(const u32x4 w, float (&v)[8]) {
    v[0] = bf2f(w.x & 0xffffu); v[1] = bf2f(w.x >> 16); v[2] = bf2f(w.y & 0xffffu); v[3] = bf2f(w.y >> 16);
    v[4] = bf2f(w.z & 0xffffu); v[5] = bf2f(w.z >> 16); v[6] = bf2f(w.w & 0xffffu); v[7] = bf2f(w.w >> 16);
}
__device__ __forceinline__ u32x4 pack8(const float (&v)[8]) { u32x4 w; w.x = pk2(v[0], v[1]); w.y = pk2(v[2], v[3]); w.z = pk2(v[4], v[5]); w.w = pk2(v[6], v[7]); return w; }
#define SWZX(v, m) __int_as_float(__builtin_amdgcn_ds_swizzle(__float_as_int(v), (((m) << 10) | 0x1f)))
__device__ __forceinline__ float wave_sum(float v) {
    v += SWZX(v, 1); v += SWZX(v, 2); v += SWZX(v, 4); v += SWZX(v, 8); v += SWZX(v, 16);
    return __int_as_float(__builtin_amdgcn_readlane(__float_as_int(v), 0)) + __int_as_float(__builtin_amdgcn_readlane(__float_as_int(v), 32));
}
__device__ __forceinline__ float sum8(float v) { v += SWZX(v, 1); v += SWZX(v, 2); v += SWZX(v, 4); return v; }
#define LDS_WAIT() asm volatile("s_waitcnt lgkmcnt(0)" ::: "memory")
#define VM_WAIT() asm volatile("s_waitcnt vmcnt(0)" ::: "memory")
#define WAVE_SYNC() do { asm volatile("s_waitcnt lgkmcnt(0)" ::: "memory"); __builtin_amdgcn_wave_barrier(); } while (0)

__device__ __forceinline__ int pos2s_even(int pos, int d) { return d == 0 ? pos : (pos < LCTX ? LCTX - 1 - pos : (SEQL + LCTX - 1) - pos); }
__device__ __forceinline__ int pos2s_odd(int pos, int d) {
    if (pos < LCTX) return d == 0 ? pos : LCTX - 1 - pos;
    const int p = d == 0 ? pos - LCTX : LLAT - 1 - (pos - LCTX);
    return LCTX + (p & 127) * 64 + (p >> 7);
}
__device__ __forceinline__ int nb_even(int s, int o) { const int t = s + o; return s < LCTX ? ((t >= 0 && t < LCTX) ? t : -1) : ((t >= LCTX && t < SEQL) ? t : -1); }
__device__ __forceinline__ int nb_odd(int s, int o) {
    if (s < LCTX) { const int t = s + o; return (t >= 0 && t < LCTX) ? t : -1; }
    const int i = s - LCTX, p = (i & 63) * 128 + (i >> 6) + o;
    if (p < 0 || p >= LLAT) return -1;
    return LCTX + (p & 127) * 64 + (p >> 7);
}

#define XB_TMO      128
#define XB_XCNT(j)  (256  + 64 * (j))
#define XB_XSUB(j)  (1280 + 64 * (j))
#define XB_XGEN(j)  (2304 + 64 * (j))
#define XB_TOP      3328
#define XB_TOPGEN   3392
#define XCD_BAR_WORDS 3456
#define XB_SPIN_CAP (1u << 22)
__device__ __forceinline__ unsigned xb_ld(unsigned* p)              { return __hip_atomic_load(p, __ATOMIC_RELAXED, __HIP_MEMORY_SCOPE_AGENT); }
__device__ __forceinline__ unsigned xb_add(unsigned* p, unsigned v) { return __hip_atomic_fetch_add(p, v, __ATOMIC_RELAXED, __HIP_MEMORY_SCOPE_AGENT); }
__device__ __forceinline__ unsigned xb_xcc_id() { return (unsigned)__builtin_amdgcn_s_getreg((3 << 11) | 20) & 0xFu; }
#define XB_SPIN(cond, bar) do { unsigned _sp = 0; while (cond) { __builtin_amdgcn_s_sleep(1); \
    if ((++_sp & 255u) == 0u) { if (xb_ld(&(bar)[XB_TMO])) break; if (_sp > XB_SPIN_CAP) { atomicAdd(&(bar)[XB_TMO], 1u); break; } } } } while (0)
struct XcdBarrier { unsigned* bar; unsigned x; volatile LAS unsigned* st; };
__device__ __forceinline__ XcdBarrier xcd_barrier_post(unsigned* bar, volatile LAS unsigned* st) {
    XcdBarrier b; b.bar = bar; b.x = xb_xcc_id(); b.st = st;
    if (threadIdx.x == 0) (void)xb_add(&bar[XB_XCNT(b.x)], 1u);
    return b;
}
__device__ __forceinline__ void xcd_barrier_complete(unsigned* bar, unsigned x, unsigned& nloc, unsigned& nx) {
    const unsigned G = gridDim.x * gridDim.y * gridDim.z;
    unsigned sum, cnt, mine, sp = 0u;
    for (;;) {
        sum = 0u; cnt = 0u; mine = 0u;
#pragma unroll
        for (unsigned j = 0; j < 16; ++j) { const unsigned c = xb_ld(&bar[XB_XCNT(j)]); sum += c; cnt += (c > 0u) ? 1u : 0u; mine = (j == x) ? c : mine; }
        if (sum == G) break;
        __builtin_amdgcn_s_sleep(1);
        if ((++sp & 255u) == 0u) { if (xb_ld(&bar[XB_TMO])) break; if (sp > XB_SPIN_CAP) { atomicAdd(&bar[XB_TMO], 1u); break; } }
    }
    nloc = mine > 0u ? mine : 1u; nx = cnt > 0u ? cnt : 1u;
}
__device__ __forceinline__ void xcd_barrier(const XcdBarrier& b, const bool leader) {
    asm volatile("s_waitcnt vmcnt(0)" ::: "memory");
    __syncthreads();
    if (leader) {
        unsigned* bar = b.bar;
        __builtin_amdgcn_s_waitcnt(0);
        unsigned nloc = b.st[0], nx = b.st[1];
        if (nloc == 0u) { xcd_barrier_complete(bar, b.x, nloc, nx); b.st[0] = nloc; b.st[1] = nx; }
        const unsigned old = xb_add(&bar[XB_XSUB(b.x)], 1u);
        const unsigned gen = old / nloc;
        if (old + 1u == (gen + 1u) * nloc) {
            __builtin_amdgcn_fence(__ATOMIC_RELEASE, "agent");
            asm volatile("s_waitcnt vmcnt(0)" ::: "memory");
            const unsigned og = xb_add(&bar[XB_TOP], 1u);
            const unsigned tg = og / nx;
            if (og + 1u == (tg + 1u) * nx) xb_add(&bar[XB_TOPGEN], 1u);
            else XB_SPIN(xb_ld(&bar[XB_TOPGEN]) == tg, bar);
            __builtin_amdgcn_fence(__ATOMIC_ACQUIRE, "agent");
            xb_add(&bar[XB_XGEN(b.x)], 1u);
            asm volatile("s_waitcnt vmcnt(0)" ::: "memory");
        } else {
            XB_SPIN(xb_ld(&bar[XB_XGEN(b.x)]) == gen, bar);
            __builtin_amdgcn_fence(__ATOMIC_ACQUIRE, "agent");
            asm volatile("s_waitcnt vmcnt(0)" ::: "memory");
        }
    }
    __syncthreads();
}

__device__ __forceinline__ void rg_coefs(const float la, float& om, float& mlt) {
    const float a = __expf(la);
    const float pom = -la * (1.f + la * (0.5f + la * (0.16666667f + la * 0.041666668f)));
    om = la > -0.125f ? pom : 1.f - a;
    mlt = __builtin_amdgcn_sqrtf(fmaxf(om * (2.f - om), 0.f));
}
namespace pg8 {
constexpr int BM = 256, BK = 64, HALF = 128, HTB = HALF * BK * 2, STAGE_BYTES = 8 * HTB, NXCD = 8, WGM = 8;
__host__ __device__ __forceinline__ int lds_byte(int r, int c) { const int st = (r >> 4) * 2 + (c >> 5), rr = r & 15, cc = c & 31, ob = rr * 64 + cc * 2; return st * 1024 + (ob ^ (((ob >> 9) & 1) << 5)); }
__host__ __device__ __forceinline__ void stage_rc(int b, int& R, int& C) { const int st = b / 1024, sb = b % 1024, swz = sb ^ (((sb >> 9) & 1) << 5); R = (st >> 1) * 16 + swz / 64; C = (st & 1) * 32 + (swz % 64) / 2; }
__host__ __device__ __forceinline__ int perm32(int rho) { const int n = rho >> 4, i = rho & 15; return 8 * (i >> 2) + 4 * n + (i & 3); }
struct Unit { int pm, pn; const char* a; const char* b; };
struct TileOrder {
    int nM, nN, nwg, G, c, skipctx;
    const char* A; size_t a_tile; int a_sh; size_t a_pn; const char* B; size_t b_tile;
    __device__ __forceinline__ void init(int nM_, int nN_, int G_, int c_, const void* A_, size_t a_tile_, const void* B_, size_t b_tile_, int a_sh_ = 0, size_t a_pn_ = 0) {
        nM = nM_; nN = nN_; nwg = nM * nN; G = G_; c = c_; skipctx = 0; A = (const char*)A_; a_tile = a_tile_; a_sh = a_sh_; a_pn = a_pn_; B = (const char*)B_; b_tile = b_tile_; }
    __device__ __forceinline__ bool next(int i, Unit& u) const {
        const long L = (long)i * G + c; if (L >= nwg) return false;
        int wgid = (int)L; { const int q = nwg / NXCD, r = nwg % NXCD, xcd = wgid % NXCD, off = wgid / NXCD; wgid = (xcd < r ? xcd * (q + 1) : r * (q + 1) + (xcd - r) * q) + off; }
        const int nig = WGM * nN, gid = wgid / nig, fm = gid * WGM, gsz = (nM - fm) < WGM ? (nM - fm) : WGM;
        u.pm = fm + ((wgid % nig) % gsz); u.pn = (wgid % nig) / gsz;
        if (skipctx) u.pm += u.pm / (TPB - 1) + 1;
        u.a = A + (size_t)u.pm * a_tile + (size_t)(u.pn >> a_sh) * a_pn; u.b = B + (size_t)u.pn * b_tile; return true;
    }
    __device__ __forceinline__ void a_ready(const Unit&) const {}
    __device__ __forceinline__ void done(const Unit&) const {}
};
__device__ __forceinline__ unsigned cvt_pk_bf16(float lo, float hi) { unsigned r; asm volatile("v_cvt_pk_bf16_f32 %0, %1, %2" : "=v"(r) : "v"(lo), "v"(hi)); return r; }

template <class Epi, class Sched>
__device__ __forceinline__ void gemm_phase(LAS unsigned char* lds, const int tid, const int K_, const int lda, const int ldb, const Sched& S, const Epi& E) {
    int K = K_; asm volatile("" : "+s"(K));
    const int wid = __builtin_amdgcn_readfirstlane(tid >> 6), lane = tid & 63, wr = wid >> 2, wc = wid & 3, fr = lane & 15, fq = lane >> 4;
    const int nt = K / BK;
    unsigned voffA[2], voffB[2];
#pragma unroll
    for (int i = 0; i < 2; ++i) { int R, C; stage_rc(tid * 16 + i * 8192, R, C); const int Rb = Epi::PERM ? ((R & ~31) + perm32(R & 31)) : R;
        voffA[i] = (unsigned)(R * lda + C) * 2u; voffB[i] = (unsigned)(Rb * ldb + C) * 2u; }
    const size_t kstep = (size_t)(BK * 2);
    const size_t hstepA = (size_t)HALF * lda * 2, hstepB = (size_t)HALF * ldb * 2;
    const unsigned ldsw = (unsigned)wid * 1024u;
    const int aoff = lds_byte(wr * 64 + fr, fq * 8), boff = lds_byte(wc * 32 + fr, fq * 8);
#define PG8_SA(b, h) (((b) * 2 + (h)) * HTB)
#define PG8_SB(b, h) ((4 + (b) * 2 + (h)) * HTB)
#define PG8_STAGE(bufoff, gbase, voff) do { _Pragma("unroll") for (int _i = 0; _i < 2; ++_i) \
        __builtin_amdgcn_global_load_lds((const unsigned*)((const char*)(gbase) + (voff)[_i]), (LAS unsigned*)(lds + (bufoff) + ldsw + _i * 8192), 16, 0, 0); } while (0)
#define PG8_LDA(dst, b, h) do { _Pragma("unroll") for (int m = 0; m < 4; ++m) _Pragma("unroll") for (int k = 0; k < 2; ++k) dst[m][k] = *(const LAS bf16x8*)(lds + PG8_SA(b, h) + aoff + m * 2048 + k * 1024); } while (0)
#define PG8_LDB(dst, b, h) do { _Pragma("unroll") for (int n = 0; n < 2; ++n) _Pragma("unroll") for (int k = 0; k < 2; ++k) dst[n][k] = *(const LAS bf16x8*)(lds + PG8_SB(b, h) + boff + n * 2048 + k * 1024); } while (0)
#define PG8_MMA(ai, bj, At, Bt) do { __builtin_amdgcn_s_setprio(1); _Pragma("unroll") for (int m = 0; m < 4; ++m) _Pragma("unroll") for (int n = 0; n < 2; ++n) _Pragma("unroll") for (int k = 0; k < 2; ++k) \
        acc[ai][bj][m][n] = __builtin_amdgcn_mfma_f32_16x16x32_bf16(Bt[n][k], At[m][k], acc[ai][bj][m][n], 0, 0, 0); __builtin_amdgcn_s_setprio(0); } while (0)
#define PG8_WAIT_V(n) asm volatile("s_waitcnt vmcnt(" #n ")" ::: "memory")
#define PG8_WAIT_L(n) asm volatile("s_waitcnt lgkmcnt(" #n ")" ::: "memory")
#define PG8_BAR __builtin_amdgcn_s_barrier()
#define PG8_SCHED __builtin_amdgcn_sched_barrier(0)
    Unit cur, nxt; int ui = 0;
    if (!S.next(0, cur)) return;
    f32x4 acc[2][2][4][2];
#pragma unroll
    for (int a = 0; a < 2; ++a)
#pragma unroll
        for (int b = 0; b < 2; ++b)
#pragma unroll
            for (int m = 0; m < 4; ++m)
#pragma unroll
                for (int n = 0; n < 2; ++n) acc[a][b][m][n] = (f32x4){0.f, 0.f, 0.f, 0.f};
    bf16x8 At[4][2], B0[2][2], B1[2][2];
    const char* cA = cur.a; const char* cB = cur.b;
    S.a_ready(cur);
    PG8_STAGE(PG8_SB(0, 0), cB, voffB); PG8_STAGE(PG8_SA(0, 0), cA, voffA); PG8_STAGE(PG8_SB(0, 1), cB + hstepB, voffB); PG8_STAGE(PG8_SA(0, 1), cA + hstepA, voffA);
    if (wr == 1) PG8_BAR;
    PG8_WAIT_V(4); PG8_BAR;
    PG8_STAGE(PG8_SB(1, 0), cB + kstep, voffB); PG8_STAGE(PG8_SA(1, 0), cA + kstep, voffA); PG8_STAGE(PG8_SB(1, 1), cB + hstepB + kstep, voffB);
    PG8_WAIT_V(6); PG8_BAR;
    for (;;) {
        const bool has_next = S.next(ui + 1, nxt);
        const char* nA = has_next ? nxt.a : cA; const char* nB = has_next ? nxt.b : cB;
        for (int t = 0; t < nt; t += 2) {
            const bool last = (t == nt - 2);
            const char* a1 = cA + (size_t)(t + 1) * kstep;
            const char* a2 = last ? nA : cA + (size_t)(t + 2) * kstep; const char* b2 = last ? nB : cB + (size_t)(t + 2) * kstep;
            const char* a3 = a2 + kstep; const char* b3 = b2 + kstep;
            if (last && has_next) S.a_ready(nxt);
            PG8_LDB(B0, 0, 0); PG8_SCHED; PG8_LDA(At, 0, 0); PG8_STAGE(PG8_SA(1, 1), a1 + hstepA, voffA);
            PG8_WAIT_L(8); PG8_BAR; PG8_WAIT_L(0); PG8_MMA(0, 0, At, B0); PG8_BAR; PG8_SCHED;
            PG8_LDB(B1, 0, 1); PG8_STAGE(PG8_SB(0, 0), b2, voffB);
            PG8_BAR; PG8_WAIT_L(0); PG8_MMA(0, 1, At, B1); PG8_BAR;
            PG8_LDA(At, 0, 1); PG8_STAGE(PG8_SA(0, 0), a2, voffA);
            PG8_BAR; PG8_WAIT_L(0); PG8_MMA(1, 0, At, B0); PG8_BAR; PG8_SCHED;
            PG8_STAGE(PG8_SB(0, 1), b2 + hstepB, voffB);
            PG8_WAIT_V(6); PG8_BAR; PG8_MMA(1, 1, At, B1); PG8_BAR;
            PG8_LDB(B0, 1, 0); PG8_SCHED; PG8_LDA(At, 1, 0); PG8_STAGE(PG8_SA(0, 1), a2 + hstepA, voffA);
            PG8_WAIT_L(8); PG8_BAR; PG8_WAIT_L(0); PG8_MMA(0, 0, At, B0); PG8_BAR; PG8_SCHED;
            PG8_LDB(B1, 1, 1); PG8_STAGE(PG8_SB(1, 0), b3, voffB);
            PG8_BAR; PG8_WAIT_L(0); PG8_MMA(0, 1, At, B1); PG8_BAR;
            PG8_LDA(At, 1, 1); PG8_STAGE(PG8_SA(1, 0), a3, voffA);
            PG8_BAR; PG8_WAIT_L(0); PG8_MMA(1, 0, At, B0); PG8_BAR; PG8_SCHED;
            PG8_STAGE(PG8_SB(1, 1), b3 + hstepB, voffB);
            PG8_WAIT_V(6); PG8_BAR; PG8_MMA(1, 1, At, B1); PG8_BAR;
        }
        E(acc, cur, wr, wc, fr, fq); S.done(cur);
        if (!has_next) break;
#pragma unroll
        for (int a = 0; a < 2; ++a)
#pragma unroll
            for (int b = 0; b < 2; ++b)
#pragma unroll
                for (int m = 0; m < 4; ++m)
#pragma unroll
                    for (int n = 0; n < 2; ++n) acc[a][b][m][n] = (f32x4){0.f, 0.f, 0.f, 0.f};
        cur = nxt; cA = nA; cB = nB; ++ui;
    }
    PG8_WAIT_V(0);
    if (wr == 0) PG8_BAR;
    PG8_BAR;
#undef PG8_SA
#undef PG8_SB
#undef PG8_STAGE
#undef PG8_LDA
#undef PG8_LDB
#undef PG8_MMA
#undef PG8_WAIT_V
#undef PG8_WAIT_L
#undef PG8_BAR
#undef PG8_SCHED
}

typedef const f32x4 (&AccRef)[2][2][4][2];
#ifndef NAIVE_GEMM
#define NAIVE_GEMM 0
#endif
template <class Epi, class Sched>
__device__ __forceinline__ void gemm_phase_naive(const int tid, const int K, const int lda, const int ldb, const Sched& S, const Epi& E) {
    const int wid = tid >> 6, lane = tid & 63, wr = wid >> 2, wc = wid & 3, fr = lane & 15, fq = lane >> 4;
    Unit cur;
    for (int ui = 0; S.next(ui, cur); ++ui) {
        f32x4 acc[2][2][4][2];
#pragma unroll
        for (int ai = 0; ai < 2; ++ai)
#pragma unroll
            for (int m = 0; m < 4; ++m) {
                const bf16* arow = (const bf16*)cur.a + (size_t)(128 * ai + 64 * wr + 16 * m + fr) * lda;
#pragma unroll
                for (int bj = 0; bj < 2; ++bj)
#pragma unroll
                    for (int n = 0; n < 2; ++n) {
                        const int c0 = 128 * bj + 32 * wc + (Epi::PERM ? 8 * fq + 4 * n : 16 * n + 4 * fq);
                        const bf16* b0 = (const bf16*)cur.b + (size_t)c0 * ldb;
                        float s0 = 0.f, s1 = 0.f, s2 = 0.f, s3 = 0.f;
                        for (int k = 0; k < K; k += 8) { float a[8], w[8]; unpack8(*(const u32x4*)(arow + k), a);
                            unpack8(*(const u32x4*)(b0 + k), w);
#pragma unroll
                            for (int x = 0; x < 8; ++x) s0 += a[x] * w[x];
                            unpack8(*(const u32x4*)(b0 + ldb + k), w);
#pragma unroll
                            for (int x = 0; x < 8; ++x) s1 += a[x] * w[x];
                            unpack8(*(const u32x4*)(b0 + 2 * ldb + k), w);
#pragma unroll
                            for (int x = 0; x < 8; ++x) s2 += a[x] * w[x];
                            unpack8(*(const u32x4*)(b0 + 3 * ldb + k), w);
#pragma unroll
                            for (int x = 0; x < 8; ++x) s3 += a[x] * w[x]; }
                        acc[ai][bj][m][n] = (f32x4){s0, s1, s2, s3}; } }
        E(acc, cur, wr, wc, fr, fq);
    }
}


struct EpiSplit {
    static constexpr bool PERM = true;
    bf16 *pe, *po; long se, so; int le, lo_; int wshift;
    __device__ __forceinline__ void operator()(AccRef acc, const Unit& u, int wr, int wc, int fr, int fq) const {
        const int rowb = u.pm * BM + wr * 64 + fr; const int colt = u.pn * BM; const int di = colt >> wshift, dh = di >> 1;
        bf16* base = (di & 1) ? po + (long)dh * so : pe + (long)dh * se; const int ldd = (di & 1) ? lo_ : le;
        const int col0 = (colt & ((1 << wshift) - 1)) + wc * 32 + 8 * fq;
#pragma unroll
        for (int ai = 0; ai < 2; ++ai)
#pragma unroll
            for (int m = 0; m < 4; ++m) { bf16* rowp = base + (size_t)(rowb + ai * HALF + m * 16) * ldd + col0;
#pragma unroll
                for (int bj = 0; bj < 2; ++bj) { const f32x4 v0 = acc[ai][bj][m][0], v1 = acc[ai][bj][m][1];
                    u32x4 w; w.x = cvt_pk_bf16(v0[0], v0[1]); w.y = cvt_pk_bf16(v0[2], v0[3]); w.z = cvt_pk_bf16(v1[0], v1[1]); w.w = cvt_pk_bf16(v1[2], v1[3]);
                    *(u32x4*)(rowp + bj * HALF) = w; } }
    }
};
struct EpiGlu {
    static constexpr bool PERM = true;
    const bf16* YG; bf16* Y; const float* gb;
    __device__ __forceinline__ void operator()(AccRef acc, const Unit& u, int wr, int wc, int fr, int fq) const {
        int rowb = u.pm * BM + wr * 64 + fr; const int col0 = u.pn * BM + wc * 32 + 8 * fq; asm volatile("" : "+v"(rowb));
        u32x4 ly[2][4], lg[2][4];
#define GLU_LD(g_, S) _Pragma("unroll") for (int q = 0; q < 4; ++q) { const size_t row = (size_t)(rowb + ((g_) >> 1) * HALF + (2 * ((g_) & 1) + (q >> 1)) * 16); const int col = col0 + (q & 1) * HALF; \
            ly[S][q] = *(const u32x4*)(YG + row * 1024 + col); lg[S][q] = *(const u32x4*)(Y + row * 2048 + col); }
        GLU_LD(0, 0)
#pragma unroll
        for (int g = 0; g < 4; ++g) {
            if (g + 1 < 4) { if ((g & 1) == 0) { GLU_LD(g + 1, 1) } else { GLU_LD(g + 1, 0) } }
#pragma unroll
            for (int q = 0; q < 4; ++q) { const int ai = g >> 1, m = 2 * (g & 1) + (q >> 1), bj = q & 1; const size_t row = (size_t)(rowb + ai * HALF + m * 16); const int col = col0 + bj * HALF;
                float y[8], gg[8], o[8]; unpack8(ly[g & 1][q], y); unpack8(lg[g & 1][q], gg);
                const f32x4 v0 = acc[ai][bj][m][0], v1 = acc[ai][bj][m][1];
                const float* gbp = gb + col; asm volatile("" : "+v"(gbp));
                const f32x4 b0 = *(const f32x4*)gbp, b1 = *(const f32x4*)(gbp + 4);
#pragma unroll
                for (int j = 0; j < 4; ++j) { o[j] = y[j] * sigm(v0[j] + b0[j]) * silu(gg[j]); o[4 + j] = y[4 + j] * sigm(v1[j] + b1[j]) * silu(gg[4 + j]); }
                *(u32x4*)(Y + row * 2048 + col) = pack8(o); }
        }
#undef GLU_LD
    }
};
struct EpiGate {
    static constexpr bool PERM = true;
    const bf16* XC; bf16* OM; const float *ba, *bx, *lam;
    __device__ __forceinline__ void operator()(AccRef acc, const Unit& u, int wr, int wc, int fr, int fq) const {
        const int rowb = u.pm * BM + wr * 64 + fr; const int h = u.pn >> 2, q = u.pn & 3, d = q >> 1, hf = q & 1;
        const int ch = h * 256 + hf * 128 + wc * 32 + 8 * fq;
        const int bq = u.pm / TPB; const bool cx = (u.pm - bq * TPB == 0) && d == 0;
        constexpr long dstep = (long)(SLAB / 2);
        bf16* const OMC = (bf16*)((char*)OM - (long)(WS_SLAB + 2 * SLAB - WS_ST)); bf16* const BT = OM + 3 * dstep;
        bf16* om = (cx ? OMC + ((long)bq * 256 - (long)u.pm * BM) * 1024 : OM + (long)d * dstep) + ch; bf16* bt = BT + (long)d * dstep + ch;
        float bav[8], bxv[8], sp[8];
#pragma unroll
        for (int j = 0; j < 8; ++j) { bav[j] = ba[d * 1024 + ch + j]; bxv[j] = bx[d * 1024 + ch + j]; sp[j] = lam[d * 1024 + ch + j]; }
        u32x4 xl[2][4];
#pragma unroll
        for (int ai = 0; ai < 2; ++ai)
#pragma unroll
            for (int m = 0; m < 4; ++m) xl[ai][m] = *(const u32x4*)(XC + (size_t)(rowb + ai * HALF + m * 16) * 1024 + ch);
#pragma unroll
        for (int ai = 0; ai < 2; ++ai)
#pragma unroll
            for (int m = 0; m < 4; ++m) { const size_t row = (size_t)(rowb + ai * HALF + m * 16);
                const f32x4 r0 = acc[ai][0][m][0], r1 = acc[ai][0][m][1], i0 = acc[ai][1][m][0], i1 = acc[ai][1][m][1];
                float x[8], o1[8], o2[8]; unpack8(xl[ai][m], x);
#pragma unroll
                for (int j = 0; j < 8; ++j) { const float vr = j < 4 ? r0[j & 3] : r1[j & 3], vi = j < 4 ? i0[j & 3] : i1[j & 3];
                    const float la = sp[j] * sigm(vr + bav[j]); float omj, mj; rg_coefs(la, omj, mj);
                    o1[j] = omj; o2[j] = mj * sigm(vi + bxv[j]) * x[j]; }
                *(u32x4*)(om + row * 1024) = pack8(o1); *(u32x4*)(bt + row * 1024) = pack8(o2); }
    }
};
struct EpiOut {
    static constexpr bool PERM = false;
    const float *srcLat, *srcCtx; float *dstLat, *dstCtx; const float* modl;
    __device__ __forceinline__ void operator()(AccRef acc, const Unit& u, int wr, int wc, int fr, int fq) const {
        const int b = u.pm / TPB, ti = u.pm - b * TPB;
        const float* src; float* dst; const float* gt;
        if (ti == 0) { src = srcCtx + (size_t)b * LCTX * D; dst = dstCtx + (size_t)b * LCTX * D; gt = modl + 4 * 3072 + 2048; }
        else { const size_t o = ((size_t)b * LLAT + (size_t)(ti - 1) * 256) * D; src = srcLat + o; dst = dstLat + o; gt = modl + b * 3072 + 2048; }
        const int rowb = wr * 64 + fr, col0 = u.pn * BM + wc * 32 + 4 * fq;
        f32x4 gv[2][2];
#pragma unroll
        for (int bj = 0; bj < 2; ++bj)
#pragma unroll
            for (int n = 0; n < 2; ++n) gv[bj][n] = *(const f32x4*)(gt + col0 + bj * HALF + n * 16);
        f32x4 xl[2][8];
#define OUT_LD(g_, S) { const float* sp_ = src + (size_t)(rowb + ((g_) >> 1) * HALF + 2 * ((g_) & 1) * 16) * D + col0; asm volatile("" : "+v"(sp_));     \
            _Pragma("unroll") for (int q = 0; q < 8; ++q) xl[S][q] = *(const f32x4*)(sp_ + (q >> 2) * 16 * D + ((q >> 1) & 1) * HALF + (q & 1) * 16); }
        OUT_LD(0, 0)
#pragma unroll
        for (int g = 0; g < 4; ++g) {
            if (g + 1 < 4) { if ((g & 1) == 0) { OUT_LD(g + 1, 1) } else { OUT_LD(g + 1, 0) } }
            float* dp_ = dst + (size_t)(rowb + (g >> 1) * HALF + 2 * (g & 1) * 16) * D + col0; asm volatile("" : "+v"(dp_));
#pragma unroll
            for (int q = 0; q < 8; ++q) { const int ai = g >> 1, m = 2 * (g & 1) + (q >> 2), bj = (q >> 1) & 1, n = q & 1;
                *(f32x4*)(dp_ + (q >> 2) * 16 * D + bj * HALF + n * 16) = xl[g & 1][q] + gv[bj][n] * acc[ai][bj][m][n]; }
        }
#undef OUT_LD
    }
};
struct CtxKOrder {
    int G, c; const char* A; size_t a_tile; const char* B; size_t b_tile;
    __device__ __forceinline__ bool next(int i, Unit& u) const {
        const int L = i * G + c; if (L >= 128) return false;
        const int ks = L & 7, pn = (L >> 3) & 3, b = L >> 5;
        u.pm = b * TPB; u.pn = pn | (ks << 8);
        u.a = A + (size_t)u.pm * a_tile + (size_t)ks * 256 * 2; u.b = B + (size_t)pn * b_tile + (size_t)ks * 256 * 2; return true;
    }
    __device__ __forceinline__ void a_ready(const Unit&) const {}
    __device__ __forceinline__ void done(const Unit&) const {}
};
struct CtxOrder {
    int G, c, c0, nN; const char* A; size_t a_tile; const char* B; size_t b_tile;
    __device__ __forceinline__ bool next(int i, Unit& u) const {
        const int L = i * G + c - c0; if (c < c0 || L >= NB * nN) return false;
        const int b = L / nN, pn = L - b * nN;
        u.pm = b * TPB; u.pn = pn; u.a = A + (size_t)u.pm * a_tile; u.b = B + (size_t)pn * b_tile; return true;
    }
    __device__ __forceinline__ void a_ready(const Unit&) const {}
    __device__ __forceinline__ void done(const Unit&) const {}
};
struct EpiPart {
    static constexpr bool PERM = false;
    float* P;
    __device__ __forceinline__ void operator()(AccRef acc, const Unit& u, int wr, int wc, int fr, int fq) const {
        const int ks = u.pn >> 8, pn = u.pn & 255, b = u.pm / TPB;
        float* dst = P + ((size_t)(ks * 4 + b) * 256 + wr * 64 + fr) * 1024 + pn * BM + wc * 32 + 4 * fq;
#pragma unroll
        for (int ai = 0; ai < 2; ++ai)
#pragma unroll
            for (int m = 0; m < 4; ++m)
#pragma unroll
                for (int bj = 0; bj < 2; ++bj)
#pragma unroll
                    for (int n = 0; n < 2; ++n) *(f32x4*)(dst + (size_t)(ai * HALF + m * 16) * 1024 + bj * HALF + n * 16) = acc[ai][bj][m][n];
    }
};
}

struct Args { const float* in[38]; float* out; unsigned char* ws; int ph_lo, ph_hi; };
#define CAS __attribute__((address_space(4)))
struct Ctx {
    LAS unsigned char* lds; int tid, lane, wave, bid, G, gw, NGW;
    const CAS char* kp; float* out; unsigned char* ws;
    __device__ __forceinline__ const float* in(int k) const { return *(const float* const CAS*)(kp + 8 * k); }
};
enum { I_X = 0, I_C, I_CTX, I_CCTX, I_NORMG, I_MODW, I_MODB, I_FINALG, I_EWIN, I_EWOUT, I_S5ARE, I_S5AIM, I_S5LOGDT, I_S5BRE, I_S5BIM, I_S5CRE, I_S5CIM, I_S5D, I_GLUW, I_GLUB,
       I_RGCW, I_RGCB, I_RGWA, I_RGBA, I_RGWX, I_RGBX, I_RGLAM, I_OWIN, I_OWOUT, I_MLCW, I_MLCB, I_MLWQ, I_MLWK, I_MLWV, I_MLWIF, I_MLBIF, I_MLNG, I_MLSKIP };

__device__ __forceinline__ const float* xrow_src(const Ctx& F, int l, int r, int lc) {
    const int b = r / SEQL, s = r - b * SEQL;
    if (s < LCTX) return (lc == 0 ? F.in(I_CTX) : (const float*)(F.ws + WS_XCTX)) + ((size_t)b * LCTX + s) * D;
    return (l == 0 ? F.in(I_X) : (const float*)F.out) + ((size_t)b * LLAT + (s - LCTX)) * D;
}

__device__ __forceinline__ void ph_mod(const Ctx& F) {
    LAS float* sl = (LAS float*)F.lds;
    LAS float* red = sl + 5 * 1024;
    for (int i = F.tid; i < 5 * 1024; i += NTHR) { const int bb = i >> 10, k = i & 1023; const float v = bb < 4 ? F.in(I_C)[bb * 1024 + k] : F.in(I_CCTX)[k]; sl[i] = silu(v); }
    __syncthreads();
    float* modv = (float*)(F.ws + WS_MODV);
    for (int it = F.bid; it < DEPTH * 48; it += F.G) {
        const int l = it / 48, j = (it - l * 48) * 64 + (F.tid & 63), kp = F.tid >> 6;
        const float* w = F.in(I_MODW) + (size_t)l * 1024 * 3072 + (size_t)(kp * 128) * 3072 + j;
        float a0 = 0.f, a1 = 0.f, a2 = 0.f, a3 = 0.f, a4 = 0.f;
#pragma unroll 16
        for (int k = 0; k < 128; ++k) { const float wv = w[(size_t)k * 3072]; const int kk = kp * 128 + k; a0 += sl[kk] * wv; a1 += sl[1024 + kk] * wv; a2 += sl[2048 + kk] * wv; a3 += sl[3072 + kk] * wv; a4 += sl[4096 + kk] * wv; }
        __syncthreads();
        red[(kp * 5 + 0) * 64 + (F.tid & 63)] = a0; red[(kp * 5 + 1) * 64 + (F.tid & 63)] = a1; red[(kp * 5 + 2) * 64 + (F.tid & 63)] = a2; red[(kp * 5 + 3) * 64 + (F.tid & 63)] = a3; red[(kp * 5 + 4) * 64 + (F.tid & 63)] = a4;
        __syncthreads();
        if (F.tid < 320) { const int bb = F.tid >> 6, jj = F.tid & 63; float t = 0.f;
#pragma unroll
            for (int q = 0; q < 8; ++q) t += red[(q * 5 + bb) * 64 + jj];
            const int jo = (it - l * 48) * 64 + jj;
            modv[((size_t)l * 5 + bb) * 3072 + jo] = t + F.in(I_MODB)[l * 3072 + jo]; }
    }
    __syncthreads();
}

__device__ __forceinline__ void transpose_item(const float* W, int N, bf16* WT, int ldw, int row_off, LAS float* scr, int item, int lane) {
    const int nblk = N / 32, kb = item / nblk, nbk = item % nblk, k0 = 64 * kb, n0 = 32 * nbk;
#pragma unroll 8
    for (int i = 0; i < 32; ++i) { const int kk = 2 * i + (lane >> 5); scr[kk * 33 + (lane & 31)] = W[(size_t)(k0 + kk) * N + n0 + (lane & 31)]; }
    WAVE_SYNC();
    const int c = lane & 7;
#pragma unroll
    for (int j = 0; j < 4; ++j) { const int n = (lane >> 3) + 8 * j; const LAS float* s = scr + (8 * c) * 33 + n;
        u32x4 o; o.x = pk2(s[0 * 33], s[1 * 33]); o.y = pk2(s[2 * 33], s[3 * 33]); o.z = pk2(s[4 * 33], s[5 * 33]); o.w = pk2(s[6 * 33], s[7 * 33]);
        *(u32x4*)(WT + (size_t)(row_off + n0 + n) * ldw + k0 + 8 * c) = o; }
    WAVE_SYNC();
}
__device__ __forceinline__ void ph_wconv_even(const Ctx& F, int j) {
    { const float* lam = F.in(I_RGLAM) + (size_t)j * 2048; float* spt = (float*)(F.ws + WS_SPT);
      for (int i = F.bid * NTHR + F.tid; i < 2048; i += F.G * NTHR) spt[i] = -8.f * softplus(-lam[i]); }
    LAS float* scr = (LAS float*)(F.lds + F.wave * 16384);
    bf16* win = (bf16*)(F.ws + WS_W + W_IN); bf16* wout = (bf16*)(F.ws + WS_W + W_OUT); bf16* wglu = (bf16*)(F.ws + WS_W + W_GLU); bf16* wgate = (bf16*)(F.ws + WS_W + W_GATE);
    constexpr int I_1 = 16 * 128, I_2 = 16 * 32, I_3 = 32 * 32, I_4 = 16 * 32;
    for (int it = F.gw; it < I_1 + I_2 + I_3 + I_4; it += F.NGW) {
        int r = it;
        if (r < I_1) { transpose_item(F.in(I_EWIN) + (size_t)j * 1024 * 4096, 4096, win, 1024, 0, scr, r, F.lane); continue; } r -= I_1;
        if (r < I_2) { transpose_item(F.in(I_GLUW) + (size_t)j * 1024 * 1024, 1024, wglu, 1024, 0, scr, r, F.lane); continue; } r -= I_2;
        if (r < I_3) { transpose_item(F.in(I_EWOUT) + (size_t)j * 2048 * 1024, 1024, wout, 2048, 0, scr, r, F.lane); continue; } r -= I_3;
        { const int mat = r >> 5, sub = r & 31, h = mat >> 2, q = mat & 3, d = q >> 1, isx = q & 1;
          const float* W = (isx ? F.in(I_RGWX) : F.in(I_RGWA)) + ((size_t)((j * 2 + d) * 4 + h)) * 256 * 256;
          const int n0 = 32 * (sub & 7);
          transpose_item(W, 256, wgate, 256, (4 * h + 2 * d + (n0 >> 7)) * 256 + isx * 128 + (n0 & 127) - n0, scr, sub, F.lane); }
    }
}
__device__ __forceinline__ void ph_wconv_odd(const Ctx& F, int j) {
    LAS float* scr = (LAS float*)(F.lds + F.wave * 16384);
    bf16* win = (bf16*)(F.ws + WS_W + W_IN); bf16* wout = (bf16*)(F.ws + WS_W + W_OUT);
    constexpr int I_1 = 16 * 128, I_3 = 32 * 32;
    for (int it = F.gw; it < I_1 + I_3; it += F.NGW) {
        int r = it;
        if (r < I_1) { transpose_item(F.in(I_OWIN) + (size_t)j * 1024 * 4096, 4096, win, 1024, 0, scr, r, F.lane); continue; } r -= I_1;
        transpose_item(F.in(I_OWOUT) + (size_t)j * 2048 * 1024, 1024, wout, 2048, 0, scr, r, F.lane);
    }
    const float* wq = F.in(I_MLWQ) + (size_t)j * 512 * 16; const float* wk = F.in(I_MLWK) + (size_t)j * 512 * 16; const float* wv = F.in(I_MLWV) + (size_t)j * 512 * 16;
    float* mg = (float*)(F.ws + WS_MG);
    for (int idx = F.bid * NTHR + F.tid; idx < 512 * 16; idx += F.G * NTHR) { const int g = idx >> 4, i = (idx >> 2) & 3, jj = idx & 3; float a = 0.f;
#pragma unroll
        for (int o = 0; o < 4; ++o) a += wq[g * 16 + i * 4 + o] * wk[g * 16 + jj * 4 + o];
        mg[idx] = a * 0.04419417382415922f; }
    unsigned* wgt = (unsigned*)(F.ws + WS_WGT);
    const float* wif = F.in(I_MLWIF) + (size_t)j * 2 * 3 * 2048 * 8;
    for (int idx = F.bid * NTHR + F.tid; idx < 1024 * 32; idx += F.G * NTHR) {
        const int cp = idx >> 5, src = (idx >> 4) & 1, o = idx & 15, d = o >> 3, n8 = o & 7; float wv2[2];
#pragma unroll
        for (int half = 0; half < 2; ++half) { const int c = 2 * cp + half, g = c >> 2, i = c & 3; float a = 0.f;
#pragma unroll
            for (int oo = 0; oo < 4; ++oo) {
                if (src) a += wv[g * 16 + i * 4 + oo] * wif[((size_t)(d * 3 + 2) * 2048 + 4 * g + oo) * 8 + n8];
                else a += wq[g * 16 + i * 4 + oo] * wif[((size_t)(d * 3 + 0) * 2048 + 4 * g + oo) * 8 + n8] + wk[g * 16 + i * 4 + oo] * wif[((size_t)(d * 3 + 1) * 2048 + 4 * g + oo) * 8 + n8]; }
            wv2[half] = a; }
        const int c0 = 2 * cp, cq = c0 >> 9, rem = c0 & 511, kk = rem >> 7, g4 = (rem >> 5) & 3, i4 = (rem >> 3) & 3, e2 = (rem & 7) >> 1;
        wgt[((size_t)(((src * 4 + cq) * 16 + kk * 4 + i4) * 64 + g4 * 16 + o)) * 4 + e2] = pk2(wv2[0], wv2[1]);
    }
}

__device__ __forceinline__ void fold_ctx(const Ctx& F, const float* P, const float* gtc, int r, f32x4 (&v)[4]) {
    const int b = r / SEQL, s = r - b * SEQL;
    if (s >= LCTX) return;
    const int row = b * LCTX + s;
    const f32x4* p = (const f32x4*)(P + (size_t)row * 1024) + F.lane;
    f32x4 a[4];
#pragma unroll
    for (int jj = 0; jj < 4; ++jj) a[jj] = p[64 * jj];
#pragma unroll
    for (int ks = 1; ks < 8; ++ks)
#pragma unroll
        for (int jj = 0; jj < 4; ++jj) a[jj] += p[(size_t)ks * (1024 * 256) + 64 * jj];
    f32x4* xo = (f32x4*)((float*)(F.ws + WS_XCTX) + (size_t)row * 1024) + F.lane;
#pragma unroll
    for (int jj = 0; jj < 4; ++jj) { const f32x4 g = *(const f32x4*)(gtc + 4 * F.lane + 256 * jj); v[jj] = v[jj] + g * a[jj]; xo[64 * jj] = v[jj]; }
}
__device__ __forceinline__ void ph_norm(const Ctx& F, int l, int r0, int r1, bf16* HB, const float* P) {
    const float* modl = (const float*)(F.ws + WS_MODV) + (size_t)l * 5 * 3072;
    const float* ng = F.in(I_NORMG) + l * 1024;
    const float* gtc = modl - 5 * 3072 + 4 * 3072 + 2048;
    const int lc = P ? l - 1 : l;
    for (int ra = r0 + F.gw; ra < r1; ra += 2 * F.NGW) {
        const int rb = ra + F.NGW; const bool hasb = rb < r1; const int rbb = hasb ? rb : ra;
        const f32x4* xa = (const f32x4*)xrow_src(F, l, ra, lc) + F.lane; const f32x4* xb = (const f32x4*)xrow_src(F, l, rbb, lc) + F.lane;
        f32x4 va[4], vb[4]; float sa = 0.f, sb = 0.f;
#pragma unroll
        for (int jj = 0; jj < 4; ++jj) { va[jj] = xa[64 * jj]; vb[jj] = xb[64 * jj]; }
        if (P) { fold_ctx(F, P, gtc, ra, va); if (hasb) fold_ctx(F, P, gtc, rb, vb); }
#pragma unroll
        for (int jj = 0; jj < 4; ++jj) { sa += (va[jj].x * va[jj].x + va[jj].y * va[jj].y) + (va[jj].z * va[jj].z + va[jj].w * va[jj].w); sb += (vb[jj].x * vb[jj].x + vb[jj].y * vb[jj].y) + (vb[jj].z * vb[jj].z + vb[jj].w * vb[jj].w); }
        const float rsa = rsqrtf(wave_sum(sa) * (1.f / D) + EPS), rsb = rsqrtf(wave_sum(sb) * (1.f / D) + EPS);
#pragma unroll
        for (int w2 = 0; w2 < 2; ++w2) { if (w2 == 1 && !hasb) break;
            const int r = w2 ? rb : ra; const float rstd = w2 ? rsb : rsa;
            const int b = r / SEQL, s = r - b * SEQL, bb = s < LCTX ? 4 : b;
            const float* sh = modl + bb * 3072; const float* sc = sh + 1024;
            unsigned long long* o8 = (unsigned long long*)(HB + (size_t)(r - r0) * D) + F.lane;
#pragma unroll
            for (int jj = 0; jj < 4; ++jj) { const int c = 4 * F.lane + 256 * jj; const f32x4 v = w2 ? vb[jj] : va[jj];
                const f32x4 g = *(const f32x4*)(ng + c), a = *(const f32x4*)(sc + c), h = *(const f32x4*)(sh + c);
                const float y0 = v.x * rstd * g.x * (1.f + a.x) + h.x, y1 = v.y * rstd * g.y * (1.f + a.y) + h.y, y2 = v.z * rstd * g.z * (1.f + a.z) + h.z, y3 = v.w * rstd * g.w * (1.f + a.w) + h.w;
                o8[64 * jj] = (unsigned long long)pk2(y0, y1) | ((unsigned long long)pk2(y2, y3) << 32); } }
    }
}

__device__ __forceinline__ void ph_rgconv(const Ctx& F, int j, const bf16* XR, bf16* XC) {
    const float* cw = F.in(I_RGCW) + (size_t)j * 4 * 1024; const float* cb = F.in(I_RGCB) + (size_t)j * 1024;
    for (int it = F.bid * NTHR + F.tid; it < M * 128; it += F.G * NTHR) {
        const int r = it >> 7, c = (it & 127) * 8, b = r / SEQL, s = r - b * SEQL;
        float a[8];
#pragma unroll
        for (int e = 0; e < 8; ++e) a[e] = cb[c + e];
#pragma unroll
        for (int t = 0; t < 4; ++t) { const int sn = nb_even(s, t - 1);
            if (sn >= 0) { float x[8]; unpack8(*(const u32x4*)(XR + ((size_t)b * SEQL + sn) * 1024 + c), x);
#pragma unroll
                for (int e = 0; e < 8; ++e) a[e] += cw[t * 1024 + c + e] * x[e]; } }
        *(u32x4*)(XC + (size_t)r * 1024 + c) = pack8(a);
    }
}

__device__ __forceinline__ void ph_s5_naive(const Ctx& F, int j, const bf16* U, bf16* YS0, bf16* YS1) {
    if ((F.wave & 3) != 0) return;
    const int slot = F.wave >> 2;
    LAS float* xre = (LAS float*)(F.lds + slot * 65536);
    LAS float* xim = xre + 64 * 65;
    LAS float* cre = xim + 64 * 65;
    LAS float* cim = cre + 1024;
    LAS float* ub = cim + 1024;
    const int p = F.lane;
    for (int q = F.bid * 2 + slot; q < NB * 2 * 64; q += F.G * 2) {
        const int b = q >> 7, d = (q >> 6) & 1, g = q & 63;
        const size_t pg = (size_t)((j * 2 + d) * 64 + g);
        const float are = F.in(I_S5ARE)[pg * 64 + p], aim = F.in(I_S5AIM)[pg * 64 + p], dt = expf(F.in(I_S5LOGDT)[pg]);
        const float dar = dt * are, dai = dt * aim, mag = expf(dar);
        const float abr = mag * cosf(dai), abi = mag * sinf(dai);
        const float den = are * are + aim * aim, nr = abr - 1.f, ni = abi;
        const float cor = (nr * are + ni * aim) / den, coi = (ni * are - nr * aim) / den;
        float bbr[16], bbi[16];
#pragma unroll
        for (int h = 0; h < 16; ++h) { const float br = F.in(I_S5BRE)[(pg * 64 + p) * 16 + h], bi = F.in(I_S5BIM)[(pg * 64 + p) * 16 + h]; bbr[h] = cor * br - coi * bi; bbi[h] = cor * bi + coi * br; }
#pragma unroll
        for (int h = 0; h < 16; ++h) { cre[h * 64 + p] = F.in(I_S5CRE)[(pg * 16 + h) * 64 + p]; cim[h * 64 + p] = F.in(I_S5CIM)[(pg * 16 + h) * 64 + p]; }
        bf16* YS = d ? YS1 : YS0;
        float sr = 0.f, si = 0.f;
        for (int ck = 0; ck < SEQL / 64; ++ck) {
            const size_t myrow = (size_t)b * SEQL + pos2s_even(ck * 64 + F.lane, d);
            { float x[8]; unpack8(*(const u32x4*)(U + myrow * 1024 + 16 * g), x);
#pragma unroll
              for (int e = 0; e < 8; ++e) ub[F.lane * 16 + e] = x[e];
              unpack8(*(const u32x4*)(U + myrow * 1024 + 16 * g + 8), x);
#pragma unroll
              for (int e = 0; e < 8; ++e) ub[F.lane * 16 + 8 + e] = x[e]; }
            WAVE_SYNC();
            for (int t = 0; t < 64; ++t) {
                float bur = 0.f, bui = 0.f;
#pragma unroll
                for (int h4 = 0; h4 < 4; ++h4) { const f32x4 uv = *(const LAS f32x4*)(ub + t * 16 + h4 * 4);
                    bur += bbr[h4 * 4] * uv.x + bbr[h4 * 4 + 1] * uv.y + bbr[h4 * 4 + 2] * uv.z + bbr[h4 * 4 + 3] * uv.w;
                    bui += bbi[h4 * 4] * uv.x + bbi[h4 * 4 + 1] * uv.y + bbi[h4 * 4 + 2] * uv.z + bbi[h4 * 4 + 3] * uv.w; }
                const float nsr = abr * sr - abi * si + bur, nsi = abr * si + abi * sr + bui;
                sr = nsr; si = nsi;
                xre[p * 65 + t] = sr; xim[p * 65 + t] = si;
            }
            WAVE_SYNC();
            float y[16];
#pragma unroll
            for (int h = 0; h < 16; ++h) y[h] = 0.f;
            for (int pp = 0; pp < 64; ++pp) { const float vr = xre[pp * 65 + F.lane], vi = xim[pp * 65 + F.lane];
#pragma unroll
                for (int h = 0; h < 16; ++h) y[h] += vr * cre[h * 64 + pp] - vi * cim[h * 64 + pp]; }
            { float o[8];
#pragma unroll
              for (int e = 0; e < 8; ++e) o[e] = y[e];
              *(u32x4*)(YS + myrow * 1024 + 16 * g) = pack8(o);
#pragma unroll
              for (int e = 0; e < 8; ++e) o[e] = y[8 + e];
              *(u32x4*)(YS + myrow * 1024 + 16 * g + 8) = pack8(o); }
            WAVE_SYNC();
        }
    }
}
typedef float f32x16s __attribute__((ext_vector_type(16)));
__device__ __forceinline__ float xhalf(const float v, const int hh) { const auto r = __builtin_amdgcn_permlane32_swap(__float_as_uint(v), __float_as_uint(v), false, false); return __uint_as_float(hh ? r[0] : r[1]); }
__device__ __forceinline__ void ph_s5_mfma(const Ctx& F, int j, bf16* U, bf16* YS0) {
    const int qd = F.wave;
    constexpr int XS = 272;
    constexpr int NCQ = SEQL / 32 / 8;
    LAS unsigned char* const X = F.lds + F.wave * 8704;
    LAS bf16x8* const FRL = (LAS bf16x8*)(F.lds + 8 * 8704);
    LAS f32x4* const PWT = (LAS f32x4*)(F.lds + 8 * 8704 + 8192);
    LAS f32x4* const ES = (LAS f32x4*)(F.lds + 8 * 8704 + 24576);
    const float* dd = F.in(I_S5D) + (size_t)j * 1024;
    const int lane = F.lane, c = lane & 31, hh = lane >> 5;
    const int qb = (F.G == 256) ? ((F.bid & 7) * 32 + (F.bid >> 3)) : F.bid;
    for (int q = qb; q < NB * 64; q += F.G) {
        const int b = q >> 6, g = q & 63;
#pragma unroll 1
      for (int d = 0; d < 2; ++d) {
        const size_t pg = (size_t)((j * 2 + d) * 64 + g);
        const float dt = expf(F.in(I_S5LOGDT)[pg]);
        float abr[2], abi[2], cor[2], coi[2], a16r[2], a16i[2], aqr[2], aqi[2];
#pragma unroll
        for (int st = 0; st < 2; ++st) { const int pp = st * 32 + c; const float are = F.in(I_S5ARE)[pg * 64 + pp], aim = F.in(I_S5AIM)[pg * 64 + pp];
            const float dar = dt * are, dai = dt * aim, mag = expf(dar); abr[st] = mag * cosf(dai); abi[st] = mag * sinf(dai);
            const float den = are * are + aim * aim, nr = abr[st] - 1.f, ni = abi[st]; cor[st] = (nr * are + ni * aim) / den; coi[st] = (ni * are - nr * aim) / den;
            const float m16 = expf(16.f * dar); a16r[st] = m16 * cosf(16.f * dai); a16i[st] = m16 * sinf(16.f * dai);
            const float mq = expf((float)(NCQ * 32) * dar); aqr[st] = mq * cosf((float)(NCQ * 32) * dai); aqi[st] = mq * sinf((float)(NCQ * 32) * dai); }
        __syncthreads();
        if (qd == 0) {
            { float pr = abr[0], pi = abi[0], qr = abr[1], qi = abi[1];
#pragma unroll 1
              for (int i = 0; i < 16; ++i) { PWT[i * 64 + lane] = (f32x4){pr, pi, qr, qi};
                  const float npr = pr * abr[0] - pi * abi[0], npi = pr * abi[0] + pi * abr[0]; pr = npr; pi = npi;
                  const float nqr = qr * abr[1] - qi * abi[1], nqi = qr * abi[1] + qi * abr[1]; qr = nqr; qi = nqi; } }
#pragma unroll
            for (int st = 0; st < 2; ++st) { const int pp = st * 32 + c;
                const f32x4 br0 = *(const f32x4*)(F.in(I_S5BRE) + (pg * 64 + pp) * 16 + 8 * hh), br1 = *(const f32x4*)(F.in(I_S5BRE) + (pg * 64 + pp) * 16 + 8 * hh + 4);
                const f32x4 bi0 = *(const f32x4*)(F.in(I_S5BIM) + (pg * 64 + pp) * 16 + 8 * hh), bi1 = *(const f32x4*)(F.in(I_S5BIM) + (pg * 64 + pp) * 16 + 8 * hh + 4);
                const float brv[8] = {br0.x, br0.y, br0.z, br0.w, br1.x, br1.y, br1.z, br1.w}, biv[8] = {bi0.x, bi0.y, bi0.z, bi0.w, bi1.x, bi1.y, bi1.z, bi1.w};
                float vr[8], vi[8];
#pragma unroll
                for (int i = 0; i < 8; ++i) { vr[i] = cor[st] * brv[i] - coi[st] * biv[i]; vi[i] = cor[st] * biv[i] + coi[st] * brv[i]; }
                FRL[st * 64 + lane] = __builtin_bit_cast(bf16x8, pack8(vr)); FRL[(2 + st) * 64 + lane] = __builtin_bit_cast(bf16x8, pack8(vi)); }
#pragma unroll
            for (int ks = 0; ks < 4; ++ks) { const int c2a = 8 * ks + 2 * (lane >> 4); const size_t ro = (pg * 16 + (lane & 15)) * 64;
                const float2 r0 = *(const float2*)(F.in(I_S5CRE) + ro + c2a), r1 = *(const float2*)(F.in(I_S5CRE) + ro + 32 + c2a);
                const float2 m0 = *(const float2*)(F.in(I_S5CIM) + ro + c2a), m1 = *(const float2*)(F.in(I_S5CIM) + ro + 32 + c2a);
                const float v[8] = {r0.x, r1.x, -m0.x, -m1.x, r0.y, r1.y, -m0.y, -m1.y};
                FRL[(4 + ks) * 64 + lane] = __builtin_bit_cast(bf16x8, pack8(v)); }
        }
        __syncthreads();
        const int tau = 16 * ((c >> 2) & 1) + 4 * (c >> 3) + (c & 3);
        float cin[4] = {0.f, 0.f, 0.f, 0.f};
        const int ck0 = qd * NCQ;
#define S5_HEAD() \
                const bf16x8 ucur = unext; \
                if (ck + 1 < ck0 + NCQ) unext = *(const bf16x8*)(U + ((size_t)b * SEQL + pos2s_even(32 * (ck + 1) + tau, d)) * 1024 + 16 * g + 8 * hh); \
                f32x16s t0, t1, t2, t3; \
                _Pragma("unroll") for (int i = 0; i < 16; ++i) { t0[i] = 0.f; t1[i] = 0.f; t2[i] = 0.f; t3[i] = 0.f; } \
                t0 = __builtin_amdgcn_mfma_f32_32x32x16_bf16(ucur, FRL[lane], t0, 0, 0, 0); t1 = __builtin_amdgcn_mfma_f32_32x32x16_bf16(ucur, FRL[64 + lane], t1, 0, 0, 0); \
                t2 = __builtin_amdgcn_mfma_f32_32x32x16_bf16(ucur, FRL[128 + lane], t2, 0, 0, 0); t3 = __builtin_amdgcn_mfma_f32_32x32x16_bf16(ucur, FRL[192 + lane], t3, 0, 0, 0); \
                  \
                { float xr = 0.f, xi = 0.f, yr = 0.f, yi = 0.f; \
                  _Pragma("unroll") for (int i = 0; i < 16; ++i) { const float nr = abr[0] * xr - abi[0] * xi + t0[i], ni = abr[0] * xi + abi[0] * xr + t2[i]; t0[i] = nr; t2[i] = ni; xr = nr; xi = ni; \
                      const float mr = abr[1] * yr - abi[1] * yi + t1[i], mi = abr[1] * yi + abi[1] * yr + t3[i]; t1[i] = mr; t3[i] = mi; yr = mr; yi = mi; } } \
                __builtin_amdgcn_sched_barrier(0); \
                  \
                float ce[4]; \
                { const float l0 = xhalf(t0[15], hh), l2 = xhalf(t2[15], hh), l1 = xhalf(t1[15], hh), l3 = xhalf(t3[15], hh); \
                  const float e0 = l0 + (a16r[0] * cin[0] - a16i[0] * cin[1]), e1 = l2 + (a16r[0] * cin[1] + a16i[0] * cin[0]); \
                  const float e2 = l1 + (a16r[1] * cin[2] - a16i[1] * cin[3]), e3 = l3 + (a16r[1] * cin[3] + a16i[1] * cin[2]); \
                  ce[0] = hh ? e0 : cin[0]; ce[1] = hh ? e1 : cin[1]; ce[2] = hh ? e2 : cin[2]; ce[3] = hh ? e3 : cin[3]; }
        {
            bf16x8 unext = *(const bf16x8*)(U + ((size_t)b * SEQL + pos2s_even(32 * ck0 + tau, d)) * 1024 + 16 * g + 8 * hh);
#pragma unroll 1
            for (int ck = ck0; ck < ck0 + NCQ; ++ck) {
                S5_HEAD()
                const float n0 = t0[15] + (a16r[0] * ce[0] - a16i[0] * ce[1]), n1 = t2[15] + (a16r[0] * ce[1] + a16i[0] * ce[0]);
                const float n2 = t1[15] + (a16r[1] * ce[2] - a16i[1] * ce[3]), n3 = t3[15] + (a16r[1] * ce[3] + a16i[1] * ce[2]);
                const float o0 = xhalf(n0, hh), o1 = xhalf(n1, hh), o2 = xhalf(n2, hh), o3 = xhalf(n3, hh);
                cin[0] = hh ? n0 : o0; cin[1] = hh ? n1 : o1; cin[2] = hh ? n2 : o2; cin[3] = hh ? n3 : o3;
            }
            ES[qd * 64 + lane] = (f32x4){cin[0], cin[1], cin[2], cin[3]};
            __syncthreads();
            float c0 = 0.f, c1 = 0.f, c2 = 0.f, c3 = 0.f;
            for (int k = 0; k < qd; ++k) { const f32x4 e = ES[k * 64 + lane];
                const float n0 = aqr[0] * c0 - aqi[0] * c1 + e.x, n1 = aqr[0] * c1 + aqi[0] * c0 + e.y, n2 = aqr[1] * c2 - aqi[1] * c3 + e.z, n3 = aqr[1] * c3 + aqi[1] * c2 + e.w;
                c0 = n0; c1 = n1; c2 = n2; c3 = n3; }
            cin[0] = c0; cin[1] = c1; cin[2] = c2; cin[3] = c3;
        }
        {
            bf16x8 unext = *(const bf16x8*)(U + ((size_t)b * SEQL + pos2s_even(32 * ck0 + tau, d)) * 1024 + 16 * g + 8 * hh);
#pragma unroll 1
            for (int ck = ck0; ck < ck0 + NCQ; ++ck) {
                S5_HEAD()
#pragma unroll
                for (int i = 0; i < 16; ++i) { const f32x4 pw = PWT[i * 64 + lane];
                    t0[i] += pw.x * ce[0] - pw.y * ce[1]; t2[i] += pw.x * ce[1] + pw.y * ce[0]; t1[i] += pw.z * ce[2] - pw.w * ce[3]; t3[i] += pw.z * ce[3] + pw.w * ce[2]; }
                { const float o0 = xhalf(t0[15], hh), o1 = xhalf(t2[15], hh), o2 = xhalf(t1[15], hh), o3 = xhalf(t3[15], hh);
                  cin[0] = hh ? t0[15] : o0; cin[1] = hh ? t2[15] : o1; cin[2] = hh ? t1[15] : o2; cin[3] = hh ? t3[15] : o3; }
                __builtin_amdgcn_sched_barrier(0);
#pragma unroll
                for (int i = 0; i < 16; ++i) { u32x2 w; w.x = pk2(t0[i], t1[i]); w.y = pk2(t2[i], t3[i]); *(LAS u32x2*)(X + (16 * hh + i) * XS + 8 * c) = w; }
                WAVE_SYNC();
                __builtin_amdgcn_sched_barrier(0);
                f32x4 y0 = (f32x4){0.f, 0.f, 0.f, 0.f}, y1 = (f32x4){0.f, 0.f, 0.f, 0.f};
#pragma unroll
                for (int ks = 0; ks < 4; ++ks) { const bf16x8 x0 = *(const LAS bf16x8*)(X + (lane & 15) * XS + 64 * ks + 16 * (lane >> 4)), x1 = *(const LAS bf16x8*)(X + (16 + (lane & 15)) * XS + 64 * ks + 16 * (lane >> 4));
                    const bf16x8 cf = FRL[(4 + ks) * 64 + lane]; y0 = __builtin_amdgcn_mfma_f32_16x16x32_bf16(cf, x0, y0, 0, 0, 0); y1 = __builtin_amdgcn_mfma_f32_16x16x32_bf16(cf, x1, y1, 0, 0, 0); }
                { const size_t o0 = ((size_t)b * SEQL + pos2s_even(32 * ck + (lane & 15), d)) * 1024 + 16 * g + 4 * (lane >> 4), o1 = ((size_t)b * SEQL + pos2s_even(32 * ck + 16 + (lane & 15), d)) * 1024 + 16 * g + 4 * (lane >> 4);
                  if (d == 0) { u32x2 w; w.x = pk2(y0[0], y0[1]); w.y = pk2(y0[2], y0[3]); *(u32x2*)(YS0 + o0) = w;
                      w.x = pk2(y1[0], y1[1]); w.y = pk2(y1[2], y1[3]); *(u32x2*)(YS0 + o1) = w; }
                  else {
                      const unsigned long long f0 = __hip_atomic_load((const unsigned long long*)(YS0 + o0), __ATOMIC_RELAXED, __HIP_MEMORY_SCOPE_AGENT), f1 = __hip_atomic_load((const unsigned long long*)(YS0 + o1), __ATOMIC_RELAXED, __HIP_MEMORY_SCOPE_AGENT);
                      const u32x2 u0 = *(const u32x2*)(U + o0), u1 = *(const u32x2*)(U + o1);
                      const f32x4 dv = *(const f32x4*)(dd + 16 * g + 4 * (lane >> 4));
                      const unsigned fa0 = (unsigned)f0, fb0 = (unsigned)(f0 >> 32), fa1 = (unsigned)f1, fb1 = (unsigned)(f1 >> 32);
                      u32x2 w;
                      w.x = pk2(gelu_tanh(bf2f(fa0 & 0xffffu) + y0[0] + dv.x * bf2f(u0.x & 0xffffu)), gelu_tanh(bf2f(fa0 >> 16) + y0[1] + dv.y * bf2f(u0.x >> 16)));
                      w.y = pk2(gelu_tanh(bf2f(fb0 & 0xffffu) + y0[2] + dv.z * bf2f(u0.y & 0xffffu)), gelu_tanh(bf2f(fb0 >> 16) + y0[3] + dv.w * bf2f(u0.y >> 16)));
                      *(u32x2*)(U + o0) = w;
                      w.x = pk2(gelu_tanh(bf2f(fa1 & 0xffffu) + y1[0] + dv.x * bf2f(u1.x & 0xffffu)), gelu_tanh(bf2f(fa1 >> 16) + y1[1] + dv.y * bf2f(u1.x >> 16)));
                      w.y = pk2(gelu_tanh(bf2f(fb1 & 0xffffu) + y1[2] + dv.z * bf2f(u1.y & 0xffffu)), gelu_tanh(bf2f(fb1 >> 16) + y1[3] + dv.w * bf2f(u1.y >> 16)));
                      *(u32x2*)(U + o1) = w; } }
                WAVE_SYNC();
            }
        }
#undef S5_HEAD
      }
    }
    __syncthreads();
}
__device__ __forceinline__ void ph_s5_post(const Ctx& F, int j, bf16* U, const bf16* YS0, const bf16* YS1) {
    const float* dd = F.in(I_S5D) + (size_t)j * 1024;
    const int stride = F.G * NTHR;
    for (int it = F.bid * NTHR + F.tid; it < M * 128; it += 2 * stride) {
        const int it2 = it + stride; const bool has2 = it2 < M * 128;
        const size_t o1 = (size_t)it * 8, o2 = (size_t)(has2 ? it2 : it) * 8; const int c1 = (it & 127) * 8, c2 = ((has2 ? it2 : it) & 127) * 8;
        const u32x4 u1 = *(const u32x4*)(U + o1), a1 = *(const u32x4*)(YS0 + o1), b1 = *(const u32x4*)(YS1 + o1);
        const u32x4 u2 = *(const u32x4*)(U + o2), a2 = *(const u32x4*)(YS0 + o2), b2 = *(const u32x4*)(YS1 + o2);
        { float u[8], a[8], b[8], o[8]; unpack8(u1, u); unpack8(a1, a); unpack8(b1, b);
#pragma unroll
          for (int e = 0; e < 8; ++e) o[e] = gelu_tanh(a[e] + b[e] + dd[c1 + e] * u[e]);
          *(u32x4*)(U + o1) = pack8(o); }
        if (has2) { float u[8], a[8], b[8], o[8]; unpack8(u2, u); unpack8(a2, a); unpack8(b2, b);
#pragma unroll
          for (int e = 0; e < 8; ++e) o[e] = gelu_tanh(a[e] + b[e] + dd[c2 + e] * u[e]);
          *(u32x4*)(U + o2) = pack8(o); }
    }
}
__device__ __forceinline__ void ph_rgscan_a(const Ctx& F, const bf16* OM0, const bf16* OM1, const bf16* BT0, const bf16* BT1, float* RGE, float* RGP, const bf16* OMC) {
    for (int it = F.wave * F.G + F.bid; it < NB * 2 * TPB * 4; it += F.NGW) {
        const int cg = it & 3, k = (it >> 2) % TPB, bd = (it >> 2) / TPB, b = bd >> 1, d = bd & 1, ch = cg * 256 + 4 * F.lane;
        const int r0 = pos2s_even(256 * k, d); const long rs = d ? -1024 : 1024;
        const bf16* OM = (d ? OM1 + ((size_t)b * SEQL + r0) * 1024 : (k == 0 ? OMC + ((size_t)b * 256 + r0) * 1024 : OM0 + ((size_t)b * SEQL + r0) * 1024)) + ch;
        const bf16* BT = (d ? BT1 : BT0) + ((size_t)b * SEQL + r0) * 1024 + ch;
        float h0 = 0.f, h1 = 0.f, h2 = 0.f, h3 = 0.f, p0 = 1.f, p1 = 1.f, p2 = 1.f, p3 = 1.f;
        u32x2 ow[16], bw[16], on[16], bn[16];
#pragma unroll
        for (int e = 0; e < 16; ++e) { ow[e] = *(const u32x2*)(OM + e * rs); bw[e] = *(const u32x2*)(BT + e * rs); }
#pragma unroll 1
        for (int t = 0; t < 256; t += 16) {
            const int tn = t + 16 < 256 ? t + 16 : t;
#pragma unroll
            for (int e = 0; e < 16; ++e) { on[e] = *(const u32x2*)(OM + (tn + e) * rs); bn[e] = *(const u32x2*)(BT + (tn + e) * rs); }
#pragma unroll
            for (int e = 0; e < 16; ++e) {
                const float a0 = 1.f - bf2f(ow[e].x & 0xffffu), a1 = 1.f - bf2f(ow[e].x >> 16), a2 = 1.f - bf2f(ow[e].y & 0xffffu), a3 = 1.f - bf2f(ow[e].y >> 16);
                h0 = a0 * h0 + bf2f(bw[e].x & 0xffffu); p0 *= a0; h1 = a1 * h1 + bf2f(bw[e].x >> 16); p1 *= a1;
                h2 = a2 * h2 + bf2f(bw[e].y & 0xffffu); p2 *= a2; h3 = a3 * h3 + bf2f(bw[e].y >> 16); p3 *= a3; }
#pragma unroll
            for (int e = 0; e < 16; ++e) { ow[e] = on[e]; bw[e] = bn[e]; }
        }
        const size_t o = ((size_t)bd * TPB + k) * 1024 + ch;
        *(f32x4*)(RGE + o) = (f32x4){h0, h1, h2, h3}; *(f32x4*)(RGP + o) = (f32x4){p0, p1, p2, p3};
    }
}
__device__ __forceinline__ void rg_carry(const float* RGE, const float* RGP, const size_t o, const int nk, float& h0, float& h1) {
    h0 = 0.f; h1 = 0.f;
#pragma unroll 1
    for (int k0 = 0; k0 < nk; k0 += 8) {
        float2 e[8], p[8];
#pragma unroll
        for (int i = 0; i < 8; ++i) { const int kk = k0 + i < nk ? k0 + i : nk - 1; e[i] = *(const float2*)(RGE + o + (size_t)kk * 1024); p[i] = *(const float2*)(RGP + o + (size_t)kk * 1024); }
#pragma unroll
        for (int i = 0; i < 8; ++i) if (k0 + i < nk) { h0 = p[i].x * h0 + e[i].x; h1 = p[i].y * h1 + e[i].y; }
    }
}
__device__ __forceinline__ void ph_rgscan_c(const Ctx& F, const bf16* OM0, const bf16* OM1, bf16* BT0, const bf16* BT1, const float* RGE, const float* RGP, bf16* Y, const bf16* OMC) {
    for (int it = F.wave * F.G + F.bid; it < NB * TPB * 8; it += F.NGW) {
        const int cg = it & 7, ti = (it >> 3) % TPB, b = (it >> 3) / TPB, ch = cg * 128 + 2 * F.lane;
        const size_t rb = (size_t)b * SEQL + 256 * ti;
        float h0, h1;
        rg_carry(RGE, RGP, ((size_t)(b * 2 + 0) * TPB) * 1024 + ch, ti, h0, h1);
        {
            const bf16* OM = (ti == 0 ? OMC + (size_t)b * 256 * 1024 : OM0 + rb * 1024) + ch; bf16* BT = BT0 + rb * 1024 + ch;
            unsigned ow[16], bw[16], on[16], bn[16];
#pragma unroll
            for (int e = 0; e < 16; ++e) { ow[e] = *(const unsigned*)(OM + (size_t)e * 1024); bw[e] = *(const unsigned*)(BT + (size_t)e * 1024); }
#pragma unroll 1
            for (int t = 0; t < 256; t += 16) {
                const int tn = t + 16 < 256 ? t + 16 : t;
#pragma unroll
                for (int e = 0; e < 16; ++e) { on[e] = *(const unsigned*)(OM + (size_t)(tn + e) * 1024); bn[e] = *(const unsigned*)(BT + (size_t)(tn + e) * 1024); }
#pragma unroll
                for (int e = 0; e < 16; ++e) {
                    h0 = (1.f - bf2f(ow[e] & 0xffffu)) * h0 + bf2f(bw[e] & 0xffffu); h1 = (1.f - bf2f(ow[e] >> 16)) * h1 + bf2f(bw[e] >> 16);
                    *(unsigned*)(BT + (size_t)(t + e) * 1024) = pk2(h0, h1); }
#pragma unroll
                for (int e = 0; e < 16; ++e) { ow[e] = on[e]; bw[e] = bn[e]; }
            }
        }
        const int kb = ti == 0 ? 0 : TPB - ti;
        rg_carry(RGE, RGP, ((size_t)(b * 2 + 1) * TPB) * 1024 + ch, kb, h0, h1);
        {
            const bf16* OM = OM1 + (rb + 255) * 1024 + ch; const bf16* BT = BT1 + (rb + 255) * 1024 + ch; const bf16* HF = BT0 + (rb + 255) * 1024 + ch; bf16* YR = Y + (rb + 255) * 2048 + 1024 + ch;
            unsigned ow[16], bw[16], hw[16], gw_[16], on[16], bn[16], hn[16], gn[16];
#define RGC_LD(t_, O, B, H, G) _Pragma("unroll") for (int e = 0; e < 16; ++e) { const long ro_ = -(long)((t_) + e); O[e] = *(const unsigned*)(OM + ro_ * 1024); B[e] = *(const unsigned*)(BT + ro_ * 1024); \
                H[e] = __hip_atomic_load((const unsigned*)(HF + ro_ * 1024), __ATOMIC_RELAXED, __HIP_MEMORY_SCOPE_AGENT); G[e] = *(const unsigned*)(YR + ro_ * 2048); }
            RGC_LD(0, ow, bw, hw, gw_)
#pragma unroll 1
            for (int t = 0; t < 256; t += 16) {
                const int tn = t + 16 < 256 ? t + 16 : t;
                RGC_LD(tn, on, bn, hn, gn)
#pragma unroll
                for (int e = 0; e < 16; ++e) {
                    h0 = (1.f - bf2f(ow[e] & 0xffffu)) * h0 + bf2f(bw[e] & 0xffffu); h1 = (1.f - bf2f(ow[e] >> 16)) * h1 + bf2f(bw[e] >> 16);
                    const float o0 = (bf2f(hw[e] & 0xffffu) + h0) * silu(bf2f(gw_[e] & 0xffffu)), o1 = (bf2f(hw[e] >> 16) + h1) * silu(bf2f(gw_[e] >> 16));
                    *(unsigned*)(YR - (long)(t + e) * 2048) = pk2(o0, o1); }
#pragma unroll
                for (int e = 0; e < 16; ++e) { ow[e] = on[e]; bw[e] = bn[e]; hw[e] = hn[e]; gw_[e] = gn[e]; }
            }
#undef RGC_LD
        }
    }
}

typedef __bf16 v2bf __attribute__((ext_vector_type(2)));
__device__ __forceinline__ float dot2bf(const unsigned a, const unsigned b, const float c) { return __builtin_amdgcn_fdot2_f32_bf16(__builtin_bit_cast(v2bf, a), __builtin_bit_cast(v2bf, b), c, false); }
__device__ __forceinline__ void ph_convq(const Ctx& F, int j, int hb, const bf16* XM, bf16* XCV, bf16* QP) {
    constexpr int NT = MH / 16, NTX = NT / 8;
    const bool xmap = (F.G & 7) == 0;
    const int xq = F.bid & 7, cu = F.bid >> 3, cpx = F.G >> 3;
    int ntile = xmap ? (NTX - cu + cpx - 1) / cpx : (NT - F.bid + F.G - 1) / F.G; ntile = ntile < 0 ? 0 : ntile;
#define CQ_TILE(slot_) (xmap ? 4 * (cu + cpx * (slot_) + NTX * (xq >> 2)) + (xq & 3) : F.bid + F.G * (slot_))
    const float* cw = F.in(I_MLCW) + (size_t)j * 4 * 2048; const float* cb = F.in(I_MLCB) + (size_t)j * 2048;
    const float* mg = (const float*)(F.ws + WS_MG);
    const float* bif = F.in(I_MLBIF) + (size_t)j * 16;
    float* gate = (float*)(F.ws + WS_GATE);
    const int nrows = 2 * ntile;
    {
        LAS f32x4* const WQ = (LAS f32x4*)F.lds;
        for (int i = F.tid; i < 4 * 18 * 64; i += NTHR) { const int ln = i & 63, q = (i >> 6) % 18, k = i / (18 * 64), c = 8 * ln + 512 * k;
            const float* src = q < 8 ? cw + (q >> 1) * 2048 + c + 4 * (q & 1) : (q < 10 ? cb + c + 4 * (q - 8) : mg + (size_t)((c >> 2) + ((q - 10) >> 2)) * 16 + 4 * ((q - 10) & 3));
            WQ[i] = *(const f32x4*)src; }
        __syncthreads();
        u32x4 cur[4][4]; float ma[4], mn[4]; int nrw[4];
#define CQ_NEXT(n_) do { const int nn_ = (n_); const int rl_ = CQ_TILE(nn_ >> 1) * 16 + 2 * F.wave + (nn_ & 1); const int r_ = hb * MH + rl_, b_ = r_ / SEQL, s2_ = r_ - b_ * SEQL; \
            _Pragma("unroll") for (int t = 0; t < 4; ++t) { const int sn = nb_odd(s2_, t - 1); const bool ok = sn >= 0; nrw[t] = ok ? (b_ * SEQL + sn - hb * MH) : rl_; mn[t] = ok ? 1.f : 0.f; } } while (0)
        if (nrows > 0) { CQ_NEXT(0);
#pragma unroll
            for (int k = 0; k < 4; ++k)
#pragma unroll
                for (int t = 0; t < 4; ++t) cur[k][t] = *(const u32x4*)(XM + (size_t)nrw[t] * 2048 + 8 * F.lane + 512 * k); }
#pragma unroll 1
        for (int n = 0; n < nrows; ++n) {
#pragma unroll
            for (int t = 0; t < 4; ++t) ma[t] = mn[t];
            const int rl = CQ_TILE(n >> 1) * 16 + 2 * F.wave + (n & 1);
            CQ_NEXT(n + 1 < nrows ? n + 1 : n);
#pragma unroll
            for (int k = 0; k < 4; ++k) {
                const int c = 8 * F.lane + 512 * k;
                const LAS f32x4* wl = WQ + (k * 18) * 64 + F.lane;
                float a[8];
                { const f32x4 b0 = wl[8 * 64], b1 = wl[9 * 64]; a[0] = b0.x; a[1] = b0.y; a[2] = b0.z; a[3] = b0.w; a[4] = b1.x; a[5] = b1.y; a[6] = b1.z; a[7] = b1.w; }
#pragma unroll
                for (int t = 0; t < 4; ++t) { float x[8]; unpack8(cur[k][t], x); const f32x4 w0 = wl[(2 * t) * 64], w1 = wl[(2 * t + 1) * 64];
                    a[0] += w0.x * (ma[t] * x[0]); a[1] += w0.y * (ma[t] * x[1]); a[2] += w0.z * (ma[t] * x[2]); a[3] += w0.w * (ma[t] * x[3]);
                    a[4] += w1.x * (ma[t] * x[4]); a[5] += w1.y * (ma[t] * x[5]); a[6] += w1.z * (ma[t] * x[6]); a[7] += w1.w * (ma[t] * x[7]); }
#pragma unroll
                for (int e = 0; e < 8; ++e) a[e] = silu(a[e]);
                *(u32x4*)(XCV + (size_t)rl * 2048 + c) = pack8(a);
                float qv[8];
#pragma unroll
                for (int blk = 0; blk < 2; ++blk) { const f32x4 m0 = wl[(10 + blk * 4 + 0) * 64], m1 = wl[(10 + blk * 4 + 1) * 64], m2 = wl[(10 + blk * 4 + 2) * 64], m3 = wl[(10 + blk * 4 + 3) * 64];
#pragma unroll
                    for (int jj = 0; jj < 4; ++jj) qv[blk * 4 + jj] = a[blk * 4 + 0] * m0[jj] + a[blk * 4 + 1] * m1[jj] + a[blk * 4 + 2] * m2[jj] + a[blk * 4 + 3] * m3[jj]; }
                { const int half = (c >> 3) & 1; bf16* qb = QP + (size_t)rl * 2048 + (c & ~15) + 4 * half;
                  u32x2 w0, w1; w0.x = pk2(qv[0], qv[1]); w0.y = pk2(qv[2], qv[3]); w1.x = pk2(qv[4], qv[5]); w1.y = pk2(qv[6], qv[7]);
                  *(u32x2*)qb = w0; *(u32x2*)(qb + 8) = w1; }
#pragma unroll
                for (int t = 0; t < 4; ++t) cur[k][t] = *(const u32x4*)(XM + (size_t)nrw[t] * 2048 + c);
                __builtin_amdgcn_sched_barrier(0);
            }
        }
#undef CQ_NEXT
    }
    __builtin_amdgcn_fence(__ATOMIC_RELEASE, "workgroup");
    asm volatile("s_waitcnt vmcnt(0)" ::: "memory");
    __syncthreads();
    __builtin_amdgcn_fence(__ATOMIC_ACQUIRE, "workgroup");
    {
        const int w = F.wave; const bf16* SRC = (w >> 2) ? XM : XCV;
        const u32x4* tb = (const u32x4*)(F.ws + WS_WGT) + (size_t)(w * 16) * 64 + F.lane;
        bf16x8 bfr[16];
#pragma unroll
        for (int st = 0; st < 16; ++st) bfr[st] = __builtin_bit_cast(bf16x8, tb[st * 64]);
        const bf16* cbase = SRC + (size_t)(F.lane & 15) * 2048 + (w & 3) * 512 + (F.lane >> 4) * 32;
        LAS f32x4* part = (LAS f32x4*)F.lds;
        bf16x8 cur[16], nxt[16];
#define CQ_LOADT(slot_, AV) do { const bf16* rp_ = cbase + (size_t)CQ_TILE(slot_) * 16 * 2048; \
            _Pragma("unroll") for (int st = 0; st < 16; ++st) AV[st] = *(const bf16x8*)(rp_ + (st >> 2) * 128 + (st & 3) * 8); } while (0)
        if (ntile > 0) CQ_LOADT(0, cur);
#pragma unroll 1
        for (int slot = 0; slot < ntile; ++slot) {
            { const int sn = slot + 1 < ntile ? slot + 1 : ntile - 1; CQ_LOADT(sn, nxt); }
            f32x4 acc = (f32x4){0.f, 0.f, 0.f, 0.f};
#pragma unroll
            for (int st = 0; st < 16; ++st) acc = __builtin_amdgcn_mfma_f32_16x16x32_bf16(cur[st], bfr[st], acc, 0, 0, 0);
            part[(slot * 8 + w) * 64 + F.lane] = acc;
#pragma unroll
            for (int st = 0; st < 16; ++st) cur[st] = nxt[st];
        }
#undef CQ_LOADT
        __syncthreads();
        for (int idx = F.tid; idx < ntile * 256; idx += NTHR) { const int slot = idx >> 8, o = idx & 255, ln = o & 63, i = o >> 6;
            float v = 0.f;
#pragma unroll
            for (int ww = 0; ww < 8; ++ww) v += ((const LAS float*)part)[((slot * 8 + ww) * 64 + ln) * 4 + i];
            const int n = ln & 15, m = 4 * (ln >> 4) + i, r = hb * MH + CQ_TILE(slot) * 16 + m, d = n >> 3, n8 = n & 7;
            v += bif[n];
            gate[((size_t)d * M + r) * 8 + n8] = n8 >= 4 ? logsigmoid(v) : v; }
    }
#undef CQ_TILE
    __syncthreads();
}

__device__ __forceinline__ void odd_chunk_rows(const int ck, const int d, int& rb, int& rs) {
    if (ck < LCTX / 64) { rb = d == 0 ? ck * 64 : LCTX - 1 - ck * 64; rs = d == 0 ? 1 : -1; }
    else { const int q0 = ck * 64 - LCTX, lo = q0 & 127, hi = q0 >> 7;
        if (d == 0) { rb = LCTX + lo * 64 + hi; rs = 64; } else { rb = LCTX + (127 - lo) * 64 + 63 - hi; rs = -64; } }
}
__device__ __forceinline__ void ph_mscan(const Ctx& F, int hb) {
    if (F.bid >= 16) return;
    const int sq = F.bid, b = hb * 2 + (sq >> 3), n = (sq >> 1) & 3, d = sq & 1;
    const float* gate = (const float*)(F.ws + WS_GATE) + (size_t)d * M * 8;
    LAS float* be = (LAS float*)F.lds; LAS float* um = be + 192; LAS float* ms = um + 192;
    const int ck = F.tid; const bool act = ck < NCH;
    float li[64], lf[64];
    if (act) {
        int rb, rs; odd_chunk_rows(ck, d, rb, rs);
        const float* gp = gate + ((size_t)b * SEQL + rb) * 8 + n; const long gs = (long)rs * 8;
#pragma unroll
        for (int e = 0; e < 64; ++e) { li[e] = gp[e * gs]; lf[e] = gp[e * gs + 4]; }
        float bs = 0.f, umax = -3.0e38f;
#pragma unroll
        for (int e = 0; e < 64; ++e) { bs += lf[e]; umax = fmaxf(umax, li[e] - bs); }
        be[ck] = bs; um[ck] = umax;
    }
    __syncthreads();
    if (F.tid == 0) { float m = 0.f;
#pragma unroll
        for (int c4 = 0; c4 < NCH; c4 += 4) { const f32x4 b4 = *(const LAS f32x4*)(be + c4), u4 = *(const LAS f32x4*)(um + c4); f32x4 m4;
            m4.x = m; m = b4.x + fmaxf(m, u4.x); m4.y = m; m = b4.y + fmaxf(m, u4.y); m4.z = m; m = b4.z + fmaxf(m, u4.z); m4.w = m; m = b4.w + fmaxf(m, u4.w);
            *(LAS f32x4*)(ms + c4) = m4; } }
    __syncthreads();
    LAS f32x4* stg = (LAS f32x4*)(F.lds + 4096);
    float* ps = (float*)(F.ws + WS_PS) + (size_t)sq * SEQL * 4;
    if (act) {
        float* pc = (float*)(F.ws + WS_PC) + (size_t)sq * NCH * 4;
        const float m = ms[ck]; float bs = 0.f, cm = m, mt = 0.f;
#pragma unroll
        for (int e = 0; e < 64; ++e) { bs += lf[e]; const float u = li[e] - bs; cm = fmaxf(cm, u); mt = bs + cm;
            stg[ck * 65 + e] = (f32x4){bs - mt, u, __expf(m - cm), mt}; }
        *(f32x4*)(pc + (size_t)ck * 4) = (f32x4){bs, mt, __expf(bs + m - mt), m};
    }
    __syncthreads();
    for (int p = F.tid; p < SEQL; p += NTHR) *(f32x4*)(ps + (size_t)p * 4) = stg[(p >> 6) * 65 + (p & 63)];
    __syncthreads();
}

__device__ __forceinline__ void ph_stilde(const Ctx& F, int hb, const bf16* QP, const bf16* XCV) {
    constexpr int LDR = 520;
    LAS bf16* ql = (LAS bf16*)F.lds; LAS bf16* kl = ql + 64 * LDR;
    LAS float* red = (LAS float*)(kl + 64 * LDR);
    LAS float* rsum = red + 4 * 16 * 64;
    LAS float* cwl = rsum + 128;
    bf16* DN = (bf16*)(F.ws + WS_DN);
    const float* PC = (const float*)(F.ws + WS_PC);
    bf16* ST = (bf16*)(F.ws + WS_ST); float* DS = (float*)(F.ws + WS_DS); const float* PS = (const float*)(F.ws + WS_PS);
    const int lane = F.lane, w = F.wave, r = lane & 31, h = lane >> 5;
    const int tile = w & 3, st = tile & 1, tt = tile >> 1, kh = w >> 2;
    u32x4 qg[8], kg[8]; float pc0n = 0.f, pc1n = 0.f, psn = 0.f;
#define ST_SQ(it_) ((((it_) >> 2) & 1) * 8 + ((it_) & 3) * 2 + (((it_) >> 3) & 1))
#define ST_CK(it_) (((((it_) >> 3) & 1) == 0) ? ((it_) >> 4) : (((it_) >> 4) < LCTX / 64 ? LCTX / 64 - 1 - ((it_) >> 4) : NCH + LCTX / 64 - 1 - ((it_) >> 4)))
#define ST_LOAD(it_) do { const int sq_ = ST_SQ(it_), ck_ = ST_CK(it_); int rb_, rs_; odd_chunk_rows(ck_, sq_ & 1, rb_, rs_); \
        const size_t o_ = (size_t)((sq_ >> 3) * SEQL + rb_ + w * rs_) * 2048 + ((sq_ >> 1) & 3) * 512 + 8 * lane; const long st_ = (long)rs_ * (8 * 2048); \
        _Pragma("unroll") for (int k_ = 0; k_ < 8; ++k_) { qg[k_] = *(const u32x4*)(QP + o_ + k_ * st_); kg[k_] = *(const u32x4*)(XCV + o_ + k_ * st_); } \
        if (w == 0) { const float* pcq_ = PC + ((size_t)sq_ * NCH + ck_) * 4; pc0n = pcq_[0]; pc1n = pcq_[1]; psn = PS[((size_t)sq_ * SEQL + ck_ * 64 + lane) * 4 + 1]; } } while (0)
    if (F.bid < 16 * NCH) ST_LOAD(F.bid);
    for (int it = F.bid; it < 16 * NCH; it += F.G) {
        const int sq = ST_SQ(it), ck = ST_CK(it);
        __syncthreads();
        { const int c8 = 8 * lane, hq = (c8 >> 3) & 1, g16 = c8 & ~15;
#pragma unroll
          for (int k_ = 0; k_ < 8; ++k_) { const int t = w + 8 * k_; u32x2 lo, hi; lo.x = qg[k_].x; lo.y = qg[k_].y; hi.x = qg[k_].z; hi.y = qg[k_].w;
              *(LAS u32x2*)(ql + t * LDR + g16 + 4 * hq) = lo; *(LAS u32x2*)(ql + t * LDR + g16 + 8 + 4 * hq) = hi;
              *(LAS u32x4*)(kl + t * LDR + c8) = kg[k_]; } }
        if (w == 0) cwl[lane] = __expf(pc0n + psn - pc1n);
        __syncthreads();
        const float* psq = PS + ((size_t)sq * SEQL + ck * 64) * 4;
        const int t = 32 * tt + r; const float am = psq[t * 4 + 0];
        float us[16];
#pragma unroll
        for (int j = 0; j < 16; ++j) us[j] = psq[(32 * st + 8 * (j >> 2) + 4 * h + (j & 3)) * 4 + 1];
        if (it + F.G < 16 * NCH) ST_LOAD(it + F.G);
        f32x16s acc;
#pragma unroll
        for (int j = 0; j < 16; ++j) acc[j] = 0.f;
        { const LAS bf16* ka = kl + (32 * st + r) * LDR + 256 * kh + 8 * h; const LAS bf16* qb = ql + (32 * tt + r) * LDR + 256 * kh + 8 * h;
#pragma unroll
          for (int ks = 0; ks < 16; ++ks) acc = __builtin_amdgcn_mfma_f32_32x32x16_bf16(*(const LAS bf16x8*)(ka + 16 * ks), *(const LAS bf16x8*)(qb + 16 * ks), acc, 0, 0, 0); }
        if (kh == 1) {
#pragma unroll
            for (int j = 0; j < 16; ++j) red[(tile * 16 + j) * 64 + lane] = acc[j]; }
        __syncthreads();
        if (kh == 0) {
            float rs = 0.f;
#pragma unroll
            for (int q4 = 0; q4 < 4; ++q4) { float o[4];
#pragma unroll
                for (int i = 0; i < 4; ++i) { const int j = 4 * q4 + i, s_ = 32 * st + 8 * q4 + 4 * h + i; const float v = acc[j] + red[(tile * 16 + j) * 64 + lane];
                    o[i] = s_ <= t ? v * __expf(am + us[j]) : 0.f; rs += o[i]; }
                u32x2 ow; ow.x = pk2(o[0], o[1]); ow.y = pk2(o[2], o[3]);
                *(u32x2*)(ST + ((size_t)(sq * NCH + ck) * 64 + t) * 64 + 32 * st + 8 * q4 + 4 * h) = ow; }
            rs += xhalf(rs, h);
            if (h == 0) rsum[st * 64 + t] = rs;
        } else {
            const int d2 = 2 * (F.tid - 256); float dn0 = 0.f, dn1 = 0.f;
#pragma unroll 4
            for (int s4 = 0; s4 < 64; s4 += 4) { const f32x4 c4 = *(const LAS f32x4*)(cwl + s4);
#pragma unroll
                for (int i = 0; i < 4; ++i) { const unsigned kk = *(const LAS unsigned*)(kl + (s4 + i) * LDR + d2); dn0 += c4[i] * bf2f(kk & 0xffffu); dn1 += c4[i] * bf2f(kk >> 16); } }
            *(unsigned*)(DN + ((size_t)sq * NCH + ck) * 512 + d2) = pk2(dn0, dn1); }
        __syncthreads();
        if (F.tid < 64) DS[(size_t)sq * SEQL + ck * 64 + F.tid] = rsum[F.tid] + rsum[64 + F.tid];
    }
#undef ST_LOAD
#undef ST_SQ
#undef ST_CK
    __syncthreads();
}

typedef float f32x16 __attribute__((ext_vector_type(16)));
__device__ __forceinline__ bf16x8 pack_bf16x8(const f32x16& c, const int o) {
    u32x4 w; w.x = pg8::cvt_pk_bf16(c[o], c[o + 1]); w.y = pg8::cvt_pk_bf16(c[o + 2], c[o + 3]); w.z = pg8::cvt_pk_bf16(c[o + 4], c[o + 5]); w.w = pg8::cvt_pk_bf16(c[o + 6], c[o + 7]);
    return __builtin_bit_cast(bf16x8, w);
}
__device__ __forceinline__ void ph_mlstm_r(const Ctx& F, int hb, const bf16* QP, const bf16* XCV, const bf16* XM, bf16* HM0, int ld0, bf16* HM1, int ld1) {
    constexpr int RV = 128, RS = 144;
    LAS unsigned char* const VT = F.lds;
    LAS unsigned char* const VW = VT + 32 * RV;
    LAS unsigned char* const SB = VW + 32 * RV;
    LAS float* const QNP = (LAS float*)(SB + 64 * RS);
    LAS float* const SCL = QNP + 64 * 16;
    LAS unsigned* const NSB = (LAS unsigned*)(SCL + 384);
    LAS unsigned char* const KR = (LAS unsigned char*)(NSB + 256);
    LAS float* const PART = (LAS float*)(KR + 8 * 8192);
    const bf16* ST = (const bf16*)(F.ws + WS_ST); const float* DS = (const float*)(F.ws + WS_DS); const float* PS = (const float*)(F.ws + WS_PS); const float* PC = (const float*)(F.ws + WS_PC);
    const bf16* DN = (const bf16*)(F.ws + WS_DN);
    const int tid = F.tid, lane = F.lane, w = F.wave, r = lane & 31, h = lane >> 5;
#define R_BAR() do { asm volatile("s_waitcnt lgkmcnt(0)" ::: "memory"); __builtin_amdgcn_s_barrier(); asm volatile("" ::: "memory"); } while (0)
    for (int it0 = F.bid; it0 < 256; it0 += F.G) {
        const int it = (F.G == 256) ? (((it0 & 7) * 2 + ((it0 >> 3) >> 4)) * 16 + ((it0 >> 3) & 15)) : it0;
        const int sq = it >> 4, eb = it & 15, bh = sq >> 3, n = (sq >> 1) & 3, d = sq & 1;
        bf16* HM = d ? HM1 : HM0; const int ldh = d ? ld1 : ld0;
        const int colv = n * 512 + eb * 32;
        f32x16 C0, C1;
#pragma unroll
        for (int j = 0; j < 16; ++j) { C0[j] = 0.f; C1[j] = 0.f; }
        float nreg = 0.f, dec_cur = 0.f;
        u32x4 kreg[8]; u32x2 vreg; u32x4 sreg; bf16x8 Qf[8]; f32x4 pvn, pcn; float dsn, dnv;
        int rbn, rsn, rowtn, rbk, rsk;
#define R_PREFETCH_K(ck_) do { const bf16* kb_ = XCV + (size_t)(bh * SEQL + rbk + (lane >> 3) * rsk) * 2048 + n * 512 + 64 * w + 8 * (lane & 7); const long ks_ = (long)rsk * (8 * 2048); \
            _Pragma("unroll") for (int k_ = 0; k_ < 8; ++k_) kreg[k_] = *(const u32x4*)(kb_ + k_ * ks_); } while (0)
#define R_KWRITE() do { LAS unsigned char* kp0_ = KR + w * 8192 + (lane >> 3) * 128 + (((lane & 7) ^ (((lane >> 4) & 1) << 2)) * 16); asm volatile("" : "+v"(kp0_)); \
            _Pragma("unroll") for (int k_ = 0; k_ < 8; ++k_) *(LAS u32x4*)(kp0_ + k_ * 1024) = kreg[k_]; } while (0)
#define R_PREFETCH_VS(ck_) do { const int p0_ = (ck_) * 64; rowtn = bh * SEQL + rbn + (tid >> 3) * rsn; \
            const size_t rv_ = (size_t)rowtn * 2048; vreg = *(const u32x2*)(XM + rv_ + colv + (tid & 7) * 4); \
            sreg = *(const u32x4*)(ST + ((size_t)(sq * NCH + (ck_))) * 4096 + (size_t)tid * 8); \
            pvn = *(const f32x4*)(PS + ((size_t)sq * SEQL + p0_ + (tid >> 3)) * 4); dsn = DS[(size_t)sq * SEQL + p0_ + (tid >> 3)]; dnv = bf2f(DN[((size_t)sq * NCH + (ck_)) * 512 + tid]); pcn = *(const f32x4*)(PC + ((size_t)sq * NCH + (ck_)) * 4); } while (0)
#define R_PREFETCH_Q(ck_) do { const bf16* qb_ = QP + (size_t)(bh * SEQL + rbn + (lane >> 3) * rsn) * 2048 + n * 512 + 64 * w + 8 * (lane & 7); const long qs_ = (long)rsn * (8 * 2048); \
            _Pragma("unroll") for (int k_ = 0; k_ < 8; ++k_) Qf[k_] = *(const bf16x8*)(qb_ + k_ * qs_); } while (0)
#define R_QSTAGE() do { LAS unsigned char* qe_ = (LAS unsigned char*)PART + w * 8192 + (lane >> 3) * 128 + (((lane & 7) ^ (lane >> 4)) * 16); LAS unsigned char* qo_ = (LAS unsigned char*)PART + w * 8192 + (lane >> 3) * 128 + (((lane & 7) ^ (lane >> 4) ^ 4) * 16); asm volatile("" : "+v"(qe_), "+v"(qo_)); \
            _Pragma("unroll") for (int k_ = 0; k_ < 8; ++k_) *(LAS bf16x8*)(((k_ & 1) ? qo_ : qe_) + k_ * 1024) = Qf[k_]; \
            const int p0_ = h ^ ((r >> 1) & 7); LAS unsigned char* qr_ = (LAS unsigned char*)PART + w * 8192 + r * 128; \
            _Pragma("unroll") for (int tt_ = 0; tt_ < 2; ++tt_) _Pragma("unroll") for (int i_ = 0; i_ < 2; ++i_) _Pragma("unroll") for (int s_ = 0; s_ < 2; ++s_) \
                Qf[(tt_ * 2 + i_) * 2 + s_] = *(const LAS bf16x8*)(qr_ + tt_ * 4096 + ((p0_ ^ (4 * i_ + 2 * s_)) << 4)); } while (0)
#define R_STAGE(ck_) do { const f32x4 pc_ = pcn; asm volatile("" :: "v"(pc_.w), "v"(pvn.x));     \
            ((LAS bf16*)NSB)[tid] = (bf16)f2bf(nreg); nreg = pc_.z * nreg + dnv; dec_cur = pc_.z; \
            const int s_ = tid >> 3, e4_ = (tid & 7) * 4; const float cw_ = __expf(pc_.x + pvn.y - pc_.y); \
            if ((tid & 7) == 0) { LAS float* sc_ = SCL + ((ck_) & 1) * 192; sc_[s_] = pvn.z; sc_[64 + s_] = __expf(-pvn.w); sc_[128 + s_] = dsn; } \
            *(LAS u32x4*)(SB + s_ * RS + (tid & 7) * 16) = sreg; \
            const float v0_ = bf2f(vreg.x & 0xffffu), v1_ = bf2f(vreg.x >> 16), v2_ = bf2f(vreg.y & 0xffffu), v3_ = bf2f(vreg.y >> 16); (void)e4_; \
            *(LAS u32x2*)(VT + s_ * 64 + (tid & 7) * 8) = vreg; \
            { u32x2 wv_; wv_.x = pk2(cw_ * v0_, cw_ * v1_); wv_.y = pk2(cw_ * v2_, cw_ * v3_); *(LAS u32x2*)(VW + s_ * 64 + (tid & 7) * 8) = wv_; } } while (0)
        odd_chunk_rows(0, d, rbn, rsn); rbk = rbn; rsk = rsn;
        R_PREFETCH_K(0); R_PREFETCH_VS(0); R_PREFETCH_Q(0);
        __syncthreads();
        R_KWRITE(); odd_chunk_rows(1, d, rbk, rsk); R_PREFETCH_K(1);
        R_STAGE(0);
        for (int ck = 0; ck < NCH; ++ck) {
            const float decay = dec_cur;
            int vlo = (8 * h + ((lane & 15) >> 2)) * 64 + (16 * ((lane >> 4) & 1) + 4 * (lane & 3)) * 2; asm volatile("" : "+v"(vlo));
            const int rowt = rowtn;
            const LAS float* const scl = SCL + (ck & 1) * 192;
            if (ck + 1 < NCH) odd_chunk_rows(ck + 1, d, rbn, rsn);
            if (ck + 2 < NCH) odd_chunk_rows(ck + 2, d, rbk, rsk);
            R_BAR();
            R_QSTAGE();
            s16x4 kf[16];
            {
                const int swz = (lane >> 3) & 1;
                const LAS unsigned char* krb = KR + w * 8192 + (8 * h + ((lane & 15) >> 2)) * 128 + (8 * swz + 4 * ((lane >> 4) & 1) + (lane & 3)) * 8;
                const LAS unsigned char* krc = krb + 64 - 128 * swz; asm volatile("" : "+v"(krb), "+v"(krc));
#pragma unroll
                for (int ks = 0; ks < 4; ++ks) {
                    kf[4 * ks + 0] = __builtin_amdgcn_ds_read_tr16_b64_v4i16((LAS s16x4*)(krb + (16 * ks) * 128)); kf[4 * ks + 1] = __builtin_amdgcn_ds_read_tr16_b64_v4i16((LAS s16x4*)(krb + (16 * ks + 4) * 128));
                    kf[4 * ks + 2] = __builtin_amdgcn_ds_read_tr16_b64_v4i16((LAS s16x4*)(krc + (16 * ks) * 128)); kf[4 * ks + 3] = __builtin_amdgcn_ds_read_tr16_b64_v4i16((LAS s16x4*)(krc + (16 * ks + 4) * 128)); }
            }
            __builtin_amdgcn_sched_barrier(0);
            if (ck + 1 < NCH) R_KWRITE();
            __builtin_amdgcn_sched_barrier(0);
            f32x16 P0, P1;
#pragma unroll
            for (int j = 0; j < 16; ++j) { P0[j] = 0.f; P1[j] = 0.f; }
            { const bf16x8 c00 = pack_bf16x8(C0, 0), c01 = pack_bf16x8(C0, 8), c10 = pack_bf16x8(C1, 0), c11 = pack_bf16x8(C1, 8);
              P0 = __builtin_amdgcn_mfma_f32_32x32x16_bf16(Qf[0], c00, P0, 0, 0, 0); P1 = __builtin_amdgcn_mfma_f32_32x32x16_bf16(Qf[4], c00, P1, 0, 0, 0);
              P0 = __builtin_amdgcn_mfma_f32_32x32x16_bf16(Qf[1], c01, P0, 0, 0, 0); P1 = __builtin_amdgcn_mfma_f32_32x32x16_bf16(Qf[5], c01, P1, 0, 0, 0);
              P0 = __builtin_amdgcn_mfma_f32_32x32x16_bf16(Qf[2], c10, P0, 0, 0, 0); P1 = __builtin_amdgcn_mfma_f32_32x32x16_bf16(Qf[6], c10, P1, 0, 0, 0);
              P0 = __builtin_amdgcn_mfma_f32_32x32x16_bf16(Qf[3], c11, P0, 0, 0, 0); P1 = __builtin_amdgcn_mfma_f32_32x32x16_bf16(Qf[7], c11, P1, 0, 0, 0); }
            __builtin_amdgcn_sched_barrier(0);
            {
                const LAS unsigned char* vwb = VT + vlo + 32 * RV;
#pragma unroll
                for (int j = 0; j < 16; ++j) { C0[j] *= decay; C1[j] *= decay; }
#pragma unroll
                for (int kh = 0; kh < 2; ++kh) {
                    bf16x8 vw2[2];
#pragma unroll
                    for (int k2 = 0; k2 < 2; ++k2) { const int ks = 2 * kh + k2;
                        const s16x4 f0 = __builtin_amdgcn_ds_read_tr16_b64_v4i16((LAS s16x4*)(vwb + (16 * ks) * 64)), f1 = __builtin_amdgcn_ds_read_tr16_b64_v4i16((LAS s16x4*)(vwb + (16 * ks + 4) * 64));
                        vw2[k2] = (bf16x8){f0.x, f0.y, f0.z, f0.w, f1.x, f1.y, f1.z, f1.w}; }
#pragma unroll
                    for (int k2 = 0; k2 < 2; ++k2) { const int ks = 2 * kh + k2;
                        const bf16x8 ka0 = (bf16x8){kf[4 * ks].x, kf[4 * ks].y, kf[4 * ks].z, kf[4 * ks].w, kf[4 * ks + 1].x, kf[4 * ks + 1].y, kf[4 * ks + 1].z, kf[4 * ks + 1].w};
                        const bf16x8 ka1 = (bf16x8){kf[4 * ks + 2].x, kf[4 * ks + 2].y, kf[4 * ks + 2].z, kf[4 * ks + 2].w, kf[4 * ks + 3].x, kf[4 * ks + 3].y, kf[4 * ks + 3].z, kf[4 * ks + 3].w};
                        C0 = __builtin_amdgcn_mfma_f32_32x32x16_bf16(ka0, vw2[k2], C0, 0, 0, 0); C1 = __builtin_amdgcn_mfma_f32_32x32x16_bf16(ka1, vw2[k2], C1, 0, 0, 0); }
                    __builtin_amdgcn_sched_barrier(0);
                }
            }
            __builtin_amdgcn_sched_barrier(0);
            u32x2 nsa[4], nsb[4];
#pragma unroll
            for (int i = 0; i < 2; ++i)
#pragma unroll
                for (int sx = 0; sx < 2; ++sx) { const int db = 64 * w + 32 * i + 16 * sx + 4 * h; nsa[i * 2 + sx] = *(const LAS u32x2*)(NSB + (db >> 1)); nsb[i * 2 + sx] = *(const LAS u32x2*)(NSB + ((db + 8) >> 1)); }
            if (ck + 2 < NCH) R_PREFETCH_K(ck + 2);
            if (ck + 1 < NCH) R_PREFETCH_VS(ck + 1);
            __builtin_amdgcn_sched_barrier(0);
            {
                float qn0 = 0.f, qn1 = 0.f;
#pragma unroll
                for (int i = 0; i < 2; ++i)
#pragma unroll
                    for (int sx = 0; sx < 2; ++sx) { const u32x2 na = nsa[i * 2 + sx], nb = nsb[i * 2 + sx];
                        const u32x4 qa = __builtin_bit_cast(u32x4, Qf[i * 2 + sx]), qb = __builtin_bit_cast(u32x4, Qf[4 + i * 2 + sx]);
                        qn0 = dot2bf(qa.x, na.x, qn0); qn0 = dot2bf(qa.y, na.y, qn0); qn0 = dot2bf(qa.z, nb.x, qn0); qn0 = dot2bf(qa.w, nb.y, qn0);
                        qn1 = dot2bf(qb.x, na.x, qn1); qn1 = dot2bf(qb.y, na.y, qn1); qn1 = dot2bf(qb.z, nb.x, qn1); qn1 = dot2bf(qb.w, nb.y, qn1); }
                qn0 += xhalf(qn0, h); qn1 += xhalf(qn1, h);
                if (h == 0) { QNP[w * 64 + r] = qn0; QNP[w * 64 + 32 + r] = qn1; }
                __builtin_amdgcn_sched_barrier(0);
                if (ck + 1 < NCH) R_PREFETCH_Q(ck + 1);
#pragma unroll
                for (int q4 = 0; q4 < 4; ++q4) { const f32x4 s0 = *(const LAS f32x4*)(scl + 8 * q4 + 4 * h), s1 = *(const LAS f32x4*)(scl + 32 + 8 * q4 + 4 * h);
                    P0[4 * q4] *= s0.x; P0[4 * q4 + 1] *= s0.y; P0[4 * q4 + 2] *= s0.z; P0[4 * q4 + 3] *= s0.w;
                    P1[4 * q4] *= s1.x; P1[4 * q4 + 1] *= s1.y; P1[4 * q4 + 2] *= s1.z; P1[4 * q4 + 3] *= s1.w; }
                if (w < 4) { const LAS unsigned char* vtb = VT + vlo + 16 * 64 * w;
                    const s16x4 f0 = __builtin_amdgcn_ds_read_tr16_b64_v4i16((LAS s16x4*)vtb), f1 = __builtin_amdgcn_ds_read_tr16_b64_v4i16((LAS s16x4*)(vtb + 4 * 64));
                    const bf16x8 vb = (bf16x8){f0.x, f0.y, f0.z, f0.w, f1.x, f1.y, f1.z, f1.w};
                    const bf16x8 sa0 = *(const LAS bf16x8*)(SB + r * RS + 32 * w + 16 * h), sa1 = *(const LAS bf16x8*)(SB + (32 + r) * RS + 32 * w + 16 * h);
                    P0 = __builtin_amdgcn_mfma_f32_32x32x16_bf16(sa0, vb, P0, 0, 0, 0); P1 = __builtin_amdgcn_mfma_f32_32x32x16_bf16(sa1, vb, P1, 0, 0, 0); }
                { LAS float* pb = PART + (w * 64 + 4 * h) * 32 + r; asm volatile("" : "+v"(pb));
#pragma unroll
                  for (int j = 0; j < 16; ++j) { pb[((j & 3) + 8 * (j >> 2)) * 32] = P0[j]; pb[(32 + (j & 3) + 8 * (j >> 2)) * 32] = P1[j]; } }
            }
            __builtin_amdgcn_sched_barrier(0);
            R_BAR();
            {
                const int t = tid >> 3, eg = tid & 7;
                const LAS float* pr = PART + t * 32 + eg * 4; asm volatile("" : "+v"(pr));
                f32x4 pv[8]; float qv[8];
#pragma unroll
                for (int ww = 0; ww < 8; ++ww) { pv[ww] = *(const LAS f32x4*)(pr + ww * 64 * 32); qv[ww] = QNP[ww * 64 + t]; }
                const float s_ds = scl[128 + t], s_sc = scl[t], s_fl = scl[64 + t];
                __builtin_amdgcn_sched_barrier(0);
                if (ck + 1 < NCH) R_STAGE(ck + 1);
                __builtin_amdgcn_sched_barrier(0);
                f32x4 num = pv[0];
#pragma unroll
                for (int ww = 1; ww < 8; ++ww) num += pv[ww];
                const float qn = ((qv[0] + qv[1]) + (qv[2] + qv[3])) + ((qv[4] + qv[5]) + (qv[6] + qv[7]));
                const float den = s_ds + s_sc * qn, dn = fmaxf(fabsf(den), s_fl);
                const f32x4 hv = num * __builtin_amdgcn_rcpf(dn);
                u32x2 ow; ow.x = pk2(hv.x, hv.y); ow.y = pk2(hv.z, hv.w);
                *(u32x2*)(HM + (size_t)rowt * ldh + colv + eg * 4) = ow;
            }
        }
#undef R_PREFETCH_K
#undef R_KWRITE
#undef R_PREFETCH_VS
#undef R_PREFETCH_Q
#undef R_QSTAGE
#undef R_STAGE
    }
#undef R_BAR
    __syncthreads();
}

__device__ __forceinline__ void ph_mlpost(const Ctx& F, int j, int hb, bf16* PA, const bf16* HMB, const bf16* XCV, const bf16* ZG) {
    const float* wv = F.in(I_MLWV) + (size_t)j * 512 * 16; const float* ng = F.in(I_MLNG) + (size_t)j * 2048; const float* sk = F.in(I_MLSKIP) + (size_t)j * 2048;
    bf16* PH = PA + (size_t)hb * MH * 2048;
    LAS f32x4* const WL = (LAS f32x4*)F.lds;
    for (int i = F.tid; i < 4 * 12 * 64; i += NTHR) { const int ln = i & 63, q = (i >> 6) % 12, k = i / 768, c = 8 * ln + 512 * k;
        const float* src = q < 8 ? wv + (size_t)((c >> 2) + (q >> 2)) * 16 + 4 * (q & 3) : (q < 10 ? ng + c + 4 * (q - 8) : sk + c + 4 * (q - 10));
        WL[i] = *(const f32x4*)src; }
    __syncthreads();
    const int nrows = (MH - F.gw + F.NGW - 1) / F.NGW;
    u32x4 cur[4][4];
#define MP_ISSUE(n_, L) do { const size_t o_ = (size_t)(F.gw + (n_) * F.NGW) * 2048 + 8 * F.lane; \
        _Pragma("unroll") for (int k = 0; k < 4; ++k) { L[k][0] = *(const u32x4*)(PH + o_ + 512 * k); L[k][1] = *(const u32x4*)(HMB + o_ + 512 * k); L[k][2] = *(const u32x4*)(XCV + o_ + 512 * k); L[k][3] = *(const u32x4*)(ZG + o_ + 512 * k); } } while (0)
    if (nrows > 0) MP_ISSUE(0, cur);
#pragma unroll 1
    for (int n = 0; n < nrows; ++n) {
        const size_t on_ = (size_t)(F.gw + (n + 1 < nrows ? n + 1 : n) * F.NGW) * 2048 + 8 * F.lane;
        bf16* const prow = PH + (size_t)(F.gw + n * F.NGW) * 2048 + 8 * F.lane;
#pragma unroll
        for (int k = 0; k < 4; ++k) {
            const LAS f32x4* wl = WL + (k * 12) * 64 + F.lane;
            float a[8], b[8], h[8]; unpack8(cur[k][0], a); unpack8(cur[k][1], b);
#pragma unroll
            for (int e = 0; e < 8; ++e) a[e] += b[e];
#pragma unroll
            for (int blk = 0; blk < 2; ++blk) { const f32x4 w0 = wl[(blk * 4 + 0) * 64], w1 = wl[(blk * 4 + 1) * 64], w2 = wl[(blk * 4 + 2) * 64], w3 = wl[(blk * 4 + 3) * 64];
#pragma unroll
                for (int o = 0; o < 4; ++o) h[blk * 4 + o] = a[blk * 4 + 0] * w0[o] + a[blk * 4 + 1] * w1[o] + a[blk * 4 + 2] * w2[o] + a[blk * 4 + 3] * w3[o]; }
            float s1 = 0.f;
#pragma unroll
            for (int e = 0; e < 8; ++e) s1 += h[e];
            const float mu = wave_sum(s1) * (1.f / 512.f); float s2 = 0.f;
#pragma unroll
            for (int e = 0; e < 8; ++e) { h[e] -= mu; s2 += h[e] * h[e]; }
            const float rstd = rsqrtf(wave_sum(s2) * (1.f / 512.f) + EPS);
            const f32x4 g0 = wl[8 * 64], g1 = wl[9 * 64], k0 = wl[10 * 64], k1 = wl[11 * 64];
            const float ngv[8] = {g0.x, g0.y, g0.z, g0.w, g1.x, g1.y, g1.z, g1.w}, skv[8] = {k0.x, k0.y, k0.z, k0.w, k1.x, k1.y, k1.z, k1.w};
            float x[8], z[8], o[8]; unpack8(cur[k][2], x); unpack8(cur[k][3], z);
#pragma unroll
            for (int e = 0; e < 8; ++e) o[e] = (h[e] * rstd * ngv[e] + skv[e] * x[e]) * silu(z[e]);
            *(u32x4*)(prow + 512 * k) = pack8(o);
            cur[k][0] = *(const u32x4*)(PH + on_ + 512 * k); cur[k][1] = *(const u32x4*)(HMB + on_ + 512 * k); cur[k][2] = *(const u32x4*)(XCV + on_ + 512 * k); cur[k][3] = *(const u32x4*)(ZG + on_ + 512 * k);
            __builtin_amdgcn_sched_barrier(0);
        }
    }
#undef MP_ISSUE
    __syncthreads();
}

__device__ __forceinline__ void ph_ctx_reduce(const Ctx& F, const float* P, const float* src, float* dst, const float* gtc, int i0, int i1) {
    for (int i = i0 + F.bid * NTHR + F.tid; i < i1; i += F.G * NTHR) {
        const int c4 = (i & 255) * 4, row = i >> 8;
        f32x4 a = *(const f32x4*)(P + (size_t)row * 1024 + c4);
#pragma unroll
        for (int ks = 1; ks < 8; ++ks) a += *(const f32x4*)(P + ((size_t)ks * 1024 + row) * 1024 + c4);
        const f32x4 x = *(const f32x4*)(src + (size_t)row * 1024 + c4), g = *(const f32x4*)(gtc + c4);
        *(f32x4*)(dst + (size_t)row * 1024 + c4) = x + g * a;
    }
}
__device__ __forceinline__ void ph_final(const Ctx& F) {
    const float* fg = F.in(I_FINALG);
    for (int r = F.gw; r < NB * LLAT; r += F.NGW) {
        f32x4* xr = (f32x4*)(F.out + (size_t)r * D) + F.lane;
        f32x4 v[4]; float ss = 0.f;
#pragma unroll
        for (int jj = 0; jj < 4; ++jj) { v[jj] = xr[64 * jj]; ss += (v[jj].x * v[jj].x + v[jj].y * v[jj].y) + (v[jj].z * v[jj].z + v[jj].w * v[jj].w); }
        const float rstd = rsqrtf(wave_sum(ss) * (1.f / D) + EPS);
#pragma unroll
        for (int jj = 0; jj < 4; ++jj) { const f32x4 g = *(const f32x4*)(fg + 4 * F.lane + 256 * jj); xr[64 * jj] = v[jj] * rstd * g; }
    }
}

constexpr int NPH = 1 + 2 * 8 + 14 + 14 + 1;

__global__ void __launch_bounds__(NTHR, 2) fwd_kernel(Args args) {
    extern __shared__ __attribute__((aligned(16))) unsigned char lds_raw[];
    volatile LAS unsigned* MISC = (volatile LAS unsigned*)((LAS unsigned char*)lds_raw + MISC_OFF);
    if (threadIdx.x < 64) MISC[threadIdx.x] = 0u;
    __syncthreads();
    const int lo = args.ph_lo, hi = args.ph_hi;
    const int wv0 = __builtin_amdgcn_readfirstlane((int)threadIdx.x >> 6);
    XcdBarrier bar; bar.bar = (unsigned*)(args.ws + WS_CTL); bar.x = 0; bar.st = MISC;
    if (hi - lo > 1) bar = xcd_barrier_post((unsigned*)(args.ws + WS_CTL), MISC);
    int ph = 0;
#define PH_BEGIN if (ph >= lo && ph < hi) { Ctx F; { const CAS char* kp_ = (const CAS char*)__builtin_amdgcn_kernarg_segment_ptr(); asm volatile("" : "+s"(kp_)); F.kp = kp_; \
        F.lds = (LAS unsigned char*)lds_raw; { int w_ = wv0, b_ = blockIdx.x, g_ = gridDim.x, ln_; asm volatile("v_mbcnt_lo_u32_b32 %0, -1, 0\n\tv_mbcnt_hi_u32_b32 %0, -1, %0" : "=v"(ln_)); asm volatile("" : "+s"(w_), "+s"(b_), "+s"(g_)); F.tid = (w_ << 6) | ln_; F.wave = w_; F.bid = b_; F.G = g_; } \
        F.lane = F.tid & 63; \
        F.gw = F.bid * NWAVES + F.wave; F.NGW = F.G * NWAVES; F.out = *(float* const CAS*)(kp_ + 304); F.ws = *(unsigned char* const CAS*)(kp_ + 312); } \
        unsigned char* const ws = F.ws; bf16* const SL0 = (bf16*)(ws + WS_SLAB); bf16* const SL1 = (bf16*)(ws + WS_SLAB + SLAB); bf16* const SL2 = (bf16*)(ws + WS_SLAB + 2 * SLAB); bf16* const SL3 = (bf16*)(ws + WS_SLAB + 3 * SLAB); \
        bf16* const SL4 = (bf16*)(ws + WS_SLAB + 4 * SLAB); bf16* const SL5 = (bf16*)(ws + WS_SLAB + 5 * SLAB); bf16* const SL6 = (bf16*)(ws + WS_SLAB + 6 * SLAB); \
        bf16* const WIN = (bf16*)(ws + WS_W + W_IN); bf16* const WOUT = (bf16*)(ws + WS_W + W_OUT); bf16* const WGLU = (bf16*)(ws + WS_W + W_GLU); bf16* const WGATE = (bf16*)(ws + WS_W + W_GATE); \
        const float* const modv = (const float*)(ws + WS_MODV); float* const xctx = (float*)(ws + WS_XCTX); (void)SL0; (void)SL1; (void)SL2; (void)SL3; (void)SL4; (void)SL5; (void)SL6; (void)WIN; (void)WOUT; (void)WGLU; (void)WGATE; (void)modv; (void)xctx;
#define PH_END if (ph + 1 < hi) { int ln2_; asm volatile("v_mbcnt_lo_u32_b32 %0, -1, 0\n\tv_mbcnt_hi_u32_b32 %0, -1, %0" : "=v"(ln2_)); xcd_barrier(bar, (ln2_ == 0) & (wv0 == 0)); } } ++ph;

    PH_BEGIN ph_mod(F); PH_END

#pragma unroll 1
    for (int l = 0; l < DEPTH; ++l) {
        const int j = l >> 1;
        if ((l & 1) == 0) {
#define Y SL0
#define U SL2
#define XR SL3
#define HB SL4
#define XC SL4
#define YS0 SL5
#define YS1 SL6
            PH_BEGIN { int l_ = l; asm volatile("" : "+s"(l_)); ph_norm(F, l_, 0, M, HB, l_ > 0 ? (const float*)SL2 : (const float*)nullptr); } ph_wconv_even(F, j); PH_END
            PH_BEGIN { pg8::TileOrder S; S.init(NTILE, 16, F.G, F.bid, HB, (size_t)256 * 1024 * 2, WIN, (size_t)256 * 1024 * 2);
                       pg8::EpiSplit E{U, Y, (long)(XR - U), 1024, 1024, 2048, 10};
                       GEMM_CALL(1024, 1024, 1024, S, E); } PH_END
            PH_BEGIN ph_rgconv(F, j, XR, XC); __syncthreads(); ph_s5_mfma(F, j, U, YS0); PH_END
            PH_BEGIN { pg8::TileOrder S; S.init(NTILE - NB, 4, F.G, F.bid, U, (size_t)256 * 1024 * 2, WGLU, (size_t)256 * 1024 * 2); S.skipctx = 1;
                       pg8::EpiGlu E{U, Y, F.in(I_GLUB) + (size_t)j * 1024};
                       GEMM_CALL(1024, 1024, 1024, S, E); } PH_END
            PH_BEGIN {
                       { pg8::CtxOrder S3{F.G, F.bid, 64, 4, (const char*)U, (size_t)256 * 1024 * 2, (const char*)WGLU, (size_t)256 * 1024 * 2}; pg8::EpiGlu E3{U, Y, F.in(I_GLUB) + (size_t)j * 1024};
                         int tid3 = F.tid; asm volatile("" : "+v"(tid3)); pg8::gemm_phase(F.lds, tid3, 1024, 1024, 1024, S3, E3); }
                       __syncthreads();
                       pg8::TileOrder S; S.init(NTILE, 16, F.G, F.bid, XC, (size_t)256 * 1024 * 2, WGATE, (size_t)256 * 256 * 2, 2, (size_t)256 * 2);
                       pg8::EpiGate E{XC, SL2, F.in(I_RGBA) + (size_t)j * 2048, F.in(I_RGBX) + (size_t)j * 2048, (const float*)(ws + WS_SPT)};
                       GEMM_CALL(256, 1024, 256, S, E); } PH_END
            PH_BEGIN ph_rgscan_a(F, SL2, SL3, SL5, SL6, (float*)(ws + WS_PS), (float*)(ws + WS_GATE), (const bf16*)(ws + WS_ST)); PH_END
            PH_BEGIN ph_rgscan_c(F, SL2, SL3, SL5, SL6, (const float*)(ws + WS_PS), (const float*)(ws + WS_GATE), Y, (const bf16*)(ws + WS_ST)); PH_END
            PH_BEGIN { pg8::TileOrder S; S.init(NTILE - NB, 4, F.G, F.bid, Y, (size_t)256 * 2048 * 2, WOUT, (size_t)256 * 2048 * 2); S.skipctx = 1;
                       pg8::EpiOut E{l == 0 ? F.in(I_X) : (const float*)F.out, l == 0 ? F.in(I_CTX) : (const float*)xctx, F.out, xctx, modv + (size_t)l * 5 * 3072};
                       GEMM_CALL(2048, 2048, 2048, S, E);
                       __syncthreads();
                       { pg8::CtxKOrder S2{F.G, F.bid, (const char*)Y, (size_t)256 * 2048 * 2, (const char*)WOUT, (size_t)256 * 2048 * 2}; pg8::EpiPart E2{(float*)SL2};
                         { int tid2 = F.tid; asm volatile("" : "+v"(tid2)); pg8::gemm_phase(F.lds, tid2, 256, 2048, 2048, S2, E2); }     } } PH_END
        } else {
#undef Y
#undef U
#undef XR
#undef HB
#undef XC
#undef YS0
#undef YS1
#define PA SL0
#define HMB SL2
#define XM SL3
#define ZG SL4
#define XCV SL5
#define QP SL6
#define HB SL6
#pragma unroll 1
            for (int hb = 0; hb < 2; ++hb) {
                if (hb == 0) { PH_BEGIN { int l_ = l; asm volatile("" : "+s"(l_)); ph_norm(F, l_, 0, MH, HB, (const float*)SL2);
                                          ph_ctx_reduce(F, (const float*)SL2, l_ == 1 ? F.in(I_CTX) : (const float*)xctx, xctx, modv + (size_t)(l_ - 1) * 5 * 3072 + 4 * 3072 + 2048, (NB / 2) * LCTX * D / 4, NB * LCTX * D / 4); } ph_wconv_odd(F, j); PH_END }
                PH_BEGIN { pg8::TileOrder S; S.init(NTILE / 2, 16, F.G, F.bid, HB, (size_t)256 * 1024 * 2, WIN, (size_t)256 * 1024 * 2);
                           pg8::EpiSplit E{XM, ZG, 0, 0, 2048, 2048, 11};
                           GEMM_CALL(1024, 1024, 1024, S, E); } PH_END
                PH_BEGIN ph_convq(F, j, hb, XM, XCV, QP); PH_END
                PH_BEGIN ph_mscan(F, hb); PH_END
                PH_BEGIN ph_stilde(F, hb, QP, XCV); PH_END
                PH_BEGIN ph_mlstm_r(F, hb, QP, XCV, XM, PA + (size_t)hb * MH * 2048, 2048, HMB, 2048); PH_END
                PH_BEGIN ph_mlpost(F, j, hb, PA, HMB, XCV, ZG);
                         if (hb == 0) { int l_ = l; asm volatile("" : "+s"(l_)); ph_norm(F, l_, MH, 2 * MH, HB, (const float*)nullptr); }
                PH_END
            }
            PH_BEGIN { pg8::TileOrder S; S.init(NTILE - NB, 4, F.G, F.bid, PA, (size_t)256 * 2048 * 2, WOUT, (size_t)256 * 2048 * 2); S.skipctx = 1;
                       pg8::EpiOut E{l == 0 ? F.in(I_X) : (const float*)F.out, l == 0 ? F.in(I_CTX) : (const float*)xctx, F.out, xctx, modv + (size_t)l * 5 * 3072};
                       GEMM_CALL(2048, 2048, 2048, S, E);
                       if (l < DEPTH - 1) { __syncthreads();
                         pg8::CtxKOrder S2{F.G, F.bid, (const char*)PA, (size_t)256 * 2048 * 2, (const char*)WOUT, (size_t)256 * 2048 * 2}; pg8::EpiPart E2{(float*)SL2};
                         { int tid2 = F.tid; asm volatile("" : "+v"(tid2)); pg8::gemm_phase(F.lds, tid2, 256, 2048, 2048, S2, E2); }     } } PH_END
        }
    }
    PH_BEGIN ph_final(F); PH_END
#undef PH_BEGIN
#undef PH_END
#undef PA
#undef HMB
#undef XM
#undef ZG
#undef XCV
#undef QP
#undef HB
}

extern "C" void kernel_launch(void* const* d_in, const int* in_sizes, int n_in, void* d_out, int out_size, void* d_ws, size_t ws_size, hipStream_t stream) {
    static int grid = 0;
    if (grid == 0) {
        int dev = 0, cus = 0, per_cu = 0;
        if (hipGetDevice(&dev) != hipSuccess || hipDeviceGetAttribute(&cus, hipDeviceAttributeMultiprocessorCount, dev) != hipSuccess) { fprintf(stderr, "kernel_launch: device query failed\n"); grid = -1; return; }
        if (hipFuncSetAttribute((const void*)fwd_kernel, hipFuncAttributeMaxDynamicSharedMemorySize, LDS_BYTES) != hipSuccess) { fprintf(stderr, "kernel_launch: hipFuncSetAttribute failed\n"); grid = -1; return; }
        if (hipOccupancyMaxActiveBlocksPerMultiprocessor(&per_cu, (const void*)fwd_kernel, NTHR, LDS_BYTES) != hipSuccess || per_cu < 1) fprintf(stderr, "kernel_launch: occupancy query says %d\n", per_cu);
        (void)hipGetLastError();
        grid = cus;
        if (n_in != 38 || out_size != NB * LLAT * D || ws_size < WS_END) fprintf(stderr, "kernel_launch: unexpected shapes: n_in %d out %d ws %zu\n", n_in, out_size, ws_size);
    }
    if (grid < 0) return;
    (void)hipMemsetAsync((char*)d_ws + WS_CTL, 0, CTL_ZERO_BYTES, stream);
    Args a{};
    for (int i = 0; i < 38; ++i) a.in[i] = (const float*)d_in[i];
    a.out = (float*)d_out; a.ws = (unsigned char*)d_ws;
#if ONE_LAUNCH
    a.ph_lo = 0; a.ph_hi = NPH;
    hipLaunchKernelGGL(fwd_kernel, dim3(grid), dim3(NTHR), LDS_BYTES, stream, a);
#else
    for (int p = 0; p < NPH; ++p) { a.ph_lo = p; a.ph_hi = p + 1; hipLaunchKernelGGL(fwd_kernel, dim3(grid), dim3(NTHR), LDS_BYTES, stream, a); }
#endif
}
```
